# Optimizing an MI355X kernel written in HIP

```python
import jax, jax.numpy as jnp
from jax import lax
import numpy as np

D_MODEL = 2048
BATCH = 2
SEQ = 8192
DEPTH = 2

D_MIX = D_MODEL
CONV_WIDTH = D_MIX // 2
LRU_WIDTH = D_MIX - CONV_WIDTH
LRU_HEADS = 8
LRU_HEAD_DIM = LRU_WIDTH // LRU_HEADS
D_IN = 2 * CONV_WIDTH + 2 * LRU_WIDTH
CONV_K = 31
LRU_CONV_K = 4
LRU_C = 8.0
D_FF = 3 * D_MODEL
N_EXPERTS = 8
TOP_K = 2
D_EXPERT = 3 * D_MODEL
MOE_BLOCK = 512
N_DENSE = (DEPTH + 1) // 2
N_MOE = DEPTH // 2
EPS = 1e-6

kernel_name = "hybrid_conformer_rglru_moe_trunk"


def rms_norm(x, g):
    xf = x.astype(jnp.float32)
    y = xf * lax.rsqrt(jnp.mean(xf * xf, axis=-1, keepdims=True) + EPS)
    return (y * g.astype(jnp.float32)).astype(x.dtype)


def causal_depthwise_conv(x, w, b):
    width, ch = w.shape
    y = lax.conv_general_dilated(
        x, w[:, None, :].astype(x.dtype), window_strides=(1,), padding=[(width - 1, 0)],
        dimension_numbers=("NWC", "WIO", "NWC"), feature_group_count=ch)
    return y + b.astype(x.dtype)


def conformer_conv(val, gate, conv_w, conv_b, ln_g, ln_b):
    c = val * jax.nn.sigmoid(gate)
    c = causal_depthwise_conv(c, conv_w, conv_b)
    cf = c.astype(jnp.float32)
    mu = jnp.mean(cf, axis=-1, keepdims=True)
    var = jnp.mean(jnp.square(cf - mu), axis=-1, keepdims=True)
    cn = (cf - mu) * lax.rsqrt(var + EPS) * ln_g.astype(jnp.float32) + ln_b.astype(jnp.float32)
    return jax.nn.silu(cn).astype(val.dtype)


def _linear_recurrence_combine(c1, c2):
    a1, b1 = c1
    a2, b2 = c2
    return a1 * a2, a2 * b1 + b2


def rg_lru(x, wa, ba, wx, bx, lam):
    bsz, seq, width = x.shape
    xh = x.reshape(bsz, seq, LRU_HEADS, LRU_HEAD_DIM)
    gate_a = jax.nn.sigmoid(jnp.einsum("bshi,hij->bshj", xh, wa.astype(x.dtype)).reshape(bsz, seq, width) + ba.astype(x.dtype))
    gate_x = jax.nn.sigmoid(jnp.einsum("bshi,hij->bshj", xh, wx.astype(x.dtype)).reshape(bsz, seq, width) + bx.astype(x.dtype))
    log_a = -LRU_C * gate_a.astype(jnp.float32) * jax.nn.softplus(-lam.astype(jnp.float32))
    a = jnp.exp(log_a)
    mult = jnp.sqrt(-jnp.expm1(2.0 * log_a))
    is_first = (jnp.arange(seq) == 0)[None, :, None]
    mult = jnp.where(is_first, jnp.ones_like(mult), mult)
    b = mult * (gate_x * x).astype(jnp.float32)
    _, h = lax.associative_scan(_linear_recurrence_combine, (a, b), axis=1)
    return h.astype(x.dtype)


def hybrid_mixer(h, w_in, conv_w, conv_b, conv_ln_g, conv_ln_b,
                 lru_conv_w, lru_conv_b, lru_wa, lru_ba, lru_wx, lru_bx, lru_lambda, w_out):
    u = jnp.einsum("bsd,de->bse", h, w_in.astype(h.dtype))
    splits = [CONV_WIDTH, 2 * CONV_WIDTH, 2 * CONV_WIDTH + LRU_WIDTH]
    c_val, c_gate, r_x, r_gate = jnp.split(u, splits, axis=-1)
    y_conv = conformer_conv(c_val, c_gate, conv_w, conv_b, conv_ln_g, conv_ln_b)
    r_x = causal_depthwise_conv(r_x, lru_conv_w, lru_conv_b)
    y_lru = rg_lru(r_x, lru_wa, lru_ba, lru_wx, lru_bx, lru_lambda) * jax.nn.gelu(r_gate)
    y = jnp.concatenate([y_conv, y_lru], axis=-1)
    return jnp.einsum("bse,ed->bsd", y, w_out.astype(h.dtype))


def swiglu(h, wg, wu, wd):
    g = jnp.einsum("bsd,df->bsf", h, wg.astype(h.dtype))
    v = jnp.einsum("bsd,df->bsf", h, wu.astype(h.dtype))
    return jnp.einsum("bsf,fd->bsd", jax.nn.silu(g) * v, wd.astype(h.dtype))


def moe_swiglu(h, w_router, wg, wu, wd):
    bsz, seq, d = h.shape
    n_tok = bsz * seq
    n_asg = n_tok * TOP_K
    xf = h.reshape(n_tok, d)
    logits = jnp.einsum("td,de->te", xf, w_router.astype(xf.dtype)).astype(jnp.float32)
    probs = jax.nn.softmax(logits, axis=-1)
    top_p, top_e = lax.top_k(probs, TOP_K)
    top_p = top_p / jnp.sum(top_p, axis=-1, keepdims=True)
    flat_e = top_e.reshape(-1).astype(jnp.int32)
    flat_tok = jnp.arange(n_asg, dtype=jnp.int32) // TOP_K
    flat_w = top_p.reshape(-1)
    order = jnp.argsort(flat_e)
    s_e, s_tok, s_w = flat_e[order], flat_tok[order], flat_w[order]
    counts = jnp.bincount(flat_e, length=N_EXPERTS).astype(jnp.int32)
    starts = jnp.cumsum(counts) - counts
    padded = ((counts + MOE_BLOCK - 1) // MOE_BLOCK) * MOE_BLOCK
    p_ends = jnp.cumsum(padded)
    p_starts = p_ends - padded
    pos = p_starts[s_e] + (jnp.arange(n_asg, dtype=jnp.int32) - starts[s_e])
    n_blocks = -(-n_asg // MOE_BLOCK) + N_EXPERTS
    n_rows = n_blocks * MOE_BLOCK
    x_buf = jnp.zeros((n_rows, d), xf.dtype).at[pos].set(xf[s_tok])
    block_start = jnp.arange(n_blocks, dtype=jnp.int32) * MOE_BLOCK
    block_e = jnp.minimum(jnp.searchsorted(p_ends, block_start, side="right"), N_EXPERTS - 1)

    def expert_block(args):
        xb, e = args
        g = xb @ wg[e].astype(xb.dtype)
        v = xb @ wu[e].astype(xb.dtype)
        return (jax.nn.silu(g) * v) @ wd[e].astype(xb.dtype)

    y_buf = lax.map(expert_block, (x_buf.reshape(n_blocks, MOE_BLOCK, d), block_e)).reshape(n_rows, d)
    y = jnp.zeros((n_tok, d), xf.dtype).at[s_tok].add(y_buf[pos] * s_w[:, None].astype(xf.dtype))
    return y.reshape(bsz, seq, d)


def setup_inputs(seed: int = 0) -> dict:
    key = jax.random.key(seed)
    ks = jax.random.split(key, 24)
    f32 = jnp.float32

    def nrm(k, shape, scale):
        return jax.random.normal(k, shape, f32) * scale

    lam_v = jax.random.uniform(ks[13], (DEPTH, LRU_WIDTH), f32, minval=0.9, maxval=0.999)
    lam_s = lam_v ** (1.0 / LRU_C)
    return {
        "x": nrm(ks[0], (BATCH, SEQ, D_MODEL), 1.0),
        "mix_norm": 1.0 + nrm(ks[1], (DEPTH, D_MODEL), 0.02),
        "w_in": nrm(ks[2], (DEPTH, D_MODEL, D_IN), D_MODEL ** -0.5),
        "conv_w": nrm(ks[3], (DEPTH, CONV_K, CONV_WIDTH), CONV_K ** -0.5),
        "conv_b": nrm(ks[4], (DEPTH, CONV_WIDTH), 0.02),
        "conv_ln_g": 1.0 + nrm(ks[5], (DEPTH, CONV_WIDTH), 0.02),
        "conv_ln_b": nrm(ks[6], (DEPTH, CONV_WIDTH), 0.02),
        "lru_conv_w": nrm(ks[7], (DEPTH, LRU_CONV_K, LRU_WIDTH), LRU_CONV_K ** -0.5),
        "lru_conv_b": nrm(ks[8], (DEPTH, LRU_WIDTH), 0.02),
        "lru_wa": nrm(ks[9], (DEPTH, LRU_HEADS, LRU_HEAD_DIM, LRU_HEAD_DIM), LRU_HEAD_DIM ** -0.5),
        "lru_ba": nrm(ks[10], (DEPTH, LRU_WIDTH), 0.02),
        "lru_wx": nrm(ks[11], (DEPTH, LRU_HEADS, LRU_HEAD_DIM, LRU_HEAD_DIM), LRU_HEAD_DIM ** -0.5),
        "lru_bx": nrm(ks[12], (DEPTH, LRU_WIDTH), 0.02),
        "lru_lambda": jnp.log(lam_s) - jnp.log1p(-lam_s),
        "w_out": nrm(ks[14], (DEPTH, D_MIX, D_MODEL), D_MIX ** -0.5),
        "ffn_norm": 1.0 + nrm(ks[15], (DEPTH, D_MODEL), 0.02),
        "dense_wg": nrm(ks[16], (N_DENSE, D_MODEL, D_FF), D_MODEL ** -0.5),
        "dense_wu": nrm(ks[17], (N_DENSE, D_MODEL, D_FF), D_MODEL ** -0.5),
        "dense_wd": nrm(ks[18], (N_DENSE, D_FF, D_MODEL), D_FF ** -0.5),
        "w_router": nrm(ks[19], (N_MOE, D_MODEL, N_EXPERTS), D_MODEL ** -0.5),
        "moe_wg": nrm(ks[20], (N_MOE, N_EXPERTS, D_MODEL, D_EXPERT), D_MODEL ** -0.5),
        "moe_wu": nrm(ks[21], (N_MOE, N_EXPERTS, D_MODEL, D_EXPERT), D_MODEL ** -0.5),
        "moe_wd": nrm(ks[22], (N_MOE, N_EXPERTS, D_EXPERT, D_MODEL), D_EXPERT ** -0.5),
        "final_norm": 1.0 + nrm(ks[23], (D_MODEL,), 0.02),
    }


def reference(x, mix_norm, w_in, conv_w, conv_b, conv_ln_g, conv_ln_b,
              lru_conv_w, lru_conv_b, lru_wa, lru_ba, lru_wx, lru_bx, lru_lambda,
              w_out, ffn_norm, dense_wg, dense_wu, dense_wd,
              w_router, moe_wg, moe_wu, moe_wd, final_norm):
    for layer in range(DEPTH):
        h = rms_norm(x, mix_norm[layer])
        x = x + hybrid_mixer(h, w_in[layer], conv_w[layer], conv_b[layer], conv_ln_g[layer], conv_ln_b[layer],
                             lru_conv_w[layer], lru_conv_b[layer], lru_wa[layer], lru_ba[layer],
                             lru_wx[layer], lru_bx[layer], lru_lambda[layer], w_out[layer])
        h = rms_norm(x, ffn_norm[layer])
        j = layer // 2
        if layer % 2 == 0:
            x = x + swiglu(h, dense_wg[j], dense_wu[j], dense_wd[j])
        else:
            x = x + moe_swiglu(h, w_router[j], moe_wg[j], moe_wu[j], moe_wd[j])
    return rms_norm(x, final_norm)
```

```cpp
#include <hip/hip_runtime.h>
#include <cstdio>
#include <cstdint>

#define NAIVE_CONV 0
#define NAIVE_LRU 0
#ifndef DENSE2_FP8
#define DENSE2_FP8 1
#endif
#ifndef GEMM_PV
#define GEMM_PV -1
#endif
#ifndef XPAD
#define XPAD 128
#endif
#ifndef PROBE_PHASE
#define PROBE_PHASE -1
#endif
#ifndef PROBE_N
#define PROBE_N 2
#endif
#ifndef PROBE_SUB
#define PROBE_SUB 0
#endif
#ifndef PROBE_SKIP_EPI
#define PROBE_SKIP_EPI 0
#endif
#ifndef MK_PER_PHASE
#define MK_PER_PHASE 0
#endif

namespace pg8 {
#define PG8_LAS __attribute__((address_space(3)))
typedef unsigned short bf16_t;
typedef short bf16x8 __attribute__((ext_vector_type(8)));
typedef float f32x4 __attribute__((ext_vector_type(4)));
typedef unsigned u32x4 __attribute__((ext_vector_type(4)));
typedef int v4i __attribute__((ext_vector_type(4)));
typedef int v8i __attribute__((ext_vector_type(8)));
typedef int v6i __attribute__((ext_vector_type(6)));
typedef int v2i __attribute__((ext_vector_type(2)));
typedef unsigned u32x2 __attribute__((ext_vector_type(2)));
constexpr int BM = 256, BK = 64, HALF = 128, HTB = HALF * BK * 2  , STAGE_BYTES = 8 * HTB, NXCD = 8, WGM = 6;

__host__ __device__ __forceinline__ int lds_byte(int r, int c) { const int st = (r >> 4) * 2 + (c >> 5), rr = r & 15, cc = c & 31, ob = rr * 64 + cc * 2; return st * 1024 + (ob ^ (((ob >> 9) & 1) << 5)); }
__host__ __device__ __forceinline__ void stage_rc(int b, int& R, int& C) { const int st = b / 1024, sb = b % 1024, swz = sb ^ (((sb >> 9) & 1) << 5); R = (st >> 1) * 16 + swz / 64; C = (st & 1) * 32 + (swz % 64) / 2; }
__host__ __device__ __forceinline__ int perm32(int rho) { const int n = rho >> 4, i = rho & 15; return 8 * (i >> 2) + 4 * n + (i & 3); }

struct Unit { int pm, pn; bool skip_epi; };
struct Gemm { const bf16_t* A; const bf16_t* Bt; int M, N, K; int lda = 0; };

struct StaticOrder {
    int nM, nN, nwg, G, c, rep = 1;
    int i0 = 0, i1 = 0x7fffffff;
    __host__ __device__ void init(int M, int N, int G_, int c_) { nM = M / BM; nN = N / BM; nwg = nM * nN; G = G_; c = c_; }
    __host__ __device__ bool next(int i, Unit& u) const {
        i += i0; if (i >= i1) return false;
        long L = (long)i * G + c; if (L >= (long)nwg * rep) return false;
        u.skip_epi = false;
        if (rep > 1) { u.skip_epi = PROBE_SKIP_EPI && (L >= nwg); L %= nwg; }
        int wgid = (int)L; { const int q = nwg / NXCD, r = nwg % NXCD, xcd = wgid % NXCD, off = wgid / NXCD; wgid = (xcd < r ? xcd * (q + 1) : r * (q + 1) + (xcd - r) * q) + off; }
        const int nig = WGM * nN, gid = wgid / nig, fm = gid * WGM, gsz = (nM - fm) < WGM ? (nM - fm) : WGM;
        u.pm = fm + ((wgid % nig) % gsz); u.pn = (wgid % nig) / gsz; return true;
    }
    __device__ __forceinline__ size_t b_off(const Unit&) const { return 0; }
    __device__ __forceinline__ int a_tile(const Unit& u) const { return u.pm; }
    __device__ __forceinline__ void a_ready(const Unit&) const {}
    __device__ __forceinline__ void done(const Unit&) const {}
};
struct MoeOrder : StaticOrder {
    int te[8]; int dg[7]; size_t estride;
    __device__ __forceinline__ size_t b_off(const Unit& u) const { int e = 0;
#pragma unroll
        for (int k = 0; k < 7; ++k) e += (u.pm >= te[k]) ? 1 : 0;
        return (size_t)e * estride; }
    __device__ __forceinline__ int a_tile(const Unit& u) const { int t = u.pm;
#pragma unroll
        for (int k = 0; k < 7; ++k) t += (u.pm >= te[k]) ? dg[k] : 0;
        return t; }
};

__device__ __forceinline__ unsigned cvt_pk_bf16(float lo, float hi) { unsigned r; asm volatile("v_cvt_pk_bf16_f32 %0, %1, %2" : "=v"(r) : "v"(lo), "v"(hi)); return r; }

constexpr float NORM_EPS = 1e-6f, NORM_INV_D = 1.0f / 2048.0f;
struct EpiBf16 {
    static constexpr bool PERM = true, AFTER_DRAIN = false;
    bf16_t* O; int ldc; const float* ssq;
    __device__ __forceinline__ void operator()(const f32x4 (&acc)[2][2][4][2], const Unit& u, int wr, int wc, int fr, int fq) const {
        const int row0 = u.pm * BM + wr * 64 + fr, col0 = u.pn * BM + wc * 32 + 8 * fq;
#pragma unroll
        for (int ai = 0; ai < 2; ++ai)
#pragma unroll
            for (int m = 0; m < 4; ++m) { bf16_t* rowp = O + (size_t)(row0 + ai * HALF + m * 16) * ldc + col0;
                float rs = 1.0f; if (ssq) { const f32x4* p = (const f32x4*)(ssq + (size_t)(row0 + ai * HALF + m * 16) * 8); const f32x4 a = p[0], b = p[1]; rs = 1.0f / sqrtf((((a[0] + a[1]) + (a[2] + a[3])) + ((b[0] + b[1]) + (b[2] + b[3]))) * NORM_INV_D + NORM_EPS); }
#pragma unroll
                for (int bj = 0; bj < 2; ++bj) { const f32x4 v0 = acc[ai][bj][m][0] * rs, v1 = acc[ai][bj][m][1] * rs;
                    u32x4 w; w.x = cvt_pk_bf16(v0[0], v0[1]); w.y = cvt_pk_bf16(v0[2], v0[3]); w.z = cvt_pk_bf16(v1[0], v1[1]); w.w = cvt_pk_bf16(v1[2], v1[3]);
                    *(u32x4*)(rowp + bj * HALF) = w; } }
    }
};
struct EpiInProj {
    static constexpr bool PERM = true, AFTER_DRAIN = false;
    bf16_t* O; int ldc; const float* ssq;
    __device__ __forceinline__ void operator()(const f32x4 (&acc)[2][2][4][2], const Unit& u, int wr, int wc, int fr, int fq) const {
        const int row0 = u.pm * BM + wr * 64 + fr;
        const bool glu = u.pn < 8;
        const int col0 = glu ? (u.pn * HALF + wc * 32 + 8 * fq) : (1024 + (u.pn - 8) * BM + wc * 32 + 8 * fq);
#pragma unroll
        for (int ai = 0; ai < 2; ++ai)
#pragma unroll
            for (int m = 0; m < 4; ++m) { bf16_t* rowp = O + (size_t)(row0 + ai * HALF + m * 16) * ldc + col0;
                float rs = 1.0f; if (ssq) { const f32x4* p = (const f32x4*)(ssq + (size_t)(row0 + ai * HALF + m * 16) * 8); const f32x4 a = p[0], b = p[1]; rs = 1.0f / sqrtf((((a[0] + a[1]) + (a[2] + a[3])) + ((b[0] + b[1]) + (b[2] + b[3]))) * NORM_INV_D + NORM_EPS); }
                if (glu) { float h[8];
#pragma unroll
                    for (int n = 0; n < 2; ++n)
#pragma unroll
                        for (int j = 0; j < 4; ++j) { const float v = acc[ai][0][m][n][j] * rs, g = acc[ai][1][m][n][j] * rs;
                            h[4 * n + j] = v * __builtin_amdgcn_rcpf(1.0f + __builtin_amdgcn_exp2f(-1.44269504089f * g)); }
                    u32x4 w; w.x = cvt_pk_bf16(h[0], h[1]); w.y = cvt_pk_bf16(h[2], h[3]); w.z = cvt_pk_bf16(h[4], h[5]); w.w = cvt_pk_bf16(h[6], h[7]);
                    *(u32x4*)rowp = w;
                } else {
#pragma unroll
                    for (int bj = 0; bj < 2; ++bj) { const f32x4 v0 = acc[ai][bj][m][0] * rs, v1 = acc[ai][bj][m][1] * rs;
                        u32x4 w; w.x = cvt_pk_bf16(v0[0], v0[1]); w.y = cvt_pk_bf16(v0[2], v0[3]); w.z = cvt_pk_bf16(v1[0], v1[1]); w.w = cvt_pk_bf16(v1[2], v1[3]);
                        *(u32x4*)(rowp + bj * HALF) = w; } } }
    }
};
struct EpiSwiGlu {
    static constexpr bool PERM = true, AFTER_DRAIN = false;
    bf16_t* O; int ldc;
    __device__ __forceinline__ void operator()(const f32x4 (&acc)[2][2][4][2], const Unit& u, int wr, int wc, int fr, int fq) const {
        const int row0 = u.pm * BM + wr * 64 + fr, col0 = u.pn * HALF + wc * 32 + 8 * fq;
#pragma unroll
        for (int ai = 0; ai < 2; ++ai)
#pragma unroll
            for (int m = 0; m < 4; ++m) { bf16_t* rowp = O + (size_t)(row0 + ai * HALF + m * 16) * ldc + col0;
                float h[8];
#pragma unroll
                for (int n = 0; n < 2; ++n)
#pragma unroll
                    for (int j = 0; j < 4; ++j) { const float g = acc[ai][0][m][n][j], v = acc[ai][1][m][n][j];
                        h[4 * n + j] = g * __builtin_amdgcn_rcpf(1.0f + __builtin_amdgcn_exp2f(-1.44269504089f * g)) * v; }
                u32x4 w; w.x = cvt_pk_bf16(h[0], h[1]); w.y = cvt_pk_bf16(h[2], h[3]); w.z = cvt_pk_bf16(h[4], h[5]); w.w = cvt_pk_bf16(h[6], h[7]);
                *(u32x4*)rowp = w; }
    }
};

__device__ __forceinline__ unsigned cvt4_fp8(float a, float b, float c, float d) { int w = 0; w = __builtin_amdgcn_cvt_pk_fp8_f32(a, b, w, false); w = __builtin_amdgcn_cvt_pk_fp8_f32(c, d, w, true); return (unsigned)w; }
struct EpiBf16S {
    static constexpr bool PERM = true, AFTER_DRAIN = false;
    bf16_t* O; int ldc; float sc;
    __device__ __forceinline__ void operator()(const f32x4 (&acc)[2][2][4][2], const Unit& u, int wr, int wc, int fr, int fq) const {
        const int row0 = u.pm * BM + wr * 64 + fr, col0 = u.pn * BM + wc * 32 + 8 * fq;
#pragma unroll
        for (int ai = 0; ai < 2; ++ai)
#pragma unroll
            for (int m = 0; m < 4; ++m) { bf16_t* rowp = O + (size_t)(row0 + ai * HALF + m * 16) * ldc + col0;
#pragma unroll
                for (int bj = 0; bj < 2; ++bj) { const f32x4 v0 = acc[ai][bj][m][0] * sc, v1 = acc[ai][bj][m][1] * sc;
                    u32x4 w; w.x = cvt_pk_bf16(v0[0], v0[1]); w.y = cvt_pk_bf16(v0[2], v0[3]); w.z = cvt_pk_bf16(v1[0], v1[1]); w.w = cvt_pk_bf16(v1[2], v1[3]);
                    *(u32x4*)(rowp + bj * HALF) = w; } }
    }
};
struct EpiSwiGlu8 {
    static constexpr bool PERM = true, AFTER_DRAIN = false;
    unsigned char* O; int ldc; float sc; const float* ssq;
    __device__ __forceinline__ void operator()(const f32x4 (&acc)[2][2][4][2], const Unit& u, int wr, int wc, int fr, int fq) const {
        const int row0 = u.pm * BM + wr * 64 + fr, col0 = u.pn * HALF + wc * 32 + 8 * fq;
#pragma unroll
        for (int ai = 0; ai < 2; ++ai)
#pragma unroll
            for (int m = 0; m < 4; ++m) { unsigned char* rowp = O + (size_t)(row0 + ai * HALF + m * 16) * ldc + col0;
                float rs = sc; if (ssq) { const f32x4* p = (const f32x4*)(ssq + (size_t)(row0 + ai * HALF + m * 16) * 8); const f32x4 a = p[0], b = p[1]; rs = sc / sqrtf((((a[0] + a[1]) + (a[2] + a[3])) + ((b[0] + b[1]) + (b[2] + b[3]))) * NORM_INV_D + NORM_EPS); }
                float h[8]; const float c1 = -1.44269504089f * rs, c2 = rs * rs;
#pragma unroll
                for (int n = 0; n < 2; ++n) { const f32x4 ag = acc[ai][0][m][n], av = acc[ai][1][m][n]; const f32x4 t = ag * c1; f32x4 e;
#pragma unroll
                    for (int j = 0; j < 4; ++j) e[j] = __builtin_amdgcn_exp2f(t[j]);
                    const f32x4 d = e + 1.0f; f32x4 r;
#pragma unroll
                    for (int j = 0; j < 4; ++j) r[j] = __builtin_amdgcn_rcpf(d[j]);
                    const f32x4 hq = (ag * av) * (r * c2);
#pragma unroll
                    for (int j = 0; j < 4; ++j) h[4 * n + j] = hq[j]; }
                u32x2 w; w.x = cvt4_fp8(h[0], h[1], h[2], h[3]); w.y = cvt4_fp8(h[4], h[5], h[6], h[7]);
                *(u32x2*)rowp = w; }
    }
};
struct EpiResF32 {
    static constexpr bool PERM = false, AFTER_DRAIN = false;
    const float* base; float* out; int ldc;
    __device__ __forceinline__ void operator()(const f32x4 (&acc)[2][2][4][2], const Unit& u, int wr, int wc, int fr, int fq) const {
        const int row0 = u.pm * BM + wr * 64 + fr, col0 = u.pn * BM + wc * 32 + 4 * fq;
#pragma unroll
        for (int ai = 0; ai < 2; ++ai)
#pragma unroll
            for (int m = 0; m < 4; ++m) { const size_t off = (size_t)(row0 + ai * HALF + m * 16) * ldc + col0;
#pragma unroll
                for (int bj = 0; bj < 2; ++bj)
#pragma unroll
                    for (int n = 0; n < 2; ++n) { const f32x4 bs = *(const f32x4*)(base + off + bj * HALF + n * 16); *(f32x4*)(out + off + bj * HALF + n * 16) = bs + acc[ai][bj][m][n]; }
                if (m == 3) asm volatile("" ::: "memory"); }
    }
};

struct EpiResNorm {
    static constexpr bool PERM = false, AFTER_DRAIN = false;
    const float* base; float* out; bf16_t* xb; float* ssq8; int ldc; float sc; PG8_LAS float* part;
    __device__ __forceinline__ void operator()(const f32x4 (&acc)[2][2][4][2], const Unit& u, int wr, int wc, int fr, int fq) const {
        const int row0 = u.pm * BM + wr * 64 + fr, col0 = u.pn * BM + wc * 32 + 4 * fq;
#pragma unroll
        for (int ai = 0; ai < 2; ++ai) {
            float q[4];
#pragma unroll
            for (int m = 0; m < 4; ++m) { const size_t off = (size_t)(row0 + ai * HALF + m * 16) * ldc + col0; q[m] = 0.f;
#pragma unroll
                for (int bj = 0; bj < 2; ++bj)
#pragma unroll
                    for (int n = 0; n < 2; ++n) { const f32x4 bs = *(const f32x4*)(base + off + bj * HALF + n * 16); const f32x4 v = bs + acc[ai][bj][m][n] * sc;
                        *(f32x4*)(out + off + bj * HALF + n * 16) = v; q[m] += (v[0] * v[0] + v[1] * v[1]) + (v[2] * v[2] + v[3] * v[3]);
                        u32x2 w; w.x = cvt_pk_bf16(v[0], v[1]); w.y = cvt_pk_bf16(v[2], v[3]); *(u32x2*)(xb + off + bj * HALF + n * 16) = w; } }
            asm volatile("" ::: "memory");
#pragma unroll
            for (int m = 0; m < 4; ++m) { float t = q[m]; t += __shfl_xor(t, 16); t += __shfl_xor(t, 32);
                if (fq == 0) part[(ai * HALF + wr * 64 + m * 16 + fr) * 4 + wc] = t; } }
        asm volatile("s_waitcnt lgkmcnt(0)" ::: "memory"); __builtin_amdgcn_s_barrier(); asm volatile("" ::: "memory");
        if (threadIdx.x < 256) { const PG8_LAS f32x4* p4 = (const PG8_LAS f32x4*)part + threadIdx.x; const f32x4 p = *p4;
            ssq8[(size_t)(u.pm * BM + threadIdx.x) * 8 + u.pn] = (p[0] + p[1]) + (p[2] + p[3]); }
    }
};
template <bool BASE_BF16> struct EpiResNormT {
    static constexpr bool PERM = false, AFTER_DRAIN = false;
    const void* base; bf16_t* xb; float* ssq8; int ldc; float sc; PG8_LAS float* part;
    __device__ __forceinline__ void operator()(const f32x4 (&acc)[2][2][4][2], const Unit& u, int wr, int wc, int fr, int fq) const {
        const int row0 = u.pm * BM + wr * 64 + fr, col0 = u.pn * BM + wc * 32 + 4 * fq;
        u32x2 bb[2][4][4];
        if constexpr (BASE_BF16) {
#pragma unroll
            for (int ai = 0; ai < 2; ++ai)
#pragma unroll
                for (int m = 0; m < 4; ++m)
#pragma unroll
                    for (int c = 0; c < 4; ++c) bb[ai][m][c] = *(const u32x2*)((const bf16_t*)base + (size_t)(row0 + ai * HALF + m * 16) * ldc + col0 + (c >> 1) * HALF + (c & 1) * 16);
            asm volatile("" ::: "memory"); }
#pragma unroll
        for (int ai = 0; ai < 2; ++ai) {
            float q[4];
#pragma unroll
            for (int m = 0; m < 4; ++m) { const size_t off = (size_t)(row0 + ai * HALF + m * 16) * ldc + col0; q[m] = 0.f;
#pragma unroll
                for (int bj = 0; bj < 2; ++bj)
#pragma unroll
                    for (int n = 0; n < 2; ++n) { f32x4 bs;
                        if constexpr (BASE_BF16) { const u32x2 b = bb[ai][m][bj * 2 + n];
                            bs[0] = __uint_as_float(b.x << 16); bs[1] = __uint_as_float(b.x & 0xffff0000u); bs[2] = __uint_as_float(b.y << 16); bs[3] = __uint_as_float(b.y & 0xffff0000u); }
                        else bs = *(const f32x4*)((const float*)base + off + bj * HALF + n * 16);
                        const f32x4 v = bs + acc[ai][bj][m][n] * sc;
                        u32x2 w; w.x = cvt_pk_bf16(v[0], v[1]); w.y = cvt_pk_bf16(v[2], v[3]); *(u32x2*)(xb + off + bj * HALF + n * 16) = w;
                        const float r0 = __uint_as_float(w.x << 16), r1 = __uint_as_float(w.x & 0xffff0000u), r2 = __uint_as_float(w.y << 16), r3 = __uint_as_float(w.y & 0xffff0000u);
                        q[m] += (r0 * r0 + r1 * r1) + (r2 * r2 + r3 * r3); } }
            asm volatile("" ::: "memory");
#pragma unroll
            for (int m = 0; m < 4; ++m) { float t = q[m]; t += __shfl_xor(t, 16); t += __shfl_xor(t, 32);
                if (fq == 0) part[(ai * HALF + wr * 64 + m * 16 + fr) * 4 + wc] = t; } }
        asm volatile("s_waitcnt lgkmcnt(0)" ::: "memory"); __builtin_amdgcn_s_barrier(); asm volatile("" ::: "memory");
        if (threadIdx.x < 256) { const PG8_LAS f32x4* p4 = (const PG8_LAS f32x4*)part + threadIdx.x; const f32x4 p = *p4;
            ssq8[(size_t)(u.pm * BM + threadIdx.x) * 8 + u.pn] = (p[0] + p[1]) + (p[2] + p[3]); }
    }
};
struct EpiResB16 {
    static constexpr bool PERM = false, AFTER_DRAIN = false;
    bf16_t* x; int ldc;
    __device__ __forceinline__ void operator()(const f32x4 (&acc)[2][2][4][2], const Unit& u, int wr, int wc, int fr, int fq) const {
        const int row0 = u.pm * BM + wr * 64 + fr, col0 = u.pn * BM + wc * 32 + 4 * fq;
        u32x2 bb[2][4][4];
#pragma unroll
        for (int ai = 0; ai < 2; ++ai)
#pragma unroll
            for (int m = 0; m < 4; ++m)
#pragma unroll
                for (int c = 0; c < 4; ++c) bb[ai][m][c] = *(const u32x2*)(x + (size_t)(row0 + ai * HALF + m * 16) * ldc + col0 + (c >> 1) * HALF + (c & 1) * 16);
        asm volatile("" ::: "memory");
#pragma unroll
        for (int ai = 0; ai < 2; ++ai)
#pragma unroll
            for (int m = 0; m < 4; ++m) { const size_t off = (size_t)(row0 + ai * HALF + m * 16) * ldc + col0;
#pragma unroll
                for (int bj = 0; bj < 2; ++bj)
#pragma unroll
                    for (int n = 0; n < 2; ++n) { u32x2* p = (u32x2*)(x + off + bj * HALF + n * 16); const u32x2 b = bb[ai][m][bj * 2 + n]; const f32x4 a = acc[ai][bj][m][n];
                        u32x2 w; w.x = cvt_pk_bf16(__uint_as_float(b.x << 16) + a[0], __uint_as_float(b.x & 0xffff0000u) + a[1]); w.y = cvt_pk_bf16(__uint_as_float(b.y << 16) + a[2], __uint_as_float(b.y & 0xffff0000u) + a[3]); *p = w; }
                if (m == 3) asm volatile("" ::: "memory"); }
    }
};
struct EpiResF32S {
    static constexpr bool PERM = false, AFTER_DRAIN = false;
    const float* base; float* out; int ldc; float sc;
    __device__ __forceinline__ void operator()(const f32x4 (&acc)[2][2][4][2], const Unit& u, int wr, int wc, int fr, int fq) const {
        const int row0 = u.pm * BM + wr * 64 + fr, col0 = u.pn * BM + wc * 32 + 4 * fq;
#pragma unroll
        for (int ai = 0; ai < 2; ++ai)
#pragma unroll
            for (int m = 0; m < 4; ++m) { const size_t off = (size_t)(row0 + ai * HALF + m * 16) * ldc + col0;
#pragma unroll
                for (int bj = 0; bj < 2; ++bj)
#pragma unroll
                    for (int n = 0; n < 2; ++n) { const f32x4 bs = *(const f32x4*)(base + off + bj * HALF + n * 16); *(f32x4*)(out + off + bj * HALF + n * 16) = bs + acc[ai][bj][m][n] * sc; }
                if (m == 3) asm volatile("" ::: "memory"); }
    }
};

template <class Epi, class Sched, bool ALIGN_EPI = false, bool SP2 = false, bool FP8 = false, int PV = 0, bool FP6 = false>
__device__ __forceinline__ void gemm_phase(PG8_LAS unsigned char* lds, const Gemm g, const Sched& S, const Epi& E) {
    const int tid = threadIdx.x, wid = __builtin_amdgcn_readfirstlane(tid >> 6), lane = tid & 63, wr = wid >> 2, wc = wid & 3, fr = lane & 15, fq = lane >> 4;
    const int K = g.K, nt = K / BK, LDA = g.lda ? g.lda : g.K;
    unsigned voffA[2], voffB[2];
#pragma unroll
    for (int i = 0; i < 2; ++i) { int R, C; stage_rc(tid * 16 + i * 8192, R, C); const int Rb = Epi::PERM ? ((R & ~31) + perm32(R & 31)) : R;
        voffA[i] = (unsigned)(R * LDA + C) * 2u; voffB[i] = (unsigned)(Rb * K + C) * 2u; }
    const size_t kstep = (size_t)(BK * 2);
    const size_t hstep = (size_t)HALF * K * 2;
    const size_t tstep = 2 * hstep;
    const size_t hstepA = (size_t)HALF * LDA * 2, tstepA = 2 * hstepA;
    const unsigned ldsw = (unsigned)wid * 1024u;
    const int aoff = lds_byte(wr * 64 + fr, fq * 8), boff = lds_byte(wc * 32 + fr, fq * 8);
    const unsigned abase6 = (unsigned)(unsigned long)(lds + aoff), bbase6 = (unsigned)(unsigned long)(lds + 4 * HTB + boff);
#define PG8_SA(b, h) (((b) * 2 + (h)) * HTB)
#define PG8_SB(b, h) ((4 + (b) * 2 + (h)) * HTB)
#define PG8_STAGE(bufoff, gbase, voff) do { if constexpr (PV != 2) _Pragma("unroll") for (int _i = 0; _i < 2; ++_i) \
        __builtin_amdgcn_global_load_lds((const unsigned*)((const char*)(gbase) + (voff)[_i]), (PG8_LAS unsigned*)(lds + (bufoff) + ldsw + _i * 8192), 16, 0, 0); } while (0)
#define PG8_LDA(dst, b, h) do { if constexpr (PV == 3) {} else if constexpr (FP6) { _Pragma("unroll") for (int m = 0; m < 4; ++m) { v4i lo_; v2i hi_; \
            asm volatile("ds_read_b128 %0, %2 offset:%3\n\tds_read_b64 %1, %2 offset:%4" : "=&v"(lo_), "=&v"(hi_) : "v"(abase6), "n"(PG8_SA(b, h) + m * 2048), "n"(PG8_SA(b, h) + m * 2048 + 1024)); \
            dst##6[m] = __builtin_shufflevector(lo_, __builtin_shufflevector(hi_, hi_, 0, 1, -1, -1), 0, 1, 2, 3, 4, 5); } } \
        else if constexpr (FP8) { _Pragma("unroll") for (int m = 0; m < 4; ++m) { dst##8[m].lo = *(const PG8_LAS v4i*)(lds + PG8_SA(b, h) + aoff + m * 2048); dst##8[m].hi = *(const PG8_LAS v4i*)(lds + PG8_SA(b, h) + aoff + m * 2048 + 1024); } } \
        else { _Pragma("unroll") for (int m = 0; m < 4; ++m) _Pragma("unroll") for (int k = 0; k < 2; ++k) dst[m][k] = *(const PG8_LAS bf16x8*)(lds + PG8_SA(b, h) + aoff + m * 2048 + k * 1024); } } while (0)
#define PG8_LDB(dst, b, h) do { if constexpr (PV == 3) {} else if constexpr (FP6) { _Pragma("unroll") for (int n = 0; n < 2; ++n) { v4i lo_; v2i hi_; \
            asm volatile("ds_read_b128 %0, %2 offset:%3\n\tds_read_b64 %1, %2 offset:%4" : "=&v"(lo_), "=&v"(hi_) : "v"(bbase6), "n"(PG8_SB(b, h) - 4 * HTB + n * 2048), "n"(PG8_SB(b, h) - 4 * HTB + n * 2048 + 1024)); \
            dst##6[n] = __builtin_shufflevector(lo_, __builtin_shufflevector(hi_, hi_, 0, 1, -1, -1), 0, 1, 2, 3, 4, 5); } } \
        else if constexpr (FP8) { _Pragma("unroll") for (int n = 0; n < 2; ++n) { dst##8[n].lo = *(const PG8_LAS v4i*)(lds + PG8_SB(b, h) + boff + n * 2048); dst##8[n].hi = *(const PG8_LAS v4i*)(lds + PG8_SB(b, h) + boff + n * 2048 + 1024); } } \
        else { _Pragma("unroll") for (int n = 0; n < 2; ++n) _Pragma("unroll") for (int k = 0; k < 2; ++k) dst[n][k] = *(const PG8_LAS bf16x8*)(lds + PG8_SB(b, h) + boff + n * 2048 + k * 1024); } } while (0)
#define PG8_MMA(ai, bj, At, Bt) do { __builtin_amdgcn_s_setprio(1); \
        if constexpr (PV == 1) { _Pragma("unroll") for (int m = 0; m < 4; ++m) _Pragma("unroll") for (int k = 0; k < 2; ++k) asm volatile("" :: "v"(At[m][k])); _Pragma("unroll") for (int n = 0; n < 2; ++n) _Pragma("unroll") for (int k = 0; k < 2; ++k) asm volatile("" :: "v"(Bt[n][k])); } \
        else if constexpr (FP6) { _Pragma("unroll") for (int m = 0; m < 4; ++m) _Pragma("unroll") for (int n = 0; n < 2; ++n) \
            asm volatile("v_mfma_scale_f32_16x16x128_f8f6f4 %0, %1, %2, %0, %3, %3 op_sel_hi:[0,0,0] cbsz:2 blgp:2" : "+v"(acc[ai][bj][m][n]) : "v"(Bt##6[n]), "v"(At##6[m]), "v"(sc1)); } \
        else if constexpr (FP8) { _Pragma("unroll") for (int m = 0; m < 4; ++m) _Pragma("unroll") for (int n = 0; n < 2; ++n) \
            asm volatile("v_mfma_scale_f32_16x16x128_f8f6f4 %0, %1, %2, %0, %3, %3 op_sel_hi:[0,0,0]" : "+v"(acc[ai][bj][m][n]) : "v"(Bt##8[n]), "v"(At##8[m]), "v"(sc1)); } \
        else { _Pragma("unroll") for (int m = 0; m < 4; ++m) _Pragma("unroll") for (int n = 0; n < 2; ++n) _Pragma("unroll") for (int k = 0; k < 2; ++k) \
            acc[ai][bj][m][n] = __builtin_amdgcn_mfma_f32_16x16x32_bf16(Bt[n][k], At[m][k], acc[ai][bj][m][n], 0, 0, 0); } \
        __builtin_amdgcn_s_setprio(0); } while (0)
#define PG8_WAIT_V(n) asm volatile("s_waitcnt vmcnt(" #n ")" ::: "memory")
#define PG8_WAIT_L(n) asm volatile("s_waitcnt lgkmcnt(" #n ")" ::: "memory")
#define PG8_BAR __builtin_amdgcn_s_barrier()
#define PG8_SCHED __builtin_amdgcn_sched_barrier(0)
    Unit cur, nxt; int ui = 0;
    if (!S.next(0, cur)) return;
    f32x4 acc[2][2][4][2];
#pragma unroll
    for (int a = 0; a < 2; ++a)
#pragma unroll
        for (int b = 0; b < 2; ++b)
#pragma unroll
            for (int m = 0; m < 4; ++m)
#pragma unroll
                for (int n = 0; n < 2; ++n) acc[a][b][m][n] = (f32x4){0.f, 0.f, 0.f, 0.f};
    const int sc1 = 0x7f7f7f7f;
    bf16x8 At[4][2], B0[2][2], B1[2][2];
    v8i At8[4], B08[2], B18[2];
    v6i At6[4], B06[2], B16[2];
    if constexpr (PV == 3) {
#pragma unroll
        for (int m = 0; m < 4; ++m)
#pragma unroll
            for (int k = 0; k < 2; ++k) At[m][k] = (bf16x8){0, 0, 0, 0, 0, 0, 0, 0};
#pragma unroll
        for (int n = 0; n < 2; ++n)
#pragma unroll
            for (int k = 0; k < 2; ++k) { B0[n][k] = (bf16x8){0, 0, 0, 0, 0, 0, 0, 0}; B1[n][k] = B0[n][k]; } }
    const char* cA = (const char*)g.A + (size_t)S.a_tile(cur) * tstepA; const char* cB = (const char*)g.Bt + S.b_off(cur) + (size_t)cur.pn * tstep;
    S.a_ready(cur);
    if constexpr (SP2) {
        PG8_STAGE(PG8_SB(0, 0), cB, voffB); PG8_STAGE(PG8_SB(0, 1), cB + hstep, voffB); PG8_STAGE(PG8_SA(0, 0), cA, voffA); PG8_STAGE(PG8_SA(0, 1), cA + hstepA, voffA);
        if (wr == 1) PG8_BAR;
        PG8_WAIT_V(2); PG8_BAR;
        PG8_STAGE(PG8_SB(1, 0), cB + kstep, voffB); PG8_STAGE(PG8_SA(1, 0), cA + kstep, voffA); PG8_STAGE(PG8_SB(1, 1), cB + hstep + kstep, voffB);
        PG8_WAIT_V(6); PG8_BAR;
    } else {
        PG8_STAGE(PG8_SB(0, 0), cB, voffB); PG8_STAGE(PG8_SA(0, 0), cA, voffA); PG8_STAGE(PG8_SB(0, 1), cB + hstep, voffB); PG8_STAGE(PG8_SA(0, 1), cA + hstepA, voffA);
        if (wr == 1) PG8_BAR;
        PG8_WAIT_V(4); PG8_BAR;
        PG8_STAGE(PG8_SB(1, 0), cB + kstep, voffB); PG8_STAGE(PG8_SA(1, 0), cA + kstep, voffA); PG8_STAGE(PG8_SB(1, 1), cB + hstep + kstep, voffB);
        PG8_WAIT_V(6); PG8_BAR;
    }
    for (;;) {
        const bool has_next = S.next(ui + 1, nxt);
        const char* nA = has_next ? (const char*)g.A + (size_t)S.a_tile(nxt) * tstepA : cA; const char* nB = has_next ? (const char*)g.Bt + S.b_off(nxt) + (size_t)nxt.pn * tstep : cB;
        for (int t = 0; t < nt; t += 2) {
            const bool last = (t == nt - 2);
            const char* a1 = cA + (size_t)(t + 1) * kstep;
            const char* a2 = last ? nA : cA + (size_t)(t + 2) * kstep; const char* b2 = last ? nB : cB + (size_t)(t + 2) * kstep;
            const char* a3 = a2 + kstep; const char* b3 = b2 + kstep;
            if (last && has_next) S.a_ready(nxt);
            if constexpr (SP2) {
            PG8_LDB(B0, 0, 0); PG8_LDB(B1, 0, 1); PG8_SCHED; PG8_LDA(At, 0, 0); PG8_STAGE(PG8_SA(1, 1), a1 + hstepA, voffA);
            PG8_WAIT_V(8); PG8_WAIT_L(0); PG8_BAR; PG8_MMA(0, 0, At, B0); PG8_MMA(0, 1, At, B1); PG8_BAR; PG8_SCHED;
            PG8_LDA(At, 0, 1); PG8_STAGE(PG8_SB(0, 0), b2, voffB); PG8_STAGE(PG8_SB(0, 1), b2 + hstep, voffB); PG8_STAGE(PG8_SA(0, 0), a2, voffA);
            PG8_WAIT_V(8); PG8_WAIT_L(0); PG8_BAR; PG8_MMA(1, 0, At, B0); PG8_MMA(1, 1, At, B1); PG8_BAR; PG8_SCHED;
            PG8_LDB(B0, 1, 0); PG8_LDB(B1, 1, 1); PG8_SCHED; PG8_LDA(At, 1, 0); PG8_STAGE(PG8_SA(0, 1), a2 + hstepA, voffA);
            PG8_WAIT_V(8); PG8_WAIT_L(0); PG8_BAR; PG8_MMA(0, 0, At, B0); PG8_MMA(0, 1, At, B1); PG8_BAR; PG8_SCHED;
            PG8_LDA(At, 1, 1); PG8_STAGE(PG8_SB(1, 0), b3, voffB); PG8_STAGE(PG8_SB(1, 1), b3 + hstep, voffB); PG8_STAGE(PG8_SA(1, 0), a3, voffA);
            PG8_WAIT_V(8); PG8_WAIT_L(0); PG8_BAR; PG8_MMA(1, 0, At, B0); PG8_MMA(1, 1, At, B1); PG8_BAR; PG8_SCHED;
            } else {
            PG8_LDB(B0, 0, 0); PG8_SCHED; PG8_LDA(At, 0, 0); PG8_STAGE(PG8_SA(1, 1), a1 + hstepA, voffA);
            PG8_WAIT_L(8); PG8_BAR; PG8_WAIT_L(0); PG8_MMA(0, 0, At, B0); PG8_BAR; PG8_SCHED;
            PG8_LDB(B1, 0, 1); PG8_STAGE(PG8_SB(0, 0), b2, voffB);
            PG8_BAR; PG8_WAIT_L(0); PG8_MMA(0, 1, At, B1); PG8_BAR;
            PG8_LDA(At, 0, 1); PG8_STAGE(PG8_SA(0, 0), a2, voffA);
            PG8_BAR; PG8_WAIT_L(0); PG8_MMA(1, 0, At, B0); PG8_BAR; PG8_SCHED;
            PG8_STAGE(PG8_SB(0, 1), b2 + hstep, voffB);
            PG8_WAIT_V(6); PG8_BAR; PG8_MMA(1, 1, At, B1); PG8_BAR;
            PG8_LDB(B0, 1, 0); PG8_SCHED; PG8_LDA(At, 1, 0); PG8_STAGE(PG8_SA(0, 1), a2 + hstepA, voffA);
            PG8_WAIT_L(8); PG8_BAR; PG8_WAIT_L(0); PG8_MMA(0, 0, At, B0); PG8_BAR; PG8_SCHED;
            PG8_LDB(B1, 1, 1); PG8_STAGE(PG8_SB(1, 0), b3, voffB);
            PG8_BAR; PG8_WAIT_L(0); PG8_MMA(0, 1, At, B1); PG8_BAR;
            PG8_LDA(At, 1, 1); PG8_STAGE(PG8_SA(1, 0), a3, voffA);
            PG8_BAR; PG8_WAIT_L(0); PG8_MMA(1, 0, At, B0); PG8_BAR; PG8_SCHED;
            PG8_STAGE(PG8_SB(1, 1), b3 + hstep, voffB);
            PG8_WAIT_V(6); PG8_BAR; PG8_MMA(1, 1, At, B1); PG8_BAR;
            }
        }
        if constexpr (ALIGN_EPI) { if (wr == 0) PG8_BAR; }
        if constexpr (FP8) asm volatile("s_nop 15\n\ts_nop 15" ::: "memory");
        if constexpr (PV == 0) { if (!cur.skip_epi) { E(acc, cur, wr, wc, fr, fq); } } else { asm volatile("" :: "v"(acc[0][0][0][0]), "v"(acc[1][1][3][1])); } S.done(cur);
        if (!has_next) break;
#pragma unroll
        for (int a = 0; a < 2; ++a)
#pragma unroll
            for (int b = 0; b < 2; ++b)
#pragma unroll
                for (int m = 0; m < 4; ++m)
#pragma unroll
                    for (int n = 0; n < 2; ++n) acc[a][b][m][n] = (f32x4){0.f, 0.f, 0.f, 0.f};
        cur = nxt; cA = nA; cB = nB; ++ui;
        if constexpr (ALIGN_EPI) { if (wr == 1) PG8_BAR; }
    }
    PG8_WAIT_V(0);
    if constexpr (!ALIGN_EPI) { if (wr == 0) PG8_BAR; }
    PG8_BAR;
#undef PG8_SA
#undef PG8_SB
#undef PG8_STAGE
#undef PG8_LDA
#undef PG8_LDB
#undef PG8_MMA
#undef PG8_WAIT_V
#undef PG8_WAIT_L
#undef PG8_BAR
#undef PG8_SCHED
}
}

constexpr int NWAVES = 8, NTHR = NWAVES * 64;
constexpr int D = 2048, BATCH = 2, SEQ = 8192, T = BATCH * SEQ, DEPTH = 2;
constexpr int CW = 1024, LW = 1024, LH = 8, LHD = 128, DIN = 4096, CK = 31, LK = 4;
constexpr int UW = 3 * 1024;
constexpr int DFF = 6144, NE = 8;
constexpr float EPS = 1e-6f, LRU_C = 8.0f;
constexpr int MOE_ROWS_MAX = T * 2 + NE * 256;
constexpr float MOE_SC_A = 2.0f;
constexpr float MOE_SC_GU = 64.0f, MOE_SC_D = 128.0f;

constexpr size_t MiB = 1u << 20;
constexpr size_t WS_CTL = 0, CTL_ZERO_BYTES = 1 * MiB;
constexpr size_t WS_WIN = 2 * MiB;
constexpr size_t WS_WOUT = 34 * MiB;
constexpr size_t WS_WGATE = 50 * MiB;
constexpr size_t WS_DWGU = 52 * MiB;
constexpr size_t WS_DWD = 100 * MiB;
constexpr size_t WS_MWGU = 124 * MiB;
constexpr size_t WS_MWD = 316 * MiB;
constexpr size_t WS_X = 700 * MiB;
constexpr size_t WS_H = 828 * MiB;
constexpr size_t WS_ROUTE = 892 * MiB;
constexpr size_t WS_POS = WS_ROUTE + 512 * 1024;
constexpr size_t WS_HAGG = 893 * MiB;
constexpr size_t WS_CAGG = 894 * MiB;
constexpr size_t WS_SSQA = 895 * MiB, WS_SSQB = 895 * MiB + 512 * 1024;
constexpr size_t WS_XG8 = 412 * MiB;
constexpr size_t WS_YB = 896 * MiB;
constexpr size_t WS_XG = WS_YB;
constexpr size_t WS_BIG = 1032 * MiB;
constexpr size_t WS_U = WS_BIG;
constexpr size_t WS_Y = WS_BIG + 128 * MiB;
constexpr size_t WS_P1 = WS_BIG + 192 * MiB;
constexpr size_t WS_P2 = WS_BIG + 224 * MiB;
constexpr size_t WS_HID = WS_BIG;
constexpr size_t WS_END = 1440 * MiB;
constexpr size_t WS_NCONV = WS_XG;
constexpr size_t WS_NRX = WS_XG + 64 * MiB;
constexpr size_t WS_NA = WS_BIG + 256 * MiB;
constexpr size_t WS_NB = WS_BIG + 320 * MiB;
static_assert(WS_NB + 64 * MiB <= WS_END && WS_XG8 + (size_t)NE * T * (D + 128) <= WS_X, "ws map");
constexpr int CW_TMO = 0, CW_CODE = 1;
constexpr int CW_BAR = 4096;
constexpr int CW_CNT = 8192;
constexpr int CW_CUR = 8192 + 1024;
constexpr int CW_XRANK = 8192 + 2048;

constexpr int RING_OFF = 0, RING_BYTES = 131072;
constexpr int LDS_BYTES = 147456;
constexpr int LDSCTL_OFF = LDS_BYTES - 512, MISC_OFF = LDSCTL_OFF + 64;
constexpr int MX_PITCH = 1040, MX_RX = 0, MX_GG = 64 * MX_PITCH, MX_RED = 2 * 64 * MX_PITCH, MX_MR = MX_RED + 2048;
static_assert(MX_MR + 256 <= LDSCTL_OFF, "mixer LDS map");

#define GAS __attribute__((address_space(1)))
#define LAS __attribute__((address_space(3)))
typedef unsigned short bf16;
typedef unsigned v4u __attribute__((ext_vector_type(4)));
typedef unsigned v2u __attribute__((ext_vector_type(2)));
typedef float f32x4 __attribute__((ext_vector_type(4)));
typedef float f32x2 __attribute__((ext_vector_type(2)));
typedef short bf16x8 __attribute__((ext_vector_type(8)));
typedef GAS unsigned gu32;
#define RLX_AGENT __ATOMIC_RELAXED, __HIP_MEMORY_SCOPE_AGENT
#define LDS_WAIT() asm volatile("s_waitcnt lgkmcnt(0)" ::: "memory")
#define VM_WAIT() asm volatile("s_waitcnt vmcnt(0)" ::: "memory")
__device__ __forceinline__ unsigned f2bf(float f) { unsigned u = __builtin_bit_cast(unsigned, f); return (u + 0x7fffu + ((u >> 16) & 1u)) >> 16; }
__device__ __forceinline__ unsigned pk2(float lo, float hi) { unsigned r; asm("v_cvt_pk_bf16_f32 %0, %1, %2" : "=v"(r) : "v"(lo), "v"(hi)); return r; }
__device__ __forceinline__ float bf_lo(unsigned w) { return __uint_as_float(w << 16); }
__device__ __forceinline__ float bf_hi(unsigned w) { return __uint_as_float(w & 0xffff0000u); }
__device__ __forceinline__ float bf2f(bf16 b) { return __uint_as_float(((unsigned)b) << 16); }
__device__ __forceinline__ float sigmoidf_(float x) { return __builtin_amdgcn_rcpf(1.0f + __builtin_amdgcn_exp2f(-1.44269504089f * x)); }
__device__ __forceinline__ float gelu_tanh(float x) { const float u = 0.7978845608f * (x + 0.044715f * x * x * x); return x * sigmoidf_(2.0f * u); }

#define XB_TMO      128
#define XB_XCNT(j)  (256  + 64 * (j))
#define XB_XSUB(j)  (1280 + 64 * (j))
#define XB_XGEN(j)  (2304 + 64 * (j))
#define XB_TOP      3328
#define XB_TOPGEN   3392
#define XCD_BAR_WORDS 3456
#define XB_SPIN_CAP (1u << 18)
__device__ __forceinline__ unsigned xb_ld(unsigned* p)              { return __hip_atomic_load(p, __ATOMIC_RELAXED, __HIP_MEMORY_SCOPE_AGENT); }
__device__ __forceinline__ unsigned xb_add(unsigned* p, unsigned v) { return __hip_atomic_fetch_add(p, v, __ATOMIC_RELAXED, __HIP_MEMORY_SCOPE_AGENT); }
__device__ __forceinline__ unsigned xb_xcc_id() { return (unsigned)__builtin_amdgcn_s_getreg((3 << 11) | 20) & 0xFu; }
#define XB_SPIN(cond, bar) do { unsigned _sp = 0; while (cond) { __builtin_amdgcn_s_sleep(1); \
    if ((++_sp & 255u) == 0u) { if (xb_ld(&(bar)[XB_TMO])) break; if (_sp > XB_SPIN_CAP) { atomicAdd(&(bar)[XB_TMO], 1u); break; } } } } while (0)
struct XcdBarrier { unsigned* bar; unsigned x; volatile LAS unsigned* st; };
__device__ __forceinline__ XcdBarrier xcd_barrier_post(unsigned* bar, volatile LAS unsigned* st) {
    XcdBarrier b; b.bar = bar; b.x = xb_xcc_id(); b.st = st;
    if (threadIdx.x == 0) (void)xb_add(&bar[XB_XCNT(b.x)], 1u);
    return b;
}
__device__ __forceinline__ void xcd_barrier_complete(unsigned* bar, unsigned x, unsigned& nloc, unsigned& nx) {
    const unsigned G = gridDim.x * gridDim.y * gridDim.z;
    unsigned sum, cnt, mine, sp = 0u;
    for (;;) {
        sum = 0u; cnt = 0u; mine = 0u;
#pragma unroll
        for (unsigned j = 0; j < 16; ++j) { const unsigned c = xb_ld(&bar[XB_XCNT(j)]); sum += c; cnt += (c > 0u) ? 1u : 0u; mine = (j == x) ? c : mine; }
        if (sum == G) break;
        __builtin_amdgcn_s_sleep(1);
        if ((++sp & 255u) == 0u) { if (xb_ld(&bar[XB_TMO])) break; if (sp > XB_SPIN_CAP) { atomicAdd(&bar[XB_TMO], 1u); break; } }
    }
    nloc = mine > 0u ? mine : 1u; nx = cnt > 0u ? cnt : 1u;
}
__device__ __forceinline__ void xcd_barrier(const XcdBarrier& b) {
    asm volatile("s_waitcnt vmcnt(0)" ::: "memory");
    __syncthreads();
    if (threadIdx.x == 0) {
        unsigned* bar = b.bar;
        __builtin_amdgcn_s_waitcnt(0);
        unsigned nloc = b.st[0], nx = b.st[1];
        if (nloc == 0u) { xcd_barrier_complete(bar, b.x, nloc, nx); b.st[0] = nloc; b.st[1] = nx; }
        const unsigned old = xb_add(&bar[XB_XSUB(b.x)], 1u);
        const unsigned gen = old / nloc;
        if (old + 1u == (gen + 1u) * nloc) {
            __builtin_amdgcn_fence(__ATOMIC_RELEASE, "agent");
            asm volatile("s_waitcnt vmcnt(0)" ::: "memory");
            const unsigned og = xb_add(&bar[XB_TOP], 1u);
            const unsigned tg = og / nx;
            if (og + 1u == (tg + 1u) * nx) xb_add(&bar[XB_TOPGEN], 1u);
            else XB_SPIN(xb_ld(&bar[XB_TOPGEN]) == tg, bar);
            __builtin_amdgcn_fence(__ATOMIC_ACQUIRE, "agent");
            xb_add(&bar[XB_XGEN(b.x)], 1u);
            asm volatile("s_waitcnt vmcnt(0)" ::: "memory");
        } else {
            XB_SPIN(xb_ld(&bar[XB_XGEN(b.x)]) == gen, bar);
            __builtin_amdgcn_fence(__ATOMIC_ACQUIRE, "agent");
            asm volatile("s_waitcnt vmcnt(0)" ::: "memory");
        }
    }
    __syncthreads();
}

__device__ __forceinline__ float wave_sum(float v) {
#pragma unroll
    for (int o = 1; o < 64; o <<= 1) v += __shfl_xor(v, o);
    return v;
}

constexpr int CW_ = 1024;
__device__ __forceinline__ void tr_item(const float* __restrict__ W, int K, int N, bf16* WT, int mode, int item, LAS unsigned* scr, int lane, const float* kgain = nullptr) {
    const int nblk = N >> 6, kb = item / nblk, nb = item - kb * nblk, k0 = kb << 6, n0 = nb << 6;
    const int q = lane & 15, r = lane >> 4;
    f32x4 A[8], B[8];
#pragma unroll
    for (int i = 0; i < 8; ++i) { const float* p = W + (size_t)(k0 + 2 * (4 * i + r)) * N + n0 + 4 * q; A[i] = __builtin_nontemporal_load((const GAS f32x4*)p); B[i] = __builtin_nontemporal_load((const GAS f32x4*)(p + N)); }
    if (kgain) {
#pragma unroll
        for (int i = 0; i < 8; ++i) { const f32x2 g2 = *(const GAS f32x2*)(kgain + k0 + 2 * (4 * i + r)); A[i] *= g2.x; B[i] *= g2.y; } }
#pragma unroll
    for (int i = 0; i < 8; ++i)
#pragma unroll
        for (int j = 0; j < 4; ++j) scr[(4 * q + j) * 32 + ((4 * i + r) ^ (4 * (q & 7)))] = pk2(A[i][j], B[i][j]);
    LDS_WAIT(); asm volatile("" ::: "memory");
    const int c = lane & 7;
#pragma unroll
    for (int jj = 0; jj < 8; ++jj) { const int n = (lane >> 3) + 8 * jj; const v4u o = *(const LAS v4u*)(scr + n * 32 + 4 * (c ^ ((n >> 2) & 7)));
        const int ng = n0 + n; int row = mode == 0 ? ng : ((ng >> 7) * 256 + (ng & 127) + (mode == 2 ? 128 : 0));
        if (mode == 3) row = ng >= 2 * CW_ ? ng : (ng < CW_ ? ((ng >> 7) * 256 + (ng & 127)) : ((((ng - CW_) >> 7) * 256) + 128 + ((ng - CW_) & 127)));
        *(GAS v4u*)(WT + (size_t)row * K + k0 + 8 * c) = o; }
    LDS_WAIT(); asm volatile("" ::: "memory");
}


__device__ __forceinline__ unsigned cvt4_fp8(float a, float b, float c, float d) { int w = 0; w = __builtin_amdgcn_cvt_pk_fp8_f32(a, b, w, false); w = __builtin_amdgcn_cvt_pk_fp8_f32(c, d, w, true); return (unsigned)w; }
__device__ __forceinline__ void tr_item8(const float* __restrict__ W, int K, int N, unsigned char* WT, int mode, int item, LAS unsigned* scr, int lane, float sc) {
    const int nblk = N >> 5, kb = item / nblk, nb = item - kb * nblk, k0 = kb << 7, n0 = nb << 5;
    const int q = lane & 7, r = lane >> 3;
#pragma unroll
    for (int i = 0; i < 4; ++i) { const int p = 8 * i + r; const float* src = W + (size_t)(k0 + 4 * p) * N + n0 + 4 * q;
        const f32x4 R0 = __builtin_nontemporal_load((const GAS f32x4*)src), R1 = __builtin_nontemporal_load((const GAS f32x4*)(src + N)), R2 = __builtin_nontemporal_load((const GAS f32x4*)(src + 2 * (size_t)N)), R3 = __builtin_nontemporal_load((const GAS f32x4*)(src + 3 * (size_t)N));
#pragma unroll
        for (int j = 0; j < 4; ++j) scr[(4 * q + j) * 32 + (p ^ (4 * q))] = cvt4_fp8(R0[j] * sc, R1[j] * sc, R2[j] * sc, R3[j] * sc); }
    LDS_WAIT(); asm volatile("" ::: "memory");
    const int c = lane & 7;
#pragma unroll
    for (int jj = 0; jj < 4; ++jj) { const int n = (lane >> 3) + 8 * jj; const v4u o = *(const LAS v4u*)(scr + n * 32 + 4 * (c ^ ((n >> 2) & 7)));
        const int ng = n0 + n; const int row = mode == 0 ? ng : ((ng >> 7) * 256 + (ng & 127) + (mode == 2 ? 128 : 0));
        *(GAS v4u*)(WT + (size_t)row * K + k0 + 16 * c) = o; }
    LDS_WAIT(); asm volatile("" ::: "memory");
}

__device__ __forceinline__ void row_to_bf16_ssq(const float* xrow, bf16* orow, float* ssq8row, int lane) {
    const GAS f32x4* xr = (const GAS f32x4*)xrow + lane;
    f32x4 v[8]; float s = 0.f;
#pragma unroll
    for (int j = 0; j < 8; ++j) v[j] = xr[64 * j];
    GAS v2u* o8 = (GAS v2u*)orow + lane;
#pragma unroll
    for (int j = 0; j < 8; ++j) { v2u o; o.x = pk2(v[j].x, v[j].y); o.y = pk2(v[j].z, v[j].w); o8[64 * j] = o;
        const float r0 = bf_lo(o.x), r1 = bf_hi(o.x), r2 = bf_lo(o.y), r3 = bf_hi(o.y); s += (r0 * r0 + r1 * r1) + (r2 * r2 + r3 * r3); }
    s = wave_sum(s);
    if (lane < 2) ((GAS f32x4*)ssq8row)[lane] = (f32x4){lane == 0 ? s : 0.f, 0.f, 0.f, 0.f};
}
__device__ __forceinline__ void rms_row_to_bf16(const float* xrow, const float* gain, bf16* orow, int lane) {
    const GAS f32x4* xr = (const GAS f32x4*)xrow + lane; const GAS f32x4* gr = (const GAS f32x4*)gain + lane;
    f32x4 v[8]; float s = 0.f;
#pragma unroll
    for (int j = 0; j < 8; ++j) { v[j] = xr[64 * j]; s += (v[j].x * v[j].x + v[j].y * v[j].y) + (v[j].z * v[j].z + v[j].w * v[j].w); }
    const float rstd = 1.0f / sqrtf(wave_sum(s) * (1.0f / D) + EPS);
    GAS v2u* o8 = (GAS v2u*)orow + lane;
#pragma unroll
    for (int j = 0; j < 8; ++j) { const f32x4 g = gr[64 * j]; v2u o; o.x = pk2(v[j].x * rstd * g.x, v[j].y * rstd * g.y); o.y = pk2(v[j].z * rstd * g.z, v[j].w * rstd * g.w); o8[64 * j] = o; }
}


__device__ __forceinline__ float transpose_reduce64(float (&v)[64], int lane) {
#pragma unroll
    for (int d = 32; d >= 1; d >>= 1) {
        const bool up = (lane & d) != 0;
#pragma unroll
        for (int i = 0; i < d; ++i) { float x = v[i], y = v[i + d]; asm volatile("" : "+v"(x), "+v"(y));
            const float keep = up ? y : x; const float send = up ? x : y; v[i] = keep + __shfl_xor(send, d); }
    }
    return v[0];
}

__device__ __forceinline__ float transpose_reduce32(float (&v)[32], int lane) {
#pragma unroll
    for (int i = 0; i < 32; ++i) v[i] += __shfl_xor(v[i], 32);
#pragma unroll
    for (int d = 16; d >= 1; d >>= 1) {
        const bool up = (lane & d) != 0;
#pragma unroll
        for (int i = 0; i < d; ++i) { float x = v[i], y = v[i + d]; asm volatile("" : "+v"(x), "+v"(y));
            const float keep = up ? y : x; const float send = up ? x : y; v[i] = keep + __shfl_xor(send, d); }
    }
    return v[0];
}

__device__ __forceinline__ void conv_unit(const bf16* U, bf16* Y, const float* conv_w, const float* conv_b, const float* lng, const float* lnb, int tile, LAS unsigned char* lds, int tid, int lane, int wave) {
    LAS float* red = (LAS float*)(lds + MX_RED);
    LAS float* mr = (LAS float*)(lds + MX_MR);
    const int r0 = tile * 64, tl0 = r0 & (SEQ - 1), c0 = 2 * tid;
    for (int chunk = 0; chunk < 2; ++chunk) {
        const int rb = r0 + 32 * chunk; const bool head = (tl0 + 32 * chunk) == 0;
        f32x2 w[CK];
#pragma unroll
        for (int k = 0; k < CK; ++k) w[k] = *(const GAS f32x2*)(conv_w + k * CW + c0);
        const f32x2 bias = *(const GAS f32x2*)(conv_b + c0);
        f32x2 acc[32];
#pragma unroll
        for (int o = 0; o < 32; ++o) acc[o] = bias;
        const GAS unsigned* up = (const GAS unsigned*)(U + (size_t)rb * UW + c0);
        unsigned vb[2][4];
#pragma unroll
        for (int jj = 0; jj < 4; ++jj) { const long ro = head ? 0 : (long)(jj - 30); vb[0][jj] = up[ro * (UW / 2)]; }
#pragma unroll
        for (int jb = 0; jb < 16; ++jb) {
            if (jb < 15) {
#pragma unroll
                for (int jj = 0; jj < 4; ++jj) { const int j = 4 * (jb + 1) + jj; if (j < 62) { const long ro = (head && j < 30) ? 0 : (long)(j - 30); vb[(jb + 1) & 1][jj] = up[ro * (UW / 2)]; } } }
            const unsigned (&vv)[4] = vb[jb & 1];
#pragma unroll
            for (int jj = 0; jj < 4; ++jj) { const int j = 4 * jb + jj; if (j < 62) {
                f32x2 glu; glu.x = bf_lo(vv[jj]); glu.y = bf_hi(vv[jj]);
                if (head && j < 30) glu = (f32x2){0.f, 0.f};
#pragma unroll
                for (int o = 0; o < 32; ++o) { const int k = j - o; if (k >= 0 && k < CK) acc[o] += w[k] * glu; } } }
        }
        { float v[32];
#pragma unroll
          for (int o = 0; o < 32; ++o) v[o] = acc[o].x + acc[o].y;
          const float t1 = transpose_reduce32(v, lane); if (lane < 32) red[wave * 64 + lane] = t1;
#pragma unroll
          for (int o = 0; o < 32; ++o) v[o] = acc[o].x * acc[o].x + acc[o].y * acc[o].y;
          const float t2 = transpose_reduce32(v, lane); if (lane < 32) red[wave * 64 + 32 + lane] = t2; }
        __syncthreads();
        if (tid < 32) { float s1 = 0.f, s2 = 0.f;
#pragma unroll
            for (int wv = 0; wv < 8; ++wv) { s1 += red[wv * 64 + tid]; s2 += red[wv * 64 + 32 + tid]; }
            const float mean = s1 * (1.0f / CW); const float var = fmaxf(s2 * (1.0f / CW) - mean * mean, 0.f);
            mr[2 * tid] = mean; mr[2 * tid + 1] = 1.0f / sqrtf(var + EPS); }
        __syncthreads();
        const f32x2 lg = *(const GAS f32x2*)(lng + c0), lb = *(const GAS f32x2*)(lnb + c0);
        GAS unsigned* yp = (GAS unsigned*)(Y + (size_t)rb * D + c0);
#pragma unroll
        for (int o = 0; o < 32; ++o) { const float mean = mr[2 * o], rstd = mr[2 * o + 1];
            const float z0 = (acc[o].x - mean) * rstd * lg.x + lb.x, z1 = (acc[o].y - mean) * rstd * lg.y + lb.y;
            yp[(size_t)o * (D / 2)] = pk2(z0 * sigmoidf_(z0), z1 * sigmoidf_(z1)); }
        __syncthreads();
    }
}

__device__ __forceinline__ void lru_unit(const bf16* U, bf16* P1, bf16* P2, float* HAGG, float* CAGG, const bf16* WgT  ,
                                         const float* lcw, const float* lcb, const float* ba, const float* bxx, const float* lam, int tile, LAS unsigned char* lds, int tid, int lane, int wave) {
    const int r0 = tile * 64, tl0 = r0 & (SEQ - 1);
    const int fr = lane & 15, fq = lane >> 4;
    for (int hh = 0; hh < 2; ++hh) {
        { const int cp = tid & 255, th = tid >> 8, c = 512 * hh + 2 * cp;
          f32x2 w4[LK];
#pragma unroll
          for (int k = 0; k < LK; ++k) w4[k] = *(const GAS f32x2*)(lcw + k * LW + c);
          const f32x2 b4 = *(const GAS f32x2*)(lcb + c);
          const bool head = (tl0 == 0) && (th == 0);
          const GAS unsigned* up = (const GAS unsigned*)(U + (size_t)(r0 + 32 * th) * UW + CW + c);
          f32x2 win[3];
#pragma unroll
          for (int i = 0; i < 3; ++i) { const unsigned u = head ? 0u : up[(long)(i - 3) * (UW / 2)]; win[i] = (f32x2){bf_lo(u), bf_hi(u)}; }
          LAS unsigned* rxw = (LAS unsigned*)(lds + MX_RX + (32 * th) * MX_PITCH + 4 * cp);
          LAS unsigned* ggw = (LAS unsigned*)(lds + MX_GG + (32 * th) * MX_PITCH + 4 * cp);
#pragma unroll 8
          for (int i = 0; i < 32; ++i) { const unsigned u = up[(long)i * (UW / 2)], gt = up[(long)i * (UW / 2) + CW / 2];
              const f32x2 cur = (f32x2){bf_lo(u), bf_hi(u)};
              const f32x2 rx = b4 + w4[0] * win[0] + w4[1] * win[1] + w4[2] * win[2] + w4[3] * cur;
              win[0] = win[1]; win[1] = win[2]; win[2] = cur;
              rxw[i * (MX_PITCH / 4)] = pk2(rx.x, rx.y);
              ggw[i * (MX_PITCH / 4)] = pk2(gelu_tanh(bf_lo(gt)), gelu_tanh(bf_hi(gt))); } }
        __syncthreads();
        { const int hl = wave >> 1, hd = 4 * hh + hl, nb = 64 * (wave & 1);
          const bf16* WaT = WgT + (size_t)hd * LHD * LHD; const bf16* WxT = WgT + (size_t)(LH + hd) * LHD * LHD;
          bf16x8 bA[4], bX[4]; float ba_c, bx_c, lam_c;
#pragma unroll
          for (int ks = 0; ks < 4; ++ks) { bA[ks] = *(const GAS bf16x8*)(WaT + (size_t)(nb + fr) * LHD + 32 * ks + 8 * fq); bX[ks] = *(const GAS bf16x8*)(WxT + (size_t)(nb + fr) * LHD + 32 * ks + 8 * fq); }
          ba_c = ba[LHD * hd + nb + fr]; bx_c = bxx[LHD * hd + nb + fr]; lam_c = lam[LHD * hd + nb + fr];
#pragma unroll 1
          for (int nt = 0; nt < 4; ++nt) {
              const int n0 = nb + 16 * nt, ch = LHD * hd + n0 + fr, lcol = LHD * hl + n0 + fr;
              f32x4 aa[4], ax[4];
#pragma unroll
              for (int m = 0; m < 4; ++m) { aa[m] = (f32x4){0.f, 0.f, 0.f, 0.f}; ax[m] = aa[m]; }
#pragma unroll
              for (int ks = 0; ks < 4; ++ks)
#pragma unroll
                  for (int m = 0; m < 4; ++m) { const bf16x8 af = *(const LAS bf16x8*)(lds + MX_RX + (16 * m + fr) * MX_PITCH + (LHD * hl + 32 * ks + 8 * fq) * 2);
                      aa[m] = __builtin_amdgcn_mfma_f32_16x16x32_bf16(af, bA[ks], aa[m], 0, 0, 0); ax[m] = __builtin_amdgcn_mfma_f32_16x16x32_bf16(af, bX[ks], ax[m], 0, 0, 0); }
              const float ba_u = ba_c, bx_u = bx_c, lam_u = lam_c;
              if (nt < 3) {
                  asm volatile("" ::: "memory");
#pragma unroll
                  for (int ks = 0; ks < 4; ++ks) { bA[ks] = *(const GAS bf16x8*)(WaT + (size_t)(n0 + 16 + fr) * LHD + 32 * ks + 8 * fq); bX[ks] = *(const GAS bf16x8*)(WxT + (size_t)(n0 + 16 + fr) * LHD + 32 * ks + 8 * fq); }
                  ba_c = ba[ch + 16]; bx_c = bxx[ch + 16]; lam_c = lam[ch + 16]; }
              const float nl = -lam_u; const float sp8 = LRU_C * (fmaxf(nl, 0.f) + __logf(1.0f + __expf(-fabsf(nl))));
              const LAS bf16* rxr = (const LAS bf16*)(lds + MX_RX) + lcol; const LAS bf16* ggr = (const LAS bf16*)(lds + MX_GG) + lcol;
              float hl4[4][4], cl4[4][4], A[4], B[4];
#pragma unroll
              for (int m = 0; m < 4; ++m) { float h = 0.f, cp = 1.f;
#pragma unroll
                  for (int j = 0; j < 4; ++j) { const int tt = 16 * m + 4 * fq + j;
                      const float ga = sigmoidf_(aa[m][j] + ba_u), gx = sigmoidf_(ax[m][j] + bx_u);
                      const float la = -sp8 * ga, a = __builtin_amdgcn_exp2f(1.44269504089f * la);
                      const float x2 = 2.0f * la;
                      const float om_s = -x2 * (1.0f + x2 * (0.5f + x2 * (0.16666667f + x2 * (0.041666668f + x2 * 0.0083333338f))));
                      const float om = (x2 > -0.25f) ? om_s : (1.0f - a * a);
                      float mult = sqrtf(fmaxf(om, 0.f)); if (tl0 == 0 && tt == 0) mult = 1.0f;
                      const float b = mult * gx * bf2f(rxr[tt * (MX_PITCH / 2)]);
                      h = a * h + b; cp *= a; hl4[m][j] = h; cl4[m][j] = cp; }
                  A[m] = cp; B[m] = h; }
#pragma unroll
              for (int m = 0; m < 4; ++m) { const float Ap = __shfl_up(A[m], 16), Bp = __shfl_up(B[m], 16); if (fq >= 1) { B[m] = A[m] * Bp + B[m]; A[m] = A[m] * Ap; } }
#pragma unroll
              for (int m = 0; m < 4; ++m) { const float Ap = __shfl_up(A[m], 32), Bp = __shfl_up(B[m], 32); if (fq >= 2) { B[m] = A[m] * Bp + B[m]; A[m] = A[m] * Ap; } }
              float TA[4], TB[4], EA[4], EB[4];
#pragma unroll
              for (int m = 0; m < 4; ++m) { TA[m] = __shfl(A[m], 48 + fr); TB[m] = __shfl(B[m], 48 + fr); EA[m] = __shfl_up(A[m], 16); EB[m] = __shfl_up(B[m], 16); if (fq == 0) { EA[m] = 1.f; EB[m] = 0.f; } }
              float Hc = 0.f, Cc = 1.f;
#pragma unroll
              for (int m = 0; m < 4; ++m) { const float Hin = EA[m] * Hc + EB[m], Cin = EA[m] * Cc;
#pragma unroll
                  for (int j = 0; j < 4; ++j) { const int tt = 16 * m + 4 * fq + j; const float g = bf2f(ggr[tt * (MX_PITCH / 2)]);
                      const float hf = hl4[m][j] + cl4[m][j] * Hin, cf = cl4[m][j] * Cin;
                      { const unsigned w = pk2(hf * g, cf * g); P1[(size_t)(r0 + tt) * LW + ch] = (bf16)(w & 0xffffu); P2[(size_t)(r0 + tt) * LW + ch] = (bf16)(w >> 16); } }
                  Hc = TA[m] * Hc + TB[m]; Cc = TA[m] * Cc; }
              if (fq == 0) { HAGG[(size_t)tile * LW + ch] = Hc; CAGG[(size_t)tile * LW + ch] = Cc; }
          } }
        __syncthreads();
    }
}

__device__ __forceinline__ void lru_fix_unit(const bf16* P1, const bf16* P2, const float* HAGG, const float* CAGG, bf16* Y, int tile, LAS unsigned char* lds, int tid) {
    const int tb = tile & ~(SEQ / 64 - 1), j = tile & (SEQ / 64 - 1);
    const int cg = tid & 127, ts = tid >> 7;
    float A[8], B[8];
#pragma unroll
    for (int q = 0; q < 8; ++q) { A[q] = 1.f; B[q] = 0.f; }
    const int i0 = (j * ts) >> 2, i1 = (j * (ts + 1)) >> 2;
    for (int i = i0; i < i1; ++i) { const GAS f32x4* cp = (const GAS f32x4*)(CAGG + (size_t)(tb + i) * LW + 8 * cg); const GAS f32x4* hp = (const GAS f32x4*)(HAGG + (size_t)(tb + i) * LW + 8 * cg);
        const f32x4 c0 = cp[0], c1 = cp[1], h0 = hp[0], h1 = hp[1];
#pragma unroll
        for (int q = 0; q < 4; ++q) { B[q] = c0[q] * B[q] + h0[q]; A[q] *= c0[q]; B[4 + q] = c1[q] * B[4 + q] + h1[q]; A[4 + q] *= c1[q]; } }
    LAS float* part = (LAS float*)lds;
#pragma unroll
    for (int q = 0; q < 8; ++q) { part[(ts * 128 + cg) * 16 + q] = A[q]; part[(ts * 128 + cg) * 16 + 8 + q] = B[q]; }
    __syncthreads();
    float hin[8];
#pragma unroll
    for (int q = 0; q < 8; ++q) hin[q] = 0.f;
#pragma unroll
    for (int sgm = 0; sgm < 4; ++sgm)
#pragma unroll
        for (int q = 0; q < 8; ++q) hin[q] = part[(sgm * 128 + cg) * 16 + q] * hin[q] + part[(sgm * 128 + cg) * 16 + 8 + q];
    __syncthreads();
    const int r0 = tile * 64;
#pragma unroll 4
    for (int tt = ts; tt < 64; tt += 4) { const v4u p1 = *(const GAS v4u*)(P1 + (size_t)(r0 + tt) * LW + 8 * cg), p2 = *(const GAS v4u*)(P2 + (size_t)(r0 + tt) * LW + 8 * cg);
        v4u o;
        o.x = pk2(bf_lo(p1.x) + bf_lo(p2.x) * hin[0], bf_hi(p1.x) + bf_hi(p2.x) * hin[1]); o.y = pk2(bf_lo(p1.y) + bf_lo(p2.y) * hin[2], bf_hi(p1.y) + bf_hi(p2.y) * hin[3]);
        o.z = pk2(bf_lo(p1.z) + bf_lo(p2.z) * hin[4], bf_hi(p1.z) + bf_hi(p2.z) * hin[5]); o.w = pk2(bf_lo(p1.w) + bf_lo(p2.w) * hin[6], bf_hi(p1.w) + bf_hi(p2.w) * hin[7]);
        *(GAS v4u*)(Y + (size_t)(r0 + tt) * D + CW + 8 * cg) = o; }
}


struct MoeItem { const float* W; unsigned char* WT; int K, N, mode, item; float sc; };
__device__ __forceinline__ MoeItem moe_item(int it, const float* wg, const float* wu, const float* wd, unsigned char* MWgu8, unsigned char* MWd8) {
    constexpr int I_GU = (D / 128) * (DFF / 128), I_DN = (DFF / 128) * (D / 128), N_MGU = NE * 2 * I_GU;
    MoeItem m;
    if (it < N_MGU) { const int e = it / (2 * I_GU), rr = it % (2 * I_GU), w = rr / I_GU; m.W = (w == 0 ? wg : wu) + (size_t)e * D * DFF; m.WT = MWgu8 + (size_t)e * 2 * DFF * D; m.K = D; m.N = DFF; m.mode = 1 + w; m.item = rr % I_GU; m.sc = MOE_SC_GU; }
    else { const int r = it - N_MGU, e = r / I_DN; m.W = wd + (size_t)e * DFF * D; m.WT = MWd8 + (size_t)e * D * DFF; m.K = DFF; m.N = D; m.mode = 0; m.item = r % I_DN; m.sc = MOE_SC_D; }
    return m;
}
__device__ __forceinline__ void tr8_load(const MoeItem& m, int sblk, f32x4 (&R)[16], int lane) {
    const int nblk = m.N >> 7, kb = m.item / nblk, nb = m.item - kb * nblk, k0 = (kb << 7) + 32 * sblk, n0 = nb << 7, q = lane & 31, r = lane >> 5;
#pragma unroll
    for (int i = 0; i < 4; ++i) { const float* src = m.W + (size_t)(k0 + 4 * (2 * i + r)) * m.N + n0 + 4 * q;
#pragma unroll
        for (int x = 0; x < 4; ++x) R[4 * i + x] = __builtin_nontemporal_load((const GAS f32x4*)(src + (size_t)x * m.N)); }
}
__device__ __forceinline__ void tr8_sub(const MoeItem& m, int sblk, const f32x4 (&R)[16], LAS unsigned* scr, int lane) {
    const int q = lane & 31, r = lane >> 5; const float sc = m.sc;
#pragma unroll
    for (int i = 0; i < 4; ++i) { const int p = 8 * sblk + 2 * i + r;
#pragma unroll
        for (int j = 0; j < 4; ++j) scr[(4 * q + j) * 32 + (p ^ (4 * (q & 7)))] = cvt4_fp8(R[4 * i][j] * sc, R[4 * i + 1][j] * sc, R[4 * i + 2][j] * sc, R[4 * i + 3][j] * sc); }
}
__device__ __forceinline__ void tr8_store(const MoeItem& m, LAS unsigned* scr, int lane) {
    const int nblk = m.N >> 7, kb = m.item / nblk, nb = m.item - kb * nblk, k0 = kb << 7, n0 = nb << 7;
    LDS_WAIT(); asm volatile("" ::: "memory");
    const int c = lane & 7;
#pragma unroll
    for (int jj = 0; jj < 16; ++jj) { const int n = (lane >> 3) + 8 * jj; const v4u o = *(const LAS v4u*)(scr + n * 32 + 4 * (c ^ ((n >> 2) & 7)));
        const int ng = n0 + n; const int row = m.mode == 0 ? ng : ((ng >> 7) * 256 + (ng & 127) + (m.mode == 2 ? 128 : 0));
        __builtin_nontemporal_store(o, (GAS v4u*)(m.WT + (size_t)row * m.K + k0 + 16 * c)); }
    LDS_WAIT(); asm volatile("" ::: "memory");
}
typedef float v16f __attribute__((ext_vector_type(16)));
typedef unsigned v6u __attribute__((ext_vector_type(6)));
__device__ __forceinline__ void tr6_load(const MoeItem& m, int sblk, f32x2 (&R)[32], int lane) {
    const int nblk = m.N >> 7, kb = m.item / nblk, nb = m.item - kb * nblk, k0 = 16 * kb + 4 * sblk, n0 = nb << 7;
    const __amdgpu_buffer_rsrc_t rs = __builtin_amdgcn_make_buffer_rsrc((void*)m.W, 0, m.K * m.N * 4, 0x00020000);
    const int vo = (n0 + 2 * lane) * 4, rowb = m.N * 4, so0 = k0 * rowb;
#pragma unroll
    for (int t = 0; t < 32; ++t) { const v2u w = __builtin_amdgcn_raw_buffer_load_b64(rs, vo, so0 + ((t & 3) + 256 * (t >> 2)) * rowb, 2  ); R[t] = (f32x2){__uint_as_float(w.x), __uint_as_float(w.y)}; }
}
__device__ __forceinline__ void tr6_sub(const MoeItem& m, int sblk, const f32x2 (&R)[32], LAS unsigned* scr, int lane) {
    const float sc = m.sc;
#pragma unroll
    for (int b = 0; b < 2; ++b) { v16f x, y;
#pragma unroll
        for (int k = 0; k < 16; ++k) { x[k] = R[k][b]; y[k] = R[16 + k][b]; }
        v6u d; asm volatile("v_cvt_scalef32_2xpk16_fp6_f32 %0, %1, %2, %3" : "=&v"(d) : "v"(x), "v"(y), "v"(1.0f / sc));
        const int row = 2 * lane + b, sw = (row >> 2) & 7;
        LAS unsigned* p1 = scr + row * 32 + 4 * (sblk ^ sw); LAS unsigned* p2 = scr + row * 32 + 4 * ((4 + sblk) ^ sw);
        p1[0] = d[0]; p1[1] = d[1]; p1[2] = d[2]; p1[3] = d[3]; p2[0] = d[4]; p2[1] = d[5]; }
}
__device__ __forceinline__ void moe_convert_share(const float* wg, const float* wu, const float* wd, unsigned char* MWgu8, unsigned char* MWd8, LAS unsigned char* lds, int gw, int NGW, int wave, int lane) {
    LAS unsigned* scr = (LAS unsigned*)(lds + RING_OFF + wave * 16384);
    constexpr int N_MGU = NE * 2 * (D / 128) * (DFF / 128), NTOT = N_MGU + NE * (DFF / 128) * (D / 128);
    int it = gw;
    { f32x2 Qa[32], Qb[32];
      for (; it < N_MGU; it += NGW) {
        const MoeItem m = moe_item(it, wg, wu, wd, MWgu8, MWd8);
        tr6_load(m, 0, Qa, lane);
        tr6_load(m, 1, Qb, lane); tr6_sub(m, 0, Qa, scr, lane);
        tr6_load(m, 2, Qa, lane); tr6_sub(m, 1, Qb, scr, lane);
        tr6_load(m, 3, Qb, lane); tr6_sub(m, 2, Qa, scr, lane);
        tr6_sub(m, 3, Qb, scr, lane);
        tr8_store(m, scr, lane);
      } }
    f32x4 Ra[16], Rb[16];
    for (; it < NTOT; it += NGW) {
        const MoeItem m = moe_item(it, wg, wu, wd, MWgu8, MWd8);
        tr8_load(m, 0, Ra, lane);
        tr8_load(m, 1, Rb, lane); tr8_sub(m, 0, Ra, scr, lane);
        tr8_load(m, 2, Ra, lane); tr8_sub(m, 1, Rb, scr, lane);
        tr8_load(m, 3, Rb, lane); tr8_sub(m, 2, Ra, scr, lane);
        tr8_sub(m, 3, Rb, scr, lane);
        tr8_store(m, scr, lane);
    }
}

struct Args { const float* in[24]; float* out; unsigned char* ws; int ph_lo, ph_hi; };
constexpr int N_PHASES = 15;

constexpr int DC_I_IN = (D / 64) * (DIN / 64), DC_I_OUT = (D / 64) * (D / 64), DC_I_GU = (D / 64) * (DFF / 64), DC_I_DN = (DFF / 64) * (D / 64), DC_I_GT = 4;
constexpr int DC_N_GT = DEPTH * 2 * LH * DC_I_GT, DC_N_EARLY = DC_I_IN + DC_N_GT, DC_N_ALL = DC_N_EARLY + DC_I_IN + 2 * DC_I_OUT + 2 * DC_I_GU + DC_I_DN;
__device__ __forceinline__ void dense_convert_items(const Args& args, unsigned char* ws, int lo, int hi, LAS unsigned char* lds, int gw, int NGW, int wave, int lane) {
    LAS unsigned* scr = (LAS unsigned*)(lds + RING_OFF + wave * 8192);
    bf16* Win_t = (bf16*)(ws + WS_WIN); bf16* Wout_t = (bf16*)(ws + WS_WOUT); bf16* Wgate_t = (bf16*)(ws + WS_WGATE); bf16* DWgu = (bf16*)(ws + WS_DWGU); bf16* DWd = (bf16*)(ws + WS_DWD);
    for (int it = lo + gw; it < hi; it += NGW) {
        int r = it;
        if (r < DC_I_IN) { tr_item(args.in[2], D, DIN, Win_t, 3, r, scr, lane, args.in[1]); continue; } r -= DC_I_IN;
        if (r < DC_N_GT) { const int m = r / DC_I_GT;
            const int l = m / 16, ax = (m / 8) & 1, h = m & 7;
            tr_item((ax == 0 ? args.in[9] : args.in[11]) + (size_t)(l * LH + h) * LHD * LHD, LHD, LHD, Wgate_t + (size_t)m * LHD * LHD, 0, r % DC_I_GT, scr, lane); continue; } r -= DC_N_GT;
        if (r < DC_I_IN) { tr_item(args.in[2] + (size_t)D * DIN, D, DIN, Win_t + (size_t)DIN * D, 3, r, scr, lane, args.in[1] + D); continue; } r -= DC_I_IN;
        if (r < 2 * DC_I_OUT) { const int l = r / DC_I_OUT; tr_item(args.in[14] + (size_t)l * D * D, D, D, Wout_t + (size_t)l * D * D, 0, r % DC_I_OUT, scr, lane); continue; } r -= 2 * DC_I_OUT;
        if (r < 2 * DC_I_GU) { const int w = r / DC_I_GU; tr_item(w == 0 ? args.in[16] : args.in[17], D, DFF, DWgu, 1 + w, r % DC_I_GU, scr, lane, args.in[15]); continue; } r -= 2 * DC_I_GU;
#if DENSE2_FP8
        tr_item8(args.in[18], DFF, D, (unsigned char*)DWd, 0, r, scr, lane, MOE_SC_D);
#else
        tr_item(args.in[18], DFF, D, DWd, 0, r, scr, lane);
#endif
    }
}


#define IN(k) (lo <= (k) && (k) < hi)
#define REPS(k) for (int rep_ = 0; rep_ < (((k) == PROBE_PHASE) ? PROBE_N : 1); ++rep_)
#define SEAM(k) do { if (IN(k) && IN((k) + 1)) xcd_barrier(bar); } while (0)
struct Ctx { LAS unsigned char* lds; unsigned char* ws; gu32* ctl; int tid, lane, wave, G, bx, gw, NGW, gtid, NGT, lo, hi, vbx; };
template <int L> __device__ __forceinline__ void layer_phases(const Args& args, const Ctx& C, const XcdBarrier& bar) {
    LAS unsigned char* lds = C.lds; unsigned char* ws = C.ws; gu32* ctl = C.ctl;
    const int tid = C.tid, lane = C.lane, wave = C.wave, G = C.G, bx = C.bx, gw = C.gw, NGW = C.NGW, gtid = C.gtid, NGT = C.NGT, lo = C.lo, hi = C.hi, vbx = C.vbx;
    const float* x_in = args.in[0];
    bf16* Win_t = (bf16*)(ws + WS_WIN); bf16* Wout_t = (bf16*)(ws + WS_WOUT); bf16* Wgate_t = (bf16*)(ws + WS_WGATE);
    bf16* DWgu = (bf16*)(ws + WS_DWGU); bf16* DWd = (bf16*)(ws + WS_DWD); bf16* MWgu = (bf16*)(ws + WS_MWGU); bf16* MWd = (bf16*)(ws + WS_MWD);
    float* X = (float*)(ws + WS_X); bf16* H = (bf16*)(ws + WS_H); bf16* U = (bf16*)(ws + WS_U); bf16* Y = (bf16*)(ws + WS_Y);
    bf16* HID = (bf16*)(ws + WS_HID); bf16* XG8 = (bf16*)(ws + WS_XG8); bf16* YB = (bf16*)(ws + WS_YB);
    int* ROUTE = (int*)(ws + WS_ROUTE); int* POS = (int*)(ws + WS_POS);

    {
        constexpr int l = L, pb = 1 + 6 * L;
        if (IN(pb)) REPS(pb) {
            pg8::Gemm g{H, Win_t + (size_t)l * DIN * D, T, DIN, D}; pg8::StaticOrder S; S.init(T, DIN, G, vbx);
            pg8::EpiInProj E{U, UW, (const float*)(ws + WS_SSQB)};
            if constexpr (L == 0) {
                const int rounds = (S.nwg + G - 1) / G, grp = (vbx * 4) / G, cut = (rounds * grp) / 4;
                S.i0 = 0; S.i1 = cut;
                pg8::gemm_phase<pg8::EpiInProj, pg8::StaticOrder, true, true>(lds + RING_OFF, g, S, E);
                dense_convert_items(args, ws, DC_N_EARLY, DC_N_ALL, lds, gw, NGW, wave, lane);
                __syncthreads();
                S.i0 = cut; S.i1 = 0x7fffffff;
            }
            pg8::gemm_phase<pg8::EpiInProj, pg8::StaticOrder, true, true>(lds + RING_OFF, g, S, E);
#if GEMM_PV >= 0
            if (L == 0) { __syncthreads(); pg8::gemm_phase<pg8::EpiInProj, pg8::StaticOrder, true, true, false, GEMM_PV>(lds + RING_OFF, g, S, E); }
#endif
        }
        SEAM(pb);
        if (IN(pb + 1)) { constexpr int TR = (PROBE_PHASE == pb + 1) ? PROBE_N : 1;
            const float* conv_w = args.in[3] + (size_t)l * CK * CW; const float* conv_b = args.in[4] + (size_t)l * CW;
            const float* lcw = args.in[7] + (size_t)l * LK * LW; const float* lcb = args.in[8] + (size_t)l * LW;
#if NAIVE_CONV || NAIVE_LRU
            float* NCONV = (float*)(ws + WS_NCONV); float* NRX = (float*)(ws + WS_NRX);
            for (int idx = gtid; idx < T * CW; idx += NGT) {
                const int t = idx >> 10, c = idx & 1023, tl = t & (SEQ - 1);
                float s = conv_b[c];
                for (int k = 0; k < CK; ++k) { const int tt = tl - (CK - 1) + k; if (tt >= 0) { const size_t ro = (size_t)(t - (CK - 1) + k) * DIN; const float v = bf2f(U[ro + c]), gt = bf2f(U[ro + CW + c]); s += conv_w[k * CW + c] * (v * sigmoidf_(gt)); } }
                NCONV[idx] = s;
                float r = lcb[c];
                for (int k = 0; k < LK; ++k) { const int tt = tl - (LK - 1) + k; if (tt >= 0) r += lcw[k * LW + c] * bf2f(U[(size_t)(t - (LK - 1) + k) * DIN + 2 * CW + c]); }
                NRX[idx] = r;
            }
#endif
#if !NAIVE_LRU
            for (int tile_ = bx; tile_ < (PROBE_SUB == 2 ? 1 : TR) * (T / 64); tile_ += G) { const int tile = tile_ % (T / 64);
                lru_unit(U, (bf16*)(ws + WS_P1), (bf16*)(ws + WS_P2), (float*)(ws + WS_HAGG), (float*)(ws + WS_CAGG), Wgate_t + (size_t)l * 2 * LH * LHD * LHD, lcw, lcb,
                         args.in[10] + (size_t)l * LW, args.in[12] + (size_t)l * LW, args.in[13] + (size_t)l * LW, tile, lds, tid, lane, wave); }
#endif
#if !NAIVE_CONV
            for (int tile_ = bx; tile_ < (PROBE_SUB == 1 ? 1 : TR) * (T / 64); tile_ += G) { const int tile = tile_ % (T / 64);
                conv_unit(U, Y, conv_w, conv_b, args.in[5] + (size_t)l * CW, args.in[6] + (size_t)l * CW, tile, lds, tid, lane, wave); }
#endif
        }
        SEAM(pb + 1);
        if (IN(pb + 2)) REPS(pb + 2) {
#if NAIVE_CONV
            { const float* lng = args.in[5] + (size_t)l * CW; const float* lnb = args.in[6] + (size_t)l * CW; const float* NCONV = (const float*)(ws + WS_NCONV);
            for (int m = gw; m < T; m += NGW) {
                float v[16]; float s = 0.f;
#pragma unroll
                for (int j = 0; j < 16; ++j) { v[j] = NCONV[(size_t)m * CW + lane + 64 * j]; s += v[j]; }
                const float mean = wave_sum(s) * (1.0f / CW); float q = 0.f;
#pragma unroll
                for (int j = 0; j < 16; ++j) { v[j] -= mean; q += v[j] * v[j]; }
                const float rstd = 1.0f / sqrtf(wave_sum(q) * (1.0f / CW) + EPS);
#pragma unroll
                for (int j = 0; j < 16; ++j) { const int c = lane + 64 * j; const float z = v[j] * rstd * lng[c] + lnb[c]; Y[(size_t)m * D + c] = (bf16)f2bf(z * sigmoidf_(z)); }
            } }
#endif
#if NAIVE_LRU
            { const float* NRX = (const float*)(ws + WS_NRX); float* NA = (float*)(ws + WS_NA); float* NB = (float*)(ws + WS_NB);
            const float* wa = args.in[9] + (size_t)l * LH * LHD * LHD; const float* wx = args.in[11] + (size_t)l * LH * LHD * LHD;
            const float* ba = args.in[10] + (size_t)l * LW; const float* bxx = args.in[12] + (size_t)l * LW; const float* lam = args.in[13] + (size_t)l * LW;
            for (int idx = gtid; idx < T * LW; idx += NGT) {
                const int t = idx >> 10, c = idx & 1023, h = c >> 7, j = c & 127, tl = t & (SEQ - 1);
                float da = ba[c], dx = bxx[c];
                const float* rxr = NRX + (size_t)t * LW + h * LHD; const float* war = wa + (size_t)h * LHD * LHD + j; const float* wxr = wx + (size_t)h * LHD * LHD + j;
                for (int i = 0; i < LHD; ++i) { const float r = rxr[i]; da += r * war[i * LHD]; dx += r * wxr[i * LHD]; }
                const float ga = sigmoidf_(da), gx = sigmoidf_(dx);
                const float nl = -lam[c]; const float sp = (nl > 20.f) ? nl : log1pf(expf(nl));
                const float la = -LRU_C * ga * sp; const float a = expf(la);
                float mult = sqrtf(fmaxf(-expm1f(2.0f * la), 0.f)); if (tl == 0) mult = 1.0f;
                NA[idx] = a; NB[idx] = mult * gx * NRX[idx];
            }
            xcd_barrier(bar);
            if (gtid < BATCH * LW) { const int b = gtid >> 10, c = gtid & 1023; float h = 0.f;
                for (int t = 0; t < SEQ; ++t) { const size_t row = (size_t)b * SEQ + t; h = NA[row * LW + c] * h + NB[row * LW + c];
                    Y[row * D + CW + c] = (bf16)f2bf(h * gelu_tanh(bf2f(U[row * DIN + 3 * CW + c]))); } } }
#else
            for (int tile = bx; tile < T / 64; tile += G)
                lru_fix_unit((const bf16*)(ws + WS_P1), (const bf16*)(ws + WS_P2), (const float*)(ws + WS_HAGG), (const float*)(ws + WS_CAGG), Y, tile, lds, tid);
#endif
        }
        SEAM(pb + 2);
        if (IN(pb + 3)) REPS(pb + 3) {
            pg8::Gemm g{Y, Wout_t + (size_t)l * D * D, T, D, D}; pg8::StaticOrder S; S.init(T, D, G, vbx);
            if constexpr (L == 0) { pg8::EpiResNormT<true> E{H, H, (float*)(ws + WS_SSQA), D, 1.0f, (LAS float*)(lds + RING_BYTES)};
                pg8::gemm_phase<pg8::EpiResNormT<true>, pg8::StaticOrder, true, true>(lds + RING_OFF, g, S, E); }
            else { pg8::EpiResB16 E{H, D};
                pg8::gemm_phase<pg8::EpiResB16, pg8::StaticOrder, true, true>(lds + RING_OFF, g, S, E); }
        }
        SEAM(pb + 3);
        if constexpr (L == 0) {
            if (IN(5)) {
                pg8::Gemm g{H, DWgu, T, 2 * DFF, D}; pg8::StaticOrder S; S.init(T, 2 * DFF, G, vbx);
                typedef pg8::EpiSwiGlu8 EpiD1; EpiD1 E{(unsigned char*)HID, DFF, 1.0f, (const float*)(ws + WS_SSQA)};
                const int rounds = (S.nwg + G - 1) / G, grp = (vbx * 8) / G, cut = (rounds * grp) / 8;
                S.i0 = 0; S.i1 = cut;
                pg8::gemm_phase<EpiD1, pg8::StaticOrder, true, true>(lds + RING_OFF, g, S, E);
                moe_convert_share(args.in[20], args.in[21], args.in[22], (unsigned char*)MWgu, (unsigned char*)MWd, lds, gw, NGW, wave, lane);
                __syncthreads();
                S.i0 = cut; S.i1 = 0x7fffffff;
                pg8::gemm_phase<EpiD1, pg8::StaticOrder, true, true>(lds + RING_OFF, g, S, E);
            }
            SEAM(5);
            if (IN(6)) {
                pg8::Gemm g{HID, DWd, T, D, DFF / 2}; pg8::StaticOrder S; S.init(T, D, G, vbx);
                pg8::EpiResNormT<true> E{H, H, (float*)(ws + WS_SSQB), D, 1.0f / MOE_SC_D, (LAS float*)(lds + RING_BYTES)};
                pg8::gemm_phase<pg8::EpiResNormT<true>, pg8::StaticOrder, true, true, true>(lds + RING_OFF, g, S, E);
            }
            SEAM(6);
        } else {
            if (IN(11)) {
                LAS f32x4* wl = (LAS f32x4*)lds;
                LAS unsigned* rows8 = (LAS unsigned*)(lds + 65536);
                LAS unsigned* meta = (LAS unsigned*)(lds + 131072);
                LAS unsigned* lc = meta + 128;
                LAS unsigned* lbase = meta + 136;
                const float* wrt = args.in[19]; const float* gain = args.in[15] + D;
                for (int q = tid; q < D * NE / 4; q += NTHR) { const f32x4 w = ((const GAS f32x4*)wrt)[q]; const int k = q >> 1, half = q & 1, i = k & 3, ln = (k >> 2) & 63, j = k >> 8; wl[((j * 4 + i) * 2 + half) * 64 + ln] = w; }
                __syncthreads();
                for (int sub = bx; sub < T / 32; sub += G) {
                    if (tid < NE) lc[tid] = 0u;
                    __syncthreads();
#pragma unroll 1
                    for (int rr = 0; rr < 4; ++rr) { const int row = 4 * wave + rr, m = sub * 32 + row;
                        const GAS v2u* xr = (const GAS v2u*)(H + (size_t)m * D) + lane; const GAS f32x4* gr = (const GAS f32x4*)gain + lane;
                        f32x4 v[8]; float ss = 0.f;
#pragma unroll
                        for (int j = 0; j < 8; ++j) { const v2u a = xr[64 * j]; v[j] = (f32x4){bf_lo(a.x), bf_hi(a.x), bf_lo(a.y), bf_hi(a.y)}; ss += (v[j].x * v[j].x + v[j].y * v[j].y) + (v[j].z * v[j].z + v[j].w * v[j].w); }
                        const float rstd = 1.0f / sqrtf(wave_sum(ss) * (1.0f / D) + EPS);
                        f32x4 l0 = (f32x4){0.f, 0.f, 0.f, 0.f}, l1 = l0;
                        v16f hx, hy;
#pragma unroll
                        for (int j = 0; j < 8; ++j) { const f32x4 g = gr[64 * j]; const f32x4 hv = v[j] * rstd * g;
#pragma unroll
                            for (int i = 0; i < 4; ++i) { if (j < 4) hx[4 * j + i] = hv[i] * MOE_SC_A; else hy[4 * (j - 4) + i] = hv[i] * MOE_SC_A;
                                l0 += hv[i] * wl[((j * 4 + i) * 2 + 0) * 64 + lane]; l1 += hv[i] * wl[((j * 4 + i) * 2 + 1) * 64 + lane]; } }
                        { v6u d; asm volatile("v_cvt_scalef32_2xpk16_fp6_f32 %0, %1, %2, 1.0" : "=&v"(d) : "v"(hx), "v"(hy));
                          LAS unsigned* p1 = rows8 + row * 512 + (lane >> 2) * 32 + 4 * (lane & 3); p1[0] = d[0]; p1[1] = d[1]; p1[2] = d[2]; p1[3] = d[3]; p1[16] = d[4]; p1[17] = d[5]; }
                        float p4[4], p2[2], p1;
                        { const bool up = (lane & 32) != 0; float a0[4] = {l0.x, l0.y, l0.z, l0.w}, a1[4] = {l1.x, l1.y, l1.z, l1.w};
#pragma unroll
                          for (int i = 0; i < 4; ++i) { float x = a0[i], y = a1[i]; asm volatile("" : "+v"(x), "+v"(y)); p4[i] = (up ? y : x) + __shfl_xor(up ? x : y, 32); } }
                        { const bool up = (lane & 16) != 0;
#pragma unroll
                          for (int i = 0; i < 2; ++i) { float x = p4[i], y = p4[i + 2]; asm volatile("" : "+v"(x), "+v"(y)); p2[i] = (up ? y : x) + __shfl_xor(up ? x : y, 16); } }
                        { const bool up = (lane & 8) != 0; float x = p2[0], y = p2[1]; asm volatile("" : "+v"(x), "+v"(y)); p1 = (up ? y : x) + __shfl_xor(up ? x : y, 8); }
                        p1 += __shfl_xor(p1, 4); p1 += __shfl_xor(p1, 2); p1 += __shfl_xor(p1, 1);
                        float lg[8];
#pragma unroll
                        for (int e = 0; e < 8; ++e) lg[e] = __int_as_float(__builtin_amdgcn_readlane(__float_as_int(p1), ((e & 4) ? 32 : 0) + ((e & 2) ? 16 : 0) + ((e & 1) ? 8 : 0)));
                        float m1 = lg[0]; int i1 = 0;
#pragma unroll
                        for (int e = 1; e < 8; ++e) if (lg[e] > m1) { m1 = lg[e]; i1 = e; }
                        float m2 = -3.0e38f; int i2 = 0;
#pragma unroll
                        for (int e = 0; e < 8; ++e) if (e != i1 && lg[e] > m2) { m2 = lg[e]; i2 = e; }
                        const float ex = expf(m2 - m1), w1 = 1.0f / (1.0f + ex), w2 = ex / (1.0f + ex);
                        if (lane == 0) { int4 r; r.x = i1; r.y = i2; r.z = __float_as_int(w1); r.w = __float_as_int(w2); ((int4*)ROUTE)[m] = r;
                            meta[row * 4 + 0] = (unsigned)i1; meta[row * 4 + 1] = (unsigned)i2;
                            meta[row * 4 + 2] = __hip_atomic_fetch_add(lc + i1, 1u, __ATOMIC_RELAXED, __HIP_MEMORY_SCOPE_WORKGROUP); meta[row * 4 + 3] = __hip_atomic_fetch_add(lc + i2, 1u, __ATOMIC_RELAXED, __HIP_MEMORY_SCOPE_WORKGROUP); }
                    }
                    __syncthreads();
                    if (tid < NE) lbase[tid] = __hip_atomic_fetch_add(ctl + CW_CNT + 64 * tid, lc[tid], RLX_AGENT);
                    __syncthreads();
#pragma unroll 1
                    for (int rr = 0; rr < 4; ++rr) { const int row = 4 * wave + rr, m = sub * 32 + row;
                        const unsigned e1 = meta[row * 4 + 0], e2 = meta[row * 4 + 1]; const unsigned s1 = lbase[e1] + meta[row * 4 + 2], s2 = lbase[e2] + meta[row * 4 + 3];
                        if (lane == 0) { POS[2 * m] = (int)s1; POS[2 * m + 1] = (int)s2; }
                        const LAS v4u* src = (const LAS v4u*)(rows8 + row * 512) + lane; const v4u q0 = src[0], q1 = src[64];
                        GAS v4u* d1 = (GAS v4u*)((unsigned char*)XG8 + ((size_t)e1 * T + s1) * (D + XPAD)) + lane; GAS v4u* d2 = (GAS v4u*)((unsigned char*)XG8 + ((size_t)e2 * T + s2) * (D + XPAD)) + lane;
                        d1[0] = q0; d1[64] = q1; d2[0] = q0; d2[64] = q1; }
                    __syncthreads();
                }
            }
            SEAM(11);
            if (IN(12) || IN(13)) {
                pg8::MoeOrder S; unsigned acc = 0;
#pragma unroll
                for (int e = 0; e < NE; ++e) { const unsigned c = (unsigned)__builtin_amdgcn_readfirstlane((int)__hip_atomic_load(ctl + CW_CNT + 64 * e, RLX_AGENT)); const unsigned nt = (c + 255u) >> 8; acc += nt; S.te[e] = (int)acc; if (e < 7) S.dg[e] = T / 256 - (int)nt; }
                const int ntiles = (int)acc;
                if (IN(12)) { S.rep = (PROBE_PHASE == 12) ? PROBE_N : 1;
                    S.nM = ntiles; S.nN = 2 * DFF / 256; S.nwg = S.nM * S.nN; S.G = G; S.c = vbx; S.estride = (size_t)2 * DFF * D;
                    pg8::Gemm g{XG8, MWgu, ntiles * 256, 2 * DFF, D / 2, (D + XPAD) / 2};
                    pg8::EpiSwiGlu8 E{(unsigned char*)HID, DFF, 1.0f / (MOE_SC_GU * MOE_SC_A), nullptr};
                    pg8::gemm_phase<pg8::EpiSwiGlu8, pg8::MoeOrder, true, true, true, 0, true>(lds + RING_OFF, g, S, E);
                }
                SEAM(12);
                if (IN(13)) { S.rep = (PROBE_PHASE == 13) ? PROBE_N : 1;
#pragma unroll
                    for (int k = 0; k < 7; ++k) S.dg[k] = 0;
                    S.nM = ntiles; S.nN = D / 256; S.nwg = S.nM * S.nN; S.G = G; S.c = vbx; S.estride = (size_t)D * DFF;
                    pg8::Gemm g{HID, MWd, ntiles * 256, D, DFF / 2};
                    pg8::EpiBf16S E{YB, D, 1.0f / MOE_SC_D};
                    pg8::gemm_phase<pg8::EpiBf16S, pg8::MoeOrder, true, true, true>(lds + RING_OFF, g, S, E);
                }
                SEAM(13);
            }
            if (IN(14)) REPS(14) {
                const float* fn = args.in[23];
                LAS unsigned* tst = (LAS unsigned*)(lds + RING_OFF);
                if (tid == 0) { unsigned acc = 0; for (int e = 0; e < NE; ++e) { tst[e] = acc << 8; acc += (__hip_atomic_load(ctl + CW_CNT + 64 * e, RLX_AGENT) + 255u) >> 8; } }
                __syncthreads();
                const GAS f32x4* gr = (const GAS f32x4*)fn + lane;
                int m = gw; int4 r = (int4){0, 0, 0, 0}; int q1 = 0, q2 = 0;
                v2u xa[8], ya[8], yb[8];
                if (m < T) { r = ((const int4*)ROUTE)[m]; q1 = POS[2 * m]; q2 = POS[2 * m + 1];
                    const int p1 = (int)tst[r.x] + q1, p2 = (int)tst[r.y] + q2;
                    const GAS v2u* xr = (const GAS v2u*)(H + (size_t)m * D) + lane; const GAS v2u* y1 = (const GAS v2u*)(YB + (size_t)p1 * D) + lane; const GAS v2u* y2 = (const GAS v2u*)(YB + (size_t)p2 * D) + lane;
#pragma unroll
                    for (int j = 0; j < 8; ++j) { xa[j] = xr[64 * j]; ya[j] = y1[64 * j]; yb[j] = y2[64 * j]; } }
                int4 rn = (int4){0, 0, 0, 0}; int qn1 = 0, qn2 = 0;
                { const int mn = m + NGW; if (mn < T) { rn = ((const int4*)ROUTE)[mn]; qn1 = POS[2 * mn]; qn2 = POS[2 * mn + 1]; } }
#pragma unroll 1
                for (; m < T; m += NGW) {
                    const float w1 = __int_as_float(r.z), w2 = __int_as_float(r.w);
                    const int mn = m + NGW, mnn = mn + NGW;
                    v2u xb_[8], yc[8], yd[8];
                    if (mn < T) { const int p1 = (int)tst[rn.x] + qn1, p2 = (int)tst[rn.y] + qn2;
                        const GAS v2u* xr = (const GAS v2u*)(H + (size_t)mn * D) + lane; const GAS v2u* y1 = (const GAS v2u*)(YB + (size_t)p1 * D) + lane; const GAS v2u* y2 = (const GAS v2u*)(YB + (size_t)p2 * D) + lane;
#pragma unroll
                        for (int j = 0; j < 8; ++j) { xb_[j] = xr[64 * j]; yc[j] = y1[64 * j]; yd[j] = y2[64 * j]; } }
                    else {
#pragma unroll
                        for (int j = 0; j < 8; ++j) { xb_[j] = (v2u){0u, 0u}; yc[j] = xb_[j]; yd[j] = xb_[j]; } }
                    int4 rnn = (int4){0, 0, 0, 0}; int qa = 0, qb = 0;
                    if (mnn < T) { rnn = ((const int4*)ROUTE)[mnn]; qa = POS[2 * mnn]; qb = POS[2 * mnn + 1]; }
                    f32x4 v[8]; float s = 0.f;
#pragma unroll
                    for (int j = 0; j < 8; ++j) { const v2u x3 = xa[j], a = ya[j], b = yb[j]; v[j] = (f32x4){bf_lo(x3.x), bf_hi(x3.x), bf_lo(x3.y), bf_hi(x3.y)};
                        v[j].x += w1 * bf_lo(a.x) + w2 * bf_lo(b.x); v[j].y += w1 * bf_hi(a.x) + w2 * bf_hi(b.x); v[j].z += w1 * bf_lo(a.y) + w2 * bf_lo(b.y); v[j].w += w1 * bf_hi(a.y) + w2 * bf_hi(b.y);
                        s += (v[j].x * v[j].x + v[j].y * v[j].y) + (v[j].z * v[j].z + v[j].w * v[j].w); }
                    const float rstd = 1.0f / sqrtf(wave_sum(s) * (1.0f / D) + EPS);
                    GAS f32x4* o = (GAS f32x4*)(args.out + (size_t)m * D) + lane;
#pragma unroll
                    for (int j = 0; j < 8; ++j) o[64 * j] = v[j] * rstd * gr[64 * j];
#pragma unroll
                    for (int j = 0; j < 8; ++j) { xa[j] = xb_[j]; ya[j] = yc[j]; yb[j] = yd[j]; }
                    r = rn; rn = rnn; qn1 = qa; qn2 = qb;
                }
            }
        }
    }
}

__global__ void __launch_bounds__(NTHR, 2) trunk_fwd(Args args) {
    extern __shared__ __attribute__((aligned(16))) unsigned char lds_raw[];
    LAS unsigned char* lds = (LAS unsigned char*)lds_raw;
    volatile LAS unsigned* MISC = (volatile LAS unsigned*)(lds + MISC_OFF);
    const int tid = threadIdx.x, lane = tid & 63, wave = __builtin_amdgcn_readfirstlane(tid >> 6);
    const int G = gridDim.x, bx = blockIdx.x;
    const int gw = bx * NWAVES + wave, NGW = G * NWAVES;
    const int gtid = bx * NTHR + tid, NGT = G * NTHR;
    unsigned char* ws = args.ws;
    gu32* ctl = (gu32*)(ws + WS_CTL);
    for (int u = tid; u < (LDS_BYTES - LDSCTL_OFF) / 4; u += NTHR) ((LAS unsigned*)(lds + LDSCTL_OFF))[u] = 0u;
    __syncthreads();
    XcdBarrier bar; bar.bar = (unsigned*)(ctl + CW_BAR); bar.x = 0; bar.st = nullptr;
    if (!MK_PER_PHASE) bar = xcd_barrier_post((unsigned*)(ctl + CW_BAR), MISC + 8);
    const int lo = args.ph_lo, hi = args.ph_hi;
    if (tid == 0) { const unsigned xcc = xb_xcc_id() & 7u; const unsigned r = __hip_atomic_fetch_add(ctl + CW_XRANK + 64 * xcc, 1u, RLX_AGENT); MISC[12] = xcc + 8u * r; }

    const float* x_in = args.in[0];
    bf16* Win_t = (bf16*)(ws + WS_WIN); bf16* Wout_t = (bf16*)(ws + WS_WOUT); bf16* Wgate_t = (bf16*)(ws + WS_WGATE);
    bf16* DWgu = (bf16*)(ws + WS_DWGU); bf16* DWd = (bf16*)(ws + WS_DWD); bf16* MWgu = (bf16*)(ws + WS_MWGU); bf16* MWd = (bf16*)(ws + WS_MWD);
    float* X = (float*)(ws + WS_X); bf16* H = (bf16*)(ws + WS_H); bf16* U = (bf16*)(ws + WS_U); bf16* Y = (bf16*)(ws + WS_Y);
    bf16* HID = (bf16*)(ws + WS_HID); bf16* XG8 = (bf16*)(ws + WS_XG8); bf16* YB = (bf16*)(ws + WS_YB);
    int* ROUTE = (int*)(ws + WS_ROUTE); int* POS = (int*)(ws + WS_POS);

    if (IN(0)) REPS(0) {
        dense_convert_items(args, ws, 0, DC_N_EARLY, lds, gw, NGW, wave, lane);
        for (int m = gw; m < T; m += NGW) row_to_bf16_ssq(x_in + (size_t)m * D, H + (size_t)m * D, (float*)(ws + WS_SSQB) + (size_t)m * 8, lane);
    }
    SEAM(0);

    int vbx = bx;
    if (G == 256 && lo == 0 && hi > 1) {
        bool ok = true;
#pragma unroll
        for (int x = 0; x < 8; ++x) ok = ok && (__builtin_amdgcn_readfirstlane((int)__hip_atomic_load(ctl + CW_XRANK + 64 * x, RLX_AGENT)) == 32);
        const int v = __builtin_amdgcn_readfirstlane((int)MISC[12]);
        if (ok && v >= 0 && v < G) vbx = v;
    }
    Ctx C; C.vbx = vbx; C.lds = lds; C.ws = ws; C.ctl = ctl; C.tid = tid; C.lane = lane; C.wave = wave; C.G = G; C.bx = bx; C.gw = gw; C.NGW = NGW; C.gtid = gtid; C.NGT = NGT; C.lo = lo; C.hi = hi;
    layer_phases<0>(args, C, bar);
    layer_phases<1>(args, C, bar);
#undef IN
#undef SEAM
}

extern "C" void kernel_launch(void* const* d_in, const int* in_sizes, int n_in, void* d_out, int out_size, void* d_ws, size_t ws_size, hipStream_t stream) {
    static int grid = 0;
    if (grid == 0) {
        if (n_in != 24 || in_sizes[0] != T * D || out_size != T * D || ws_size < WS_END) { fprintf(stderr, "kernel_launch: unexpected shapes (n_in %d, in0 %d, out %d, ws %zu < %zu?); nothing launched\n", n_in, n_in > 0 ? in_sizes[0] : -1, out_size, ws_size, (size_t)WS_END); grid = -1; return; }
        int dev = 0, cus = 0, per_cu = 0;
        if (hipGetDevice(&dev) != hipSuccess || hipDeviceGetAttribute(&cus, hipDeviceAttributeMultiprocessorCount, dev) != hipSuccess) { grid = -1; return; }
        if (hipFuncSetAttribute((const void*)trunk_fwd, hipFuncAttributeMaxDynamicSharedMemorySize, LDS_BYTES) != hipSuccess) { fprintf(stderr, "kernel_launch: hipFuncSetAttribute failed\n"); grid = -1; return; }
        if (hipOccupancyMaxActiveBlocksPerMultiprocessor(&per_cu, (const void*)trunk_fwd, NTHR, LDS_BYTES) != hipSuccess || per_cu < 1) fprintf(stderr, "kernel_launch: occupancy query reports %d blocks per CU\n", per_cu);
        (void)hipGetLastError();
        grid = cus;
    }
    if (grid < 0) return;
    if (hipMemsetAsync((char*)d_ws + WS_CTL, 0, CTL_ZERO_BYTES, stream) != hipSuccess) return;
    Args a{};
    for (int i = 0; i < 24; ++i) a.in[i] = (const float*)d_in[i];
    a.out = (float*)d_out; a.ws = (unsigned char*)d_ws;
#if MK_PER_PHASE
    for (int p = 0; p < N_PHASES; ++p) { a.ph_lo = p; a.ph_hi = p + 1; hipLaunchKernelGGL(trunk_fwd, dim3(grid), dim3(NTHR), LDS_BYTES, stream, a); }
#else
    a.ph_lo = 0; a.ph_hi = N_PHASES;
    hipLaunchKernelGGL(trunk_fwd, dim3(grid), dim3(NTHR), LDS_BYTES, stream, a);
#endif
}
```

```cpp
#include <hip/hip_runtime.h>
#include <cstdio>
#include <cstdint>

#define NAIVE_CONV 0
#define NAIVE_LRU 0
#ifndef DENSE2_FP8
#define DENSE2_FP8 1
#endif
#ifndef GEMM_PV
#define GEMM_PV -1
#endif
#ifndef XPAD
#define XPAD 128
#endif
#ifndef PROBE_PHASE
#define PROBE_PHASE -1
#endif
#ifndef PROBE_N
#define PROBE_N 2
#endif
#ifndef PROBE_SUB
#define PROBE_SUB 0
#endif
#ifndef PROBE_SKIP_EPI
#define PROBE_SKIP_EPI 0
#endif
#ifndef MK_PER_PHASE
#define MK_PER_PHASE 0
#endif

namespace pg8 {
#define PG8_LAS __attribute__((address_space(3)))
typedef unsigned short bf16_t;
typedef short bf16x8 __attribute__((ext_vector_type(8)));
typedef float f32x4 __attribute__((ext_vector_type(4)));
typedef unsigned u32x4 __attribute__((ext_vector_type(4)));
typedef int v4i __attribute__((ext_vector_type(4)));
typedef int v8i __attribute__((ext_vector_type(8)));
typedef int v6i __attribute__((ext_vector_type(6)));
typedef int v2i __attribute__((ext_vector_type(2)));
typedef unsigned u32x2 __attribute__((ext_vector_type(2)));
constexpr int BM = 256, BK = 64, HALF = 128, HTB = HALF * BK * 2  , STAGE_BYTES = 8 * HTB, NXCD = 8, WGM = 6;

__host__ __device__ __forceinline__ int lds_byte(int r, int c) { const int st = (r >> 4) * 2 + (c >> 5), rr = r & 15, cc = c & 31, ob = rr * 64 + cc * 2; return st * 1024 + (ob ^ (((ob >> 9) & 1) << 5)); }
__host__ __device__ __forceinline__ void stage_rc(int b, int& R, int& C) { const int st = b / 1024, sb = b % 1024, swz = sb ^ (((sb >> 9) & 1) << 5); R = (st >> 1) * 16 + swz / 64; C = (st & 1) * 32 + (swz % 64) / 2; }
__host__ __device__ __forceinline__ int perm32(int rho) { const int n = rho >> 4, i = rho & 15; return 8 * (i >> 2) + 4 * n + (i & 3); }

struct Unit { int pm, pn; bool skip_epi; };
struct Gemm { const bf16_t* A; const bf16_t* Bt; int M, N, K; int lda = 0; };

struct StaticOrder {
    int nM, nN, nwg, G, c, rep = 1;
    int i0 = 0, i1 = 0x7fffffff;
    __host__ __device__ void init(int M, int N, int G_, int c_) { nM = M / BM; nN = N / BM; nwg = nM * nN; G = G_; c = c_; }
    __host__ __device__ bool next(int i, Unit& u) const {
        i += i0; if (i >= i1) return false;
        long L = (long)i * G + c; if (L >= (long)nwg * rep) return false;
        u.skip_epi = false;
        if (rep > 1) { u.skip_epi = PROBE_SKIP_EPI && (L >= nwg); L %= nwg; }
        int wgid = (int)L; { const int q = nwg / NXCD, r = nwg % NXCD, xcd = wgid % NXCD, off = wgid / NXCD; wgid = (xcd < r ? xcd * (q + 1) : r * (q + 1) + (xcd - r) * q) + off; }
        const int nig = WGM * nN, gid = wgid / nig, fm = gid * WGM, gsz = (nM - fm) < WGM ? (nM - fm) : WGM;
        u.pm = fm + ((wgid % nig) % gsz); u.pn = (wgid % nig) / gsz; return true;
    }
    __device__ __forceinline__ size_t b_off(const Unit&) const { return 0; }
    __device__ __forceinline__ int a_tile(const Unit& u) const { return u.pm; }
    __device__ __forceinline__ void a_ready(const Unit&) const {}
    __device__ __forceinline__ void done(const Unit&) const {}
};
struct MoeOrder : StaticOrder {
    int te[8]; int dg[7]; size_t estride;
    __device__ __forceinline__ size_t b_off(const Unit& u) const { int e = 0;
#pragma unroll
        for (int k = 0; k < 7; ++k) e += (u.pm >= te[k]) ? 1 : 0;
        return (size_t)e * estride; }
    __device__ __forceinline__ int a_tile(const Unit& u) const { int t = u.pm;
#pragma unroll
        for (int k = 0; k < 7; ++k) t += (u.pm >= te[k]) ? dg[k] : 0;
        return t; }
};

__device__ __forceinline__ unsigned cvt_pk_bf16(float lo, float hi) { unsigned r; asm volatile("v_cvt_pk_bf16_f32 %0, %1, %2" : "=v"(r) : "v"(lo), "v"(hi)); return r; }

constexpr float NORM_EPS = 1e-6f, NORM_INV_D = 1.0f / 2048.0f;
struct EpiBf16 {
    static constexpr bool PERM = true, AFTER_DRAIN = false;
    bf16_t* O; int ldc; const float* ssq;
    __device__ __forceinline__ void operator()(const f32x4 (&acc)[2][2][4][2], const Unit& u, int wr, int wc, int fr, int fq) const {
        const int row0 = u.pm * BM + wr * 64 + fr, col0 = u.pn * BM + wc * 32 + 8 * fq;
#pragma unroll
        for (int ai = 0; ai < 2; ++ai)
#pragma unroll
            for (int m = 0; m < 4; ++m) { bf16_t* rowp = O + (size_t)(row0 + ai * HALF + m * 16) * ldc + col0;
                float rs = 1.0f; if (ssq) { const f32x4* p = (const f32x4*)(ssq + (size_t)(row0 + ai * HALF + m * 16) * 8); const f32x4 a = p[0], b = p[1]; rs = __builtin_amdgcn_rsqf((((a[0] + a[1]) + (a[2] + a[3])) + ((b[0] + b[1]) + (b[2] + b[3]))) * NORM_INV_D + NORM_EPS); }
#pragma unroll
                for (int bj = 0; bj < 2; ++bj) { const f32x4 v0 = acc[ai][bj][m][0] * rs, v1 = acc[ai][bj][m][1] * rs;
                    u32x4 w; w.x = cvt_pk_bf16(v0[0], v0[1]); w.y = cvt_pk_bf16(v0[2], v0[3]); w.z = cvt_pk_bf16(v1[0], v1[1]); w.w = cvt_pk_bf16(v1[2], v1[3]);
                    *(u32x4*)(rowp + bj * HALF) = w; } }
    }
};
struct EpiInProj {
    static constexpr bool PERM = true, AFTER_DRAIN = false;
    bf16_t* O; int ldc; const float* ssq;
    __device__ __forceinline__ void operator()(const f32x4 (&acc)[2][2][4][2], const Unit& u, int wr, int wc, int fr, int fq) const {
        const int row0 = u.pm * BM + wr * 64 + fr;
        const bool glu = u.pn < 8;
        const int col0 = glu ? (u.pn * HALF + wc * 32 + 8 * fq) : (1024 + (u.pn - 8) * BM + wc * 32 + 8 * fq);
#pragma unroll
        for (int ai = 0; ai < 2; ++ai)
#pragma unroll
            for (int m = 0; m < 4; ++m) { bf16_t* rowp = O + (size_t)(row0 + ai * HALF + m * 16) * ldc + col0;
                float rs = 1.0f; if (ssq) { const f32x4* p = (const f32x4*)(ssq + (size_t)(row0 + ai * HALF + m * 16) * 8); const f32x4 a = p[0], b = p[1]; rs = __builtin_amdgcn_rsqf((((a[0] + a[1]) + (a[2] + a[3])) + ((b[0] + b[1]) + (b[2] + b[3]))) * NORM_INV_D + NORM_EPS); }
                if (glu) { float h[8];
#pragma unroll
                    for (int n = 0; n < 2; ++n)
#pragma unroll
                        for (int j = 0; j < 4; ++j) { const float v = acc[ai][0][m][n][j] * rs, g = acc[ai][1][m][n][j] * rs;
                            h[4 * n + j] = v * __builtin_amdgcn_rcpf(1.0f + __builtin_amdgcn_exp2f(-1.44269504089f * g)); }
                    u32x4 w; w.x = cvt_pk_bf16(h[0], h[1]); w.y = cvt_pk_bf16(h[2], h[3]); w.z = cvt_pk_bf16(h[4], h[5]); w.w = cvt_pk_bf16(h[6], h[7]);
                    *(u32x4*)rowp = w;
                } else {
#pragma unroll
                    for (int bj = 0; bj < 2; ++bj) { const f32x4 v0 = acc[ai][bj][m][0] * rs, v1 = acc[ai][bj][m][1] * rs;
                        u32x4 w; w.x = cvt_pk_bf16(v0[0], v0[1]); w.y = cvt_pk_bf16(v0[2], v0[3]); w.z = cvt_pk_bf16(v1[0], v1[1]); w.w = cvt_pk_bf16(v1[2], v1[3]);
                        *(u32x4*)(rowp + bj * HALF) = w; } } }
    }
};
struct EpiSwiGlu {
    static constexpr bool PERM = true, AFTER_DRAIN = false;
    bf16_t* O; int ldc;
    __device__ __forceinline__ void operator()(const f32x4 (&acc)[2][2][4][2], const Unit& u, int wr, int wc, int fr, int fq) const {
        const int row0 = u.pm * BM + wr * 64 + fr, col0 = u.pn * HALF + wc * 32 + 8 * fq;
#pragma unroll
        for (int ai = 0; ai < 2; ++ai)
#pragma unroll
            for (int m = 0; m < 4; ++m) { bf16_t* rowp = O + (size_t)(row0 + ai * HALF + m * 16) * ldc + col0;
                float h[8];
#pragma unroll
                for (int n = 0; n < 2; ++n)
#pragma unroll
                    for (int j = 0; j < 4; ++j) { const float g = acc[ai][0][m][n][j], v = acc[ai][1][m][n][j];
                        h[4 * n + j] = g * __builtin_amdgcn_rcpf(1.0f + __builtin_amdgcn_exp2f(-1.44269504089f * g)) * v; }
                u32x4 w; w.x = cvt_pk_bf16(h[0], h[1]); w.y = cvt_pk_bf16(h[2], h[3]); w.z = cvt_pk_bf16(h[4], h[5]); w.w = cvt_pk_bf16(h[6], h[7]);
                *(u32x4*)rowp = w; }
    }
};

__device__ __forceinline__ unsigned cvt4_fp8(float a, float b, float c, float d) { int w = 0; w = __builtin_amdgcn_cvt_pk_fp8_f32(a, b, w, false); w = __builtin_amdgcn_cvt_pk_fp8_f32(c, d, w, true); return (unsigned)w; }
struct EpiBf16S {
    static constexpr bool PERM = true, AFTER_DRAIN = false;
    bf16_t* O; int ldc; float sc;
    __device__ __forceinline__ void operator()(const f32x4 (&acc)[2][2][4][2], const Unit& u, int wr, int wc, int fr, int fq) const {
        const int row0 = u.pm * BM + wr * 64 + fr, col0 = u.pn * BM + wc * 32 + 8 * fq;
#pragma unroll
        for (int ai = 0; ai < 2; ++ai)
#pragma unroll
            for (int m = 0; m < 4; ++m) { bf16_t* rowp = O + (size_t)(row0 + ai * HALF + m * 16) * ldc + col0;
#pragma unroll
                for (int bj = 0; bj < 2; ++bj) { const f32x4 v0 = acc[ai][bj][m][0] * sc, v1 = acc[ai][bj][m][1] * sc;
                    u32x4 w; w.x = cvt_pk_bf16(v0[0], v0[1]); w.y = cvt_pk_bf16(v0[2], v0[3]); w.z = cvt_pk_bf16(v1[0], v1[1]); w.w = cvt_pk_bf16(v1[2], v1[3]);
                    *(u32x4*)(rowp + bj * HALF) = w; } }
    }
};
struct EpiSwiGlu8 {
    static constexpr bool PERM = true, AFTER_DRAIN = false;
    unsigned char* O; int ldc; float sc; const float* ssq;
    __device__ __forceinline__ void operator()(const f32x4 (&acc)[2][2][4][2], const Unit& u, int wr, int wc, int fr, int fq) const {
        const int row0 = u.pm * BM + wr * 64 + fr, col0 = u.pn * HALF + wc * 32 + 8 * fq;
#pragma unroll
        for (int ai = 0; ai < 2; ++ai)
#pragma unroll
            for (int m = 0; m < 4; ++m) { unsigned char* rowp = O + (size_t)(row0 + ai * HALF + m * 16) * ldc + col0;
                float rs = sc; if (ssq) { const f32x4* p = (const f32x4*)(ssq + (size_t)(row0 + ai * HALF + m * 16) * 8); const f32x4 a = p[0], b = p[1]; rs = sc * __builtin_amdgcn_rsqf((((a[0] + a[1]) + (a[2] + a[3])) + ((b[0] + b[1]) + (b[2] + b[3]))) * NORM_INV_D + NORM_EPS); }
                float h[8]; const float c1 = -1.44269504089f * rs, c2 = rs * rs;
#pragma unroll
                for (int n = 0; n < 2; ++n) { const f32x4 ag = acc[ai][0][m][n], av = acc[ai][1][m][n]; const f32x4 t = ag * c1; f32x4 e;
#pragma unroll
                    for (int j = 0; j < 4; ++j) e[j] = __builtin_amdgcn_exp2f(t[j]);
                    const f32x4 d = e + 1.0f; f32x4 r;
#pragma unroll
                    for (int j = 0; j < 4; ++j) r[j] = __builtin_amdgcn_rcpf(d[j]);
                    const f32x4 hq = (ag * av) * (r * c2);
#pragma unroll
                    for (int j = 0; j < 4; ++j) h[4 * n + j] = hq[j]; }
                u32x2 w; w.x = cvt4_fp8(h[0], h[1], h[2], h[3]); w.y = cvt4_fp8(h[4], h[5], h[6], h[7]);
                *(u32x2*)rowp = w; }
    }
};
struct EpiResF32 {
    static constexpr bool PERM = false, AFTER_DRAIN = false;
    const float* base; float* out; int ldc;
    __device__ __forceinline__ void operator()(const f32x4 (&acc)[2][2][4][2], const Unit& u, int wr, int wc, int fr, int fq) const {
        const int row0 = u.pm * BM + wr * 64 + fr, col0 = u.pn * BM + wc * 32 + 4 * fq;
#pragma unroll
        for (int ai = 0; ai < 2; ++ai)
#pragma unroll
            for (int m = 0; m < 4; ++m) { const size_t off = (size_t)(row0 + ai * HALF + m * 16) * ldc + col0;
#pragma unroll
                for (int bj = 0; bj < 2; ++bj)
#pragma unroll
                    for (int n = 0; n < 2; ++n) { const f32x4 bs = *(const f32x4*)(base + off + bj * HALF + n * 16); *(f32x4*)(out + off + bj * HALF + n * 16) = bs + acc[ai][bj][m][n]; }
                if (m == 3) asm volatile("" ::: "memory"); }
    }
};

struct EpiResNorm {
    static constexpr bool PERM = false, AFTER_DRAIN = false;
    const float* base; float* out; bf16_t* xb; float* ssq8; int ldc; float sc; PG8_LAS float* part;
    __device__ __forceinline__ void operator()(const f32x4 (&acc)[2][2][4][2], const Unit& u, int wr, int wc, int fr, int fq) const {
        const int row0 = u.pm * BM + wr * 64 + fr, col0 = u.pn * BM + wc * 32 + 4 * fq;
#pragma unroll
        for (int ai = 0; ai < 2; ++ai) {
            float q[4];
#pragma unroll
            for (int m = 0; m < 4; ++m) { const size_t off = (size_t)(row0 + ai * HALF + m * 16) * ldc + col0; q[m] = 0.f;
#pragma unroll
                for (int bj = 0; bj < 2; ++bj)
#pragma unroll
                    for (int n = 0; n < 2; ++n) { const f32x4 bs = *(const f32x4*)(base + off + bj * HALF + n * 16); const f32x4 v = bs + acc[ai][bj][m][n] * sc;
                        *(f32x4*)(out + off + bj * HALF + n * 16) = v; q[m] += (v[0] * v[0] + v[1] * v[1]) + (v[2] * v[2] + v[3] * v[3]);
                        u32x2 w; w.x = cvt_pk_bf16(v[0], v[1]); w.y = cvt_pk_bf16(v[2], v[3]); *(u32x2*)(xb + off + bj * HALF + n * 16) = w; } }
            asm volatile("" ::: "memory");
#pragma unroll
            for (int m = 0; m < 4; ++m) { float t = q[m]; t += __shfl_xor(t, 16); t += __shfl_xor(t, 32);
                if (fq == 0) part[(ai * HALF + wr * 64 + m * 16 + fr) * 4 + wc] = t; } }
        asm volatile("s_waitcnt lgkmcnt(0)" ::: "memory"); __builtin_amdgcn_s_barrier(); asm volatile("" ::: "memory");
        if (threadIdx.x < 256) { const PG8_LAS f32x4* p4 = (const PG8_LAS f32x4*)part + threadIdx.x; const f32x4 p = *p4;
            ssq8[(size_t)(u.pm * BM + threadIdx.x) * 8 + u.pn] = (p[0] + p[1]) + (p[2] + p[3]); }
    }
};
template <bool BASE_BF16> struct EpiResNormT {
    static constexpr bool PERM = false, AFTER_DRAIN = false;
    const void* base; bf16_t* xb; float* ssq8; int ldc; float sc; PG8_LAS float* part;
    __device__ __forceinline__ void operator()(const f32x4 (&acc)[2][2][4][2], const Unit& u, int wr, int wc, int fr, int fq) const {
        const int row0 = u.pm * BM + wr * 64 + fr, col0 = u.pn * BM + wc * 32 + 4 * fq;
        u32x2 bb[2][4][4];
        if constexpr (BASE_BF16) {
#pragma unroll
            for (int ai = 0; ai < 2; ++ai)
#pragma unroll
                for (int m = 0; m < 4; ++m)
#pragma unroll
                    for (int c = 0; c < 4; ++c) bb[ai][m][c] = *(const u32x2*)((const bf16_t*)base + (size_t)(row0 + ai * HALF + m * 16) * ldc + col0 + (c >> 1) * HALF + (c & 1) * 16);
            asm volatile("" ::: "memory"); }
#pragma unroll
        for (int ai = 0; ai < 2; ++ai) {
            float q[4];
#pragma unroll
            for (int m = 0; m < 4; ++m) { const size_t off = (size_t)(row0 + ai * HALF + m * 16) * ldc + col0; q[m] = 0.f;
#pragma unroll
                for (int bj = 0; bj < 2; ++bj)
#pragma unroll
                    for (int n = 0; n < 2; ++n) { f32x4 bs;
                        if constexpr (BASE_BF16) { const u32x2 b = bb[ai][m][bj * 2 + n];
                            bs[0] = __uint_as_float(b.x << 16); bs[1] = __uint_as_float(b.x & 0xffff0000u); bs[2] = __uint_as_float(b.y << 16); bs[3] = __uint_as_float(b.y & 0xffff0000u); }
                        else bs = *(const f32x4*)((const float*)base + off + bj * HALF + n * 16);
                        const f32x4 v = bs + acc[ai][bj][m][n] * sc;
                        u32x2 w; w.x = cvt_pk_bf16(v[0], v[1]); w.y = cvt_pk_bf16(v[2], v[3]); *(u32x2*)(xb + off + bj * HALF + n * 16) = w;
                        const float r0 = __uint_as_float(w.x << 16), r1 = __uint_as_float(w.x & 0xffff0000u), r2 = __uint_as_float(w.y << 16), r3 = __uint_as_float(w.y & 0xffff0000u);
                        q[m] += (r0 * r0 + r1 * r1) + (r2 * r2 + r3 * r3); } }
            asm volatile("" ::: "memory");
#pragma unroll
            for (int m = 0; m < 4; ++m) { float t = q[m]; t += __shfl_xor(t, 16); t += __shfl_xor(t, 32);
                if (fq == 0) part[(ai * HALF + wr * 64 + m * 16 + fr) * 4 + wc] = t; } }
        asm volatile("s_waitcnt lgkmcnt(0)" ::: "memory"); __builtin_amdgcn_s_barrier(); asm volatile("" ::: "memory");
        if (threadIdx.x < 256) { const PG8_LAS f32x4* p4 = (const PG8_LAS f32x4*)part + threadIdx.x; const f32x4 p = *p4;
            ssq8[(size_t)(u.pm * BM + threadIdx.x) * 8 + u.pn] = (p[0] + p[1]) + (p[2] + p[3]); }
    }
};
struct EpiResB16 {
    static constexpr bool PERM = false, AFTER_DRAIN = false;
    bf16_t* x; int ldc;
    __device__ __forceinline__ void operator()(const f32x4 (&acc)[2][2][4][2], const Unit& u, int wr, int wc, int fr, int fq) const {
        const int row0 = u.pm * BM + wr * 64 + fr, col0 = u.pn * BM + wc * 32 + 4 * fq;
        u32x2 bb[2][4][4];
#pragma unroll
        for (int ai = 0; ai < 2; ++ai)
#pragma unroll
            for (int m = 0; m < 4; ++m)
#pragma unroll
                for (int c = 0; c < 4; ++c) bb[ai][m][c] = *(const u32x2*)(x + (size_t)(row0 + ai * HALF + m * 16) * ldc + col0 + (c >> 1) * HALF + (c & 1) * 16);
        asm volatile("" ::: "memory");
#pragma unroll
        for (int ai = 0; ai < 2; ++ai)
#pragma unroll
            for (int m = 0; m < 4; ++m) { const size_t off = (size_t)(row0 + ai * HALF + m * 16) * ldc + col0;
#pragma unroll
                for (int bj = 0; bj < 2; ++bj)
#pragma unroll
                    for (int n = 0; n < 2; ++n) { u32x2* p = (u32x2*)(x + off + bj * HALF + n * 16); const u32x2 b = bb[ai][m][bj * 2 + n]; const f32x4 a = acc[ai][bj][m][n];
                        u32x2 w; w.x = cvt_pk_bf16(__uint_as_float(b.x << 16) + a[0], __uint_as_float(b.x & 0xffff0000u) + a[1]); w.y = cvt_pk_bf16(__uint_as_float(b.y << 16) + a[2], __uint_as_float(b.y & 0xffff0000u) + a[3]); *p = w; }
                if (m == 3) asm volatile("" ::: "memory"); }
    }
};
struct EpiResF32S {
    static constexpr bool PERM = false, AFTER_DRAIN = false;
    const float* base; float* out; int ldc; float sc;
    __device__ __forceinline__ void operator()(const f32x4 (&acc)[2][2][4][2], const Unit& u, int wr, int wc, int fr, int fq) const {
        const int row0 = u.pm * BM + wr * 64 + fr, col0 = u.pn * BM + wc * 32 + 4 * fq;
#pragma unroll
        for (int ai = 0; ai < 2; ++ai)
#pragma unroll
            for (int m = 0; m < 4; ++m) { const size_t off = (size_t)(row0 + ai * HALF + m * 16) * ldc + col0;
#pragma unroll
                for (int bj = 0; bj < 2; ++bj)
#pragma unroll
                    for (int n = 0; n < 2; ++n) { const f32x4 bs = *(const f32x4*)(base + off + bj * HALF + n * 16); *(f32x4*)(out + off + bj * HALF + n * 16) = bs + acc[ai][bj][m][n] * sc; }
                if (m == 3) asm volatile("" ::: "memory"); }
    }
};

template <class Epi, class Sched, bool ALIGN_EPI = false, bool SP2 = false, bool FP8 = false, int PV = 0, bool FP6 = false>
__device__ __forceinline__ void gemm_phase(PG8_LAS unsigned char* lds, const Gemm g, const Sched& S, const Epi& E) {
    const int tid = threadIdx.x, wid = __builtin_amdgcn_readfirstlane(tid >> 6), lane = tid & 63, wr = wid >> 2, wc = wid & 3, fr = lane & 15, fq = lane >> 4;
    const int K = g.K, nt = K / BK, LDA = g.lda ? g.lda : g.K;
    unsigned voffA[2], voffB[2];
#pragma unroll
    for (int i = 0; i < 2; ++i) { int R, C; stage_rc(tid * 16 + i * 8192, R, C); const int Rb = Epi::PERM ? ((R & ~31) + perm32(R & 31)) : R;
        voffA[i] = (unsigned)(R * LDA + C) * 2u; voffB[i] = (unsigned)(Rb * K + C) * 2u; }
    const size_t kstep = (size_t)(BK * 2);
    const size_t hstep = (size_t)HALF * K * 2;
    const size_t tstep = 2 * hstep;
    const size_t hstepA = (size_t)HALF * LDA * 2, tstepA = 2 * hstepA;
    const unsigned ldsw = (unsigned)wid * 1024u;
    const int aoff = lds_byte(wr * 64 + fr, fq * 8), boff = lds_byte(wc * 32 + fr, fq * 8);
    const unsigned abase6 = (unsigned)(unsigned long)(lds + aoff), bbase6 = (unsigned)(unsigned long)(lds + 4 * HTB + boff);
#define PG8_SA(b, h) (((b) * 2 + (h)) * HTB)
#define PG8_SB(b, h) ((4 + (b) * 2 + (h)) * HTB)
#define PG8_STAGE(bufoff, gbase, voff) do { if constexpr (PV != 2) _Pragma("unroll") for (int _i = 0; _i < 2; ++_i) \
        __builtin_amdgcn_global_load_lds((const unsigned*)((const char*)(gbase) + (voff)[_i]), (PG8_LAS unsigned*)(lds + (bufoff) + ldsw + _i * 8192), 16, 0, 0); } while (0)
#define PG8_LDA(dst, b, h) do { if constexpr (PV == 3) {} else if constexpr (FP6) { _Pragma("unroll") for (int m = 0; m < 4; ++m) { v4i lo_; v2i hi_; \
            asm volatile("ds_read_b128 %0, %2 offset:%3\n\tds_read_b64 %1, %2 offset:%4" : "=&v"(lo_), "=&v"(hi_) : "v"(abase6), "n"(PG8_SA(b, h) + m * 2048), "n"(PG8_SA(b, h) + m * 2048 + 1024)); \
            dst##6[m] = __builtin_shufflevector(lo_, __builtin_shufflevector(hi_, hi_, 0, 1, -1, -1), 0, 1, 2, 3, 4, 5); } } \
        else if constexpr (FP8) { _Pragma("unroll") for (int m = 0; m < 4; ++m) { dst##8[m].lo = *(const PG8_LAS v4i*)(lds + PG8_SA(b, h) + aoff + m * 2048); dst##8[m].hi = *(const PG8_LAS v4i*)(lds + PG8_SA(b, h) + aoff + m * 2048 + 1024); } } \
        else { _Pragma("unroll") for (int m = 0; m < 4; ++m) _Pragma("unroll") for (int k = 0; k < 2; ++k) dst[m][k] = *(const PG8_LAS bf16x8*)(lds + PG8_SA(b, h) + aoff + m * 2048 + k * 1024); } } while (0)
#define PG8_LDB(dst, b, h) do { if constexpr (PV == 3) {} else if constexpr (FP6) { _Pragma("unroll") for (int n = 0; n < 2; ++n) { v4i lo_; v2i hi_; \
            asm volatile("ds_read_b128 %0, %2 offset:%3\n\tds_read_b64 %1, %2 offset:%4" : "=&v"(lo_), "=&v"(hi_) : "v"(bbase6), "n"(PG8_SB(b, h) - 4 * HTB + n * 2048), "n"(PG8_SB(b, h) - 4 * HTB + n * 2048 + 1024)); \
            dst##6[n] = __builtin_shufflevector(lo_, __builtin_shufflevector(hi_, hi_, 0, 1, -1, -1), 0, 1, 2, 3, 4, 5); } } \
        else if constexpr (FP8) { _Pragma("unroll") for (int n = 0; n < 2; ++n) { dst##8[n].lo = *(const PG8_LAS v4i*)(lds + PG8_SB(b, h) + boff + n * 2048); dst##8[n].hi = *(const PG8_LAS v4i*)(lds + PG8_SB(b, h) + boff + n * 2048 + 1024); } } \
        else { _Pragma("unroll") for (int n = 0; n < 2; ++n) _Pragma("unroll") for (int k = 0; k < 2; ++k) dst[n][k] = *(const PG8_LAS bf16x8*)(lds + PG8_SB(b, h) + boff + n * 2048 + k * 1024); } } while (0)
#define PG8_MMA(ai, bj, At, Bt) do { __builtin_amdgcn_s_setprio(1); \
        if constexpr (PV == 1) { _Pragma("unroll") for (int m = 0; m < 4; ++m) _Pragma("unroll") for (int k = 0; k < 2; ++k) asm volatile("" :: "v"(At[m][k])); _Pragma("unroll") for (int n = 0; n < 2; ++n) _Pragma("unroll") for (int k = 0; k < 2; ++k) asm volatile("" :: "v"(Bt[n][k])); } \
        else if constexpr (FP6) { _Pragma("unroll") for (int m = 0; m < 4; ++m) _Pragma("unroll") for (int n = 0; n < 2; ++n) \
            asm volatile("v_mfma_scale_f32_16x16x128_f8f6f4 %0, %1, %2, %0, %3, %3 op_sel_hi:[0,0,0] cbsz:2 blgp:2" : "+v"(acc[ai][bj][m][n]) : "v"(Bt##6[n]), "v"(At##6[m]), "v"(sc1)); } \
        else if constexpr (FP8) { _Pragma("unroll") for (int m = 0; m < 4; ++m) _Pragma("unroll") for (int n = 0; n < 2; ++n) \
            asm volatile("v_mfma_scale_f32_16x16x128_f8f6f4 %0, %1, %2, %0, %3, %3 op_sel_hi:[0,0,0]" : "+v"(acc[ai][bj][m][n]) : "v"(Bt##8[n]), "v"(At##8[m]), "v"(sc1)); } \
        else { _Pragma("unroll") for (int m = 0; m < 4; ++m) _Pragma("unroll") for (int n = 0; n < 2; ++n) _Pragma("unroll") for (int k = 0; k < 2; ++k) \
            acc[ai][bj][m][n] = __builtin_amdgcn_mfma_f32_16x16x32_bf16(Bt[n][k], At[m][k], acc[ai][bj][m][n], 0, 0, 0); } \
        __builtin_amdgcn_s_setprio(0); } while (0)
#define PG8_WAIT_V(n) asm volatile("s_waitcnt vmcnt(" #n ")" ::: "memory")
#define PG8_WAIT_L(n) asm volatile("s_waitcnt lgkmcnt(" #n ")" ::: "memory")
#define PG8_BAR __builtin_amdgcn_s_barrier()
#define PG8_SCHED __builtin_amdgcn_sched_barrier(0)
    Unit cur, nxt; int ui = 0;
    if (!S.next(0, cur)) return;
    f32x4 acc[2][2][4][2];
#pragma unroll
    for (int a = 0; a < 2; ++a)
#pragma unroll
        for (int b = 0; b < 2; ++b)
#pragma unroll
            for (int m = 0; m < 4; ++m)
#pragma unroll
                for (int n = 0; n < 2; ++n) acc[a][b][m][n] = (f32x4){0.f, 0.f, 0.f, 0.f};
    const int sc1 = 0x7f7f7f7f;
    bf16x8 At[4][2], B0[2][2], B1[2][2];
    v8i At8[4], B08[2], B18[2];
    v6i At6[4], B06[2], B16[2];
    if constexpr (PV == 3) {
#pragma unroll
        for (int m = 0; m < 4; ++m)
#pragma unroll
            for (int k = 0; k < 2; ++k) At[m][k] = (bf16x8){0, 0, 0, 0, 0, 0, 0, 0};
#pragma unroll
        for (int n = 0; n < 2; ++n)
#pragma unroll
            for (int k = 0; k < 2; ++k) { B0[n][k] = (bf16x8){0, 0, 0, 0, 0, 0, 0, 0}; B1[n][k] = B0[n][k]; } }
    const char* cA = (const char*)g.A + (size_t)S.a_tile(cur) * tstepA; const char* cB = (const char*)g.Bt + S.b_off(cur) + (size_t)cur.pn * tstep;
    S.a_ready(cur);
    if constexpr (SP2) {
        PG8_STAGE(PG8_SB(0, 0), cB, voffB); PG8_STAGE(PG8_SB(0, 1), cB + hstep, voffB); PG8_STAGE(PG8_SA(0, 0), cA, voffA); PG8_STAGE(PG8_SA(0, 1), cA + hstepA, voffA);
        if (wr == 1) PG8_BAR;
        PG8_WAIT_V(2); PG8_BAR;
        PG8_STAGE(PG8_SB(1, 0), cB + kstep, voffB); PG8_STAGE(PG8_SA(1, 0), cA + kstep, voffA); PG8_STAGE(PG8_SB(1, 1), cB + hstep + kstep, voffB);
        PG8_WAIT_V(6); PG8_BAR;
    } else {
        PG8_STAGE(PG8_SB(0, 0), cB, voffB); PG8_STAGE(PG8_SA(0, 0), cA, voffA); PG8_STAGE(PG8_SB(0, 1), cB + hstep, voffB); PG8_STAGE(PG8_SA(0, 1), cA + hstepA, voffA);
        if (wr == 1) PG8_BAR;
        PG8_WAIT_V(4); PG8_BAR;
        PG8_STAGE(PG8_SB(1, 0), cB + kstep, voffB); PG8_STAGE(PG8_SA(1, 0), cA + kstep, voffA); PG8_STAGE(PG8_SB(1, 1), cB + hstep + kstep, voffB);
        PG8_WAIT_V(6); PG8_BAR;
    }
    for (;;) {
        const bool has_next = S.next(ui + 1, nxt);
        const char* nA = has_next ? (const char*)g.A + (size_t)S.a_tile(nxt) * tstepA : cA; const char* nB = has_next ? (const char*)g.Bt + S.b_off(nxt) + (size_t)nxt.pn * tstep : cB;
        for (int t = 0; t < nt; t += 2) {
            const bool last = (t == nt - 2);
            const char* a1 = cA + (size_t)(t + 1) * kstep;
            const char* a2 = last ? nA : cA + (size_t)(t + 2) * kstep; const char* b2 = last ? nB : cB + (size_t)(t + 2) * kstep;
            const char* a3 = a2 + kstep; const char* b3 = b2 + kstep;
            if (last && has_next) S.a_ready(nxt);
            if constexpr (SP2) {
            PG8_LDB(B0, 0, 0); PG8_LDB(B1, 0, 1); PG8_SCHED; PG8_LDA(At, 0, 0); PG8_STAGE(PG8_SA(1, 1), a1 + hstepA, voffA);
            PG8_WAIT_V(8); PG8_WAIT_L(0); PG8_BAR; PG8_MMA(0, 0, At, B0); PG8_MMA(0, 1, At, B1); PG8_BAR; PG8_SCHED;
            PG8_LDA(At, 0, 1); PG8_STAGE(PG8_SB(0, 0), b2, voffB); PG8_STAGE(PG8_SB(0, 1), b2 + hstep, voffB); PG8_STAGE(PG8_SA(0, 0), a2, voffA);
            PG8_WAIT_V(8); PG8_WAIT_L(0); PG8_BAR; PG8_MMA(1, 0, At, B0); PG8_MMA(1, 1, At, B1); PG8_BAR; PG8_SCHED;
            PG8_LDB(B0, 1, 0); PG8_LDB(B1, 1, 1); PG8_SCHED; PG8_LDA(At, 1, 0); PG8_STAGE(PG8_SA(0, 1), a2 + hstepA, voffA);
            PG8_WAIT_V(8); PG8_WAIT_L(0); PG8_BAR; PG8_MMA(0, 0, At, B0); PG8_MMA(0, 1, At, B1); PG8_BAR; PG8_SCHED;
            PG8_LDA(At, 1, 1); PG8_STAGE(PG8_SB(1, 0), b3, voffB); PG8_STAGE(PG8_SB(1, 1), b3 + hstep, voffB); PG8_STAGE(PG8_SA(1, 0), a3, voffA);
            PG8_WAIT_V(8); PG8_WAIT_L(0); PG8_BAR; PG8_MMA(1, 0, At, B0); PG8_MMA(1, 1, At, B1); PG8_BAR; PG8_SCHED;
            } else {
            PG8_LDB(B0, 0, 0); PG8_SCHED; PG8_LDA(At, 0, 0); PG8_STAGE(PG8_SA(1, 1), a1 + hstepA, voffA);
            PG8_WAIT_L(8); PG8_BAR; PG8_WAIT_L(0); PG8_MMA(0, 0, At, B0); PG8_BAR; PG8_SCHED;
            PG8_LDB(B1, 0, 1); PG8_STAGE(PG8_SB(0, 0), b2, voffB);
            PG8_BAR; PG8_WAIT_L(0); PG8_MMA(0, 1, At, B1); PG8_BAR;
            PG8_LDA(At, 0, 1); PG8_STAGE(PG8_SA(0, 0), a2, voffA);
            PG8_BAR; PG8_WAIT_L(0); PG8_MMA(1, 0, At, B0); PG8_BAR; PG8_SCHED;
            PG8_STAGE(PG8_SB(0, 1), b2 + hstep, voffB);
            PG8_WAIT_V(6); PG8_BAR; PG8_MMA(1, 1, At, B1); PG8_BAR;
            PG8_LDB(B0, 1, 0); PG8_SCHED; PG8_LDA(At, 1, 0); PG8_STAGE(PG8_SA(0, 1), a2 + hstepA, voffA);
            PG8_WAIT_L(8); PG8_BAR; PG8_WAIT_L(0); PG8_MMA(0, 0, At, B0); PG8_BAR; PG8_SCHED;
            PG8_LDB(B1, 1, 1); PG8_STAGE(PG8_SB(1, 0), b3, voffB);
            PG8_BAR; PG8_WAIT_L(0); PG8_MMA(0, 1, At, B1); PG8_BAR;
            PG8_LDA(At, 1, 1); PG8_STAGE(PG8_SA(1, 0), a3, voffA);
            PG8_BAR; PG8_WAIT_L(0); PG8_MMA(1, 0, At, B0); PG8_BAR; PG8_SCHED;
            PG8_STAGE(PG8_SB(1, 1), b3 + hstep, voffB);
            PG8_WAIT_V(6); PG8_BAR; PG8_MMA(1, 1, At, B1); PG8_BAR;
            }
        }
        if constexpr (ALIGN_EPI) { if (wr == 0) PG8_BAR; }
        if constexpr (FP8) asm volatile("s_nop 15\n\ts_nop 15" ::: "memory");
        if constexpr (PV == 0) { if (!cur.skip_epi) { E(acc, cur, wr, wc, fr, fq); } } else { asm volatile("" :: "v"(acc[0][0][0][0]), "v"(acc[1][1][3][1])); } S.done(cur);
        if (!has_next) break;
#pragma unroll
        for (int a = 0; a < 2; ++a)
#pragma unroll
            for (int b = 0; b < 2; ++b)
#pragma unroll
                for (int m = 0; m < 4; ++m)
#pragma unroll
                    for (int n = 0; n < 2; ++n) acc[a][b][m][n] = (f32x4){0.f, 0.f, 0.f, 0.f};
        cur = nxt; cA = nA; cB = nB; ++ui;
        if constexpr (ALIGN_EPI) { if (wr == 1) PG8_BAR; }
    }
    PG8_WAIT_V(0);
    if constexpr (!ALIGN_EPI) { if (wr == 0) PG8_BAR; }
    PG8_BAR;
#undef PG8_SA
#undef PG8_SB
#undef PG8_STAGE
#undef PG8_LDA
#undef PG8_LDB
#undef PG8_MMA
#undef PG8_WAIT_V
#undef PG8_WAIT_L
#undef PG8_BAR
#undef PG8_SCHED
}
}

constexpr int NWAVES = 8, NTHR = NWAVES * 64;
constexpr int D = 2048, BATCH = 2, SEQ = 8192, T = BATCH * SEQ, DEPTH = 2;
constexpr int CW = 1024, LW = 1024, LH = 8, LHD = 128, DIN = 4096, CK = 31, LK = 4;
constexpr int UW = 3 * 1024;
constexpr int DFF = 6144, NE = 8;
constexpr float EPS = 1e-6f, LRU_C = 8.0f;
constexpr int MOE_ROWS_MAX = T * 2 + NE * 256;
constexpr float MOE_SC_A = 2.0f;
constexpr float MOE_SC_GU = 64.0f, MOE_SC_D = 128.0f;

constexpr size_t MiB = 1u << 20;
constexpr size_t WS_CTL = 0, CTL_ZERO_BYTES = 1 * MiB;
constexpr size_t WS_WIN = 2 * MiB;
constexpr size_t WS_WOUT = 34 * MiB;
constexpr size_t WS_WGATE = 50 * MiB;
constexpr size_t WS_DWGU = 52 * MiB;
constexpr size_t WS_DWD = 100 * MiB;
constexpr size_t WS_MWGU = 124 * MiB;
constexpr size_t WS_MWD = 316 * MiB;
constexpr size_t WS_X = 700 * MiB;
constexpr size_t WS_H = 828 * MiB;
constexpr size_t WS_ROUTE = 892 * MiB;
constexpr size_t WS_POS = WS_ROUTE + 512 * 1024;
constexpr size_t WS_HAGG = 893 * MiB;
constexpr size_t WS_CAGG = 894 * MiB;
constexpr size_t WS_SSQA = 895 * MiB, WS_SSQB = 895 * MiB + 512 * 1024;
constexpr size_t WS_XG8 = 412 * MiB;
constexpr size_t WS_YB = 896 * MiB;
constexpr size_t WS_XG = WS_YB;
constexpr size_t WS_BIG = 1032 * MiB;
constexpr size_t WS_U = WS_BIG;
constexpr size_t WS_Y = WS_BIG + 128 * MiB;
constexpr size_t WS_P1 = WS_BIG + 192 * MiB;
constexpr size_t WS_P2 = WS_BIG + 224 * MiB;
constexpr size_t WS_HID = WS_BIG;
constexpr size_t WS_END = 1440 * MiB;
constexpr size_t WS_NCONV = WS_XG;
constexpr size_t WS_NRX = WS_XG + 64 * MiB;
constexpr size_t WS_NA = WS_BIG + 256 * MiB;
constexpr size_t WS_NB = WS_BIG + 320 * MiB;
static_assert(WS_NB + 64 * MiB <= WS_END && WS_XG8 + (size_t)NE * T * (D + 128) <= WS_X, "ws map");
constexpr int CW_TMO = 0, CW_CODE = 1;
constexpr int CW_BAR = 4096;
constexpr int CW_CNT = 8192;
constexpr int CW_CUR = 8192 + 1024;
constexpr int CW_XRANK = 8192 + 2048;

constexpr int RING_OFF = 0, RING_BYTES = 131072;
constexpr int LDS_BYTES = 147456;
constexpr int LDSCTL_OFF = LDS_BYTES - 512, MISC_OFF = LDSCTL_OFF + 64;
constexpr int MX_PITCH = 1040, MX_RX = 0, MX_GG = 64 * MX_PITCH, MX_RED = 2 * 64 * MX_PITCH, MX_MR = MX_RED + 2048;
static_assert(MX_MR + 256 <= LDSCTL_OFF, "mixer LDS map");

#define GAS __attribute__((address_space(1)))
#define LAS __attribute__((address_space(3)))
typedef unsigned short bf16;
typedef unsigned v4u __attribute__((ext_vector_type(4)));
typedef unsigned v2u __attribute__((ext_vector_type(2)));
typedef float f32x4 __attribute__((ext_vector_type(4)));
typedef float f32x2 __attribute__((ext_vector_type(2)));
typedef short bf16x8 __attribute__((ext_vector_type(8)));
typedef GAS unsigned gu32;
#define RLX_AGENT __ATOMIC_RELAXED, __HIP_MEMORY_SCOPE_AGENT
#define LDS_WAIT() asm volatile("s_waitcnt lgkmcnt(0)" ::: "memory")
#define VM_WAIT() asm volatile("s_waitcnt vmcnt(0)" ::: "memory")
__device__ __forceinline__ unsigned f2bf(float f) { unsigned u = __builtin_bit_cast(unsigned, f); return (u + 0x7fffu + ((u >> 16) & 1u)) >> 16; }
__device__ __forceinline__ unsigned pk2(float lo, float hi) { unsigned r; asm("v_cvt_pk_bf16_f32 %0, %1, %2" : "=v"(r) : "v"(lo), "v"(hi)); return r; }
__device__ __forceinline__ float bf_lo(unsigned w) { return __uint_as_float(w << 16); }
__device__ __forceinline__ float bf_hi(unsigned w) { return __uint_as_float(w & 0xffff0000u); }
__device__ __forceinline__ float bf2f(bf16 b) { return __uint_as_float(((unsigned)b) << 16); }
__device__ __forceinline__ float sigmoidf_(float x) { return __builtin_amdgcn_rcpf(1.0f + __builtin_amdgcn_exp2f(-1.44269504089f * x)); }
__device__ __forceinline__ float gelu_tanh(float x) { const float u = 0.7978845608f * (x + 0.044715f * x * x * x); return x * sigmoidf_(2.0f * u); }

#define XB_TMO      128
#define XB_XCNT(j)  (256  + 64 * (j))
#define XB_XSUB(j)  (1280 + 64 * (j))
#define XB_XGEN(j)  (2304 + 64 * (j))
#define XB_TOP      3328
#define XB_TOPGEN   3392
#define XCD_BAR_WORDS 3456
#define XB_SPIN_CAP (1u << 18)
__device__ __forceinline__ unsigned xb_ld(unsigned* p)              { return __hip_atomic_load(p, __ATOMIC_RELAXED, __HIP_MEMORY_SCOPE_AGENT); }
__device__ __forceinline__ unsigned xb_add(unsigned* p, unsigned v) { return __hip_atomic_fetch_add(p, v, __ATOMIC_RELAXED, __HIP_MEMORY_SCOPE_AGENT); }
__device__ __forceinline__ unsigned xb_xcc_id() { return (unsigned)__builtin_amdgcn_s_getreg((3 << 11) | 20) & 0xFu; }
#define XB_SPIN(cond, bar) do { unsigned _sp = 0; while (cond) { __builtin_amdgcn_s_sleep(1); \
    if ((++_sp & 255u) == 0u) { if (xb_ld(&(bar)[XB_TMO])) break; if (_sp > XB_SPIN_CAP) { atomicAdd(&(bar)[XB_TMO], 1u); break; } } } } while (0)
struct XcdBarrier { unsigned* bar; unsigned x; volatile LAS unsigned* st; };
__device__ __forceinline__ XcdBarrier xcd_barrier_post(unsigned* bar, volatile LAS unsigned* st) {
    XcdBarrier b; b.bar = bar; b.x = xb_xcc_id(); b.st = st;
    if (threadIdx.x == 0) (void)xb_add(&bar[XB_XCNT(b.x)], 1u);
    return b;
}
__device__ __forceinline__ void xcd_barrier_complete(unsigned* bar, unsigned x, unsigned& nloc, unsigned& nx) {
    const unsigned G = gridDim.x * gridDim.y * gridDim.z;
    unsigned sum, cnt, mine, sp = 0u;
    for (;;) {
        sum = 0u; cnt = 0u; mine = 0u;
#pragma unroll
        for (unsigned j = 0; j < 16; ++j) { const unsigned c = xb_ld(&bar[XB_XCNT(j)]); sum += c; cnt += (c > 0u) ? 1u : 0u; mine = (j == x) ? c : mine; }
        if (sum == G) break;
        __builtin_amdgcn_s_sleep(1);
        if ((++sp & 255u) == 0u) { if (xb_ld(&bar[XB_TMO])) break; if (sp > XB_SPIN_CAP) { atomicAdd(&bar[XB_TMO], 1u); break; } }
    }
    nloc = mine > 0u ? mine : 1u; nx = cnt > 0u ? cnt : 1u;
}
__device__ __forceinline__ void xcd_barrier(const XcdBarrier& b) {
    asm volatile("s_waitcnt vmcnt(0)" ::: "memory");
    __syncthreads();
    if (threadIdx.x == 0) {
        unsigned* bar = b.bar;
        __builtin_amdgcn_s_waitcnt(0);
        unsigned nloc = b.st[0], nx = b.st[1];
        if (nloc == 0u) { xcd_barrier_complete(bar, b.x, nloc, nx); b.st[0] = nloc; b.st[1] = nx; }
        const unsigned old = xb_add(&bar[XB_XSUB(b.x)], 1u);
        const unsigned gen = old / nloc;
        if (old + 1u == (gen + 1u) * nloc) {
            __builtin_amdgcn_fence(__ATOMIC_RELEASE, "agent");
            asm volatile("s_waitcnt vmcnt(0)" ::: "memory");
            const unsigned og = xb_add(&bar[XB_TOP], 1u);
            const unsigned tg = og / nx;
            if (og + 1u == (tg + 1u) * nx) xb_add(&bar[XB_TOPGEN], 1u);
            else XB_SPIN(xb_ld(&bar[XB_TOPGEN]) == tg, bar);
            __builtin_amdgcn_fence(__ATOMIC_ACQUIRE, "agent");
            xb_add(&bar[XB_XGEN(b.x)], 1u);
            asm volatile("s_waitcnt vmcnt(0)" ::: "memory");
        } else {
            XB_SPIN(xb_ld(&bar[XB_XGEN(b.x)]) == gen, bar);
            __builtin_amdgcn_fence(__ATOMIC_ACQUIRE, "agent");
            asm volatile("s_waitcnt vmcnt(0)" ::: "memory");
        }
    }
    __syncthreads();
}

__device__ __forceinline__ float wave_sum(float v) {
#pragma unroll
    for (int o = 1; o < 64; o <<= 1) v += __shfl_xor(v, o);
    return v;
}

constexpr int CW_ = 1024;
__device__ __forceinline__ void tr_item(const float* __restrict__ W, int K, int N, bf16* WT, int mode, int item, LAS unsigned* scr, int lane, const float* kgain = nullptr) {
    const int nblk = N >> 6, kb = item / nblk, nb = item - kb * nblk, k0 = kb << 6, n0 = nb << 6;
    const int q = lane & 15, r = lane >> 4;
    f32x4 A[8], B[8];
#pragma unroll
    for (int i = 0; i < 8; ++i) { const float* p = W + (size_t)(k0 + 2 * (4 * i + r)) * N + n0 + 4 * q; A[i] = __builtin_nontemporal_load((const GAS f32x4*)p); B[i] = __builtin_nontemporal_load((const GAS f32x4*)(p + N)); }
    if (kgain) {
#pragma unroll
        for (int i = 0; i < 8; ++i) { const f32x2 g2 = *(const GAS f32x2*)(kgain + k0 + 2 * (4 * i + r)); A[i] *= g2.x; B[i] *= g2.y; } }
#pragma unroll
    for (int i = 0; i < 8; ++i)
#pragma unroll
        for (int j = 0; j < 4; ++j) scr[(4 * q + j) * 32 + ((4 * i + r) ^ (4 * (q & 7)))] = pk2(A[i][j], B[i][j]);
    LDS_WAIT(); asm volatile("" ::: "memory");
    const int c = lane & 7;
#pragma unroll
    for (int jj = 0; jj < 8; ++jj) { const int n = (lane >> 3) + 8 * jj; const v4u o = *(const LAS v4u*)(scr + n * 32 + 4 * (c ^ ((n >> 2) & 7)));
        const int ng = n0 + n; int row = mode == 0 ? ng : ((ng >> 7) * 256 + (ng & 127) + (mode == 2 ? 128 : 0));
        if (mode == 3) row = ng >= 2 * CW_ ? ng : (ng < CW_ ? ((ng >> 7) * 256 + (ng & 127)) : ((((ng - CW_) >> 7) * 256) + 128 + ((ng - CW_) & 127)));
        *(GAS v4u*)(WT + (size_t)row * K + k0 + 8 * c) = o; }
    LDS_WAIT(); asm volatile("" ::: "memory");
}


__device__ __forceinline__ unsigned cvt4_fp8(float a, float b, float c, float d) { int w = 0; w = __builtin_amdgcn_cvt_pk_fp8_f32(a, b, w, false); w = __builtin_amdgcn_cvt_pk_fp8_f32(c, d, w, true); return (unsigned)w; }
__device__ __forceinline__ void tr_item8(const float* __restrict__ W, int K, int N, unsigned char* WT, int mode, int item, LAS unsigned* scr, int lane, float sc) {
    const int nblk = N >> 5, kb = item / nblk, nb = item - kb * nblk, k0 = kb << 7, n0 = nb << 5;
    const int q = lane & 7, r = lane >> 3;
#pragma unroll
    for (int i = 0; i < 4; ++i) { const int p = 8 * i + r; const float* src = W + (size_t)(k0 + 4 * p) * N + n0 + 4 * q;
        const f32x4 R0 = __builtin_nontemporal_load((const GAS f32x4*)src), R1 = __builtin_nontemporal_load((const GAS f32x4*)(src + N)), R2 = __builtin_nontemporal_load((const GAS f32x4*)(src + 2 * (size_t)N)), R3 = __builtin_nontemporal_load((const GAS f32x4*)(src + 3 * (size_t)N));
#pragma unroll
        for (int j = 0; j < 4; ++j) scr[(4 * q + j) * 32 + (p ^ (4 * q))] = cvt4_fp8(R0[j] * sc, R1[j] * sc, R2[j] * sc, R3[j] * sc); }
    LDS_WAIT(); asm volatile("" ::: "memory");
    const int c = lane & 7;
#pragma unroll
    for (int jj = 0; jj < 4; ++jj) { const int n = (lane >> 3) + 8 * jj; const v4u o = *(const LAS v4u*)(scr + n * 32 + 4 * (c ^ ((n >> 2) & 7)));
        const int ng = n0 + n; const int row = mode == 0 ? ng : ((ng >> 7) * 256 + (ng & 127) + (mode == 2 ? 128 : 0));
        *(GAS v4u*)(WT + (size_t)row * K + k0 + 16 * c) = o; }
    LDS_WAIT(); asm volatile("" ::: "memory");
}

__device__ __forceinline__ void row_to_bf16_ssq(const float* xrow, bf16* orow, float* ssq8row, int lane) {
    const GAS f32x4* xr = (const GAS f32x4*)xrow + lane;
    f32x4 v[8]; float s = 0.f;
#pragma unroll
    for (int j = 0; j < 8; ++j) v[j] = xr[64 * j];
    GAS v2u* o8 = (GAS v2u*)orow + lane;
#pragma unroll
    for (int j = 0; j < 8; ++j) { v2u o; o.x = pk2(v[j].x, v[j].y); o.y = pk2(v[j].z, v[j].w); o8[64 * j] = o;
        const float r0 = bf_lo(o.x), r1 = bf_hi(o.x), r2 = bf_lo(o.y), r3 = bf_hi(o.y); s += (r0 * r0 + r1 * r1) + (r2 * r2 + r3 * r3); }
    s = wave_sum(s);
    if (lane < 2) ((GAS f32x4*)ssq8row)[lane] = (f32x4){lane == 0 ? s : 0.f, 0.f, 0.f, 0.f};
}
__device__ __forceinline__ void rms_row_to_bf16(const float* xrow, const float* gain, bf16* orow, int lane) {
    const GAS f32x4* xr = (const GAS f32x4*)xrow + lane; const GAS f32x4* gr = (const GAS f32x4*)gain + lane;
    f32x4 v[8]; float s = 0.f;
#pragma unroll
    for (int j = 0; j < 8; ++j) { v[j] = xr[64 * j]; s += (v[j].x * v[j].x + v[j].y * v[j].y) + (v[j].z * v[j].z + v[j].w * v[j].w); }
    const float rstd = 1.0f / sqrtf(wave_sum(s) * (1.0f / D) + EPS);
    GAS v2u* o8 = (GAS v2u*)orow + lane;
#pragma unroll
    for (int j = 0; j < 8; ++j) { const f32x4 g = gr[64 * j]; v2u o; o.x = pk2(v[j].x * rstd * g.x, v[j].y * rstd * g.y); o.y = pk2(v[j].z * rstd * g.z, v[j].w * rstd * g.w); o8[64 * j] = o; }
}


__device__ __forceinline__ float transpose_reduce64(float (&v)[64], int lane) {
#pragma unroll
    for (int d = 32; d >= 1; d >>= 1) {
        const bool up = (lane & d) != 0;
#pragma unroll
        for (int i = 0; i < d; ++i) { float x = v[i], y = v[i + d]; asm volatile("" : "+v"(x), "+v"(y));
            const float keep = up ? y : x; const float send = up ? x : y; v[i] = keep + __shfl_xor(send, d); }
    }
    return v[0];
}

__device__ __forceinline__ float transpose_reduce32(float (&v)[32], int lane) {
#pragma unroll
    for (int i = 0; i < 32; ++i) v[i] += __shfl_xor(v[i], 32);
#pragma unroll
    for (int d = 16; d >= 1; d >>= 1) {
        const bool up = (lane & d) != 0;
#pragma unroll
        for (int i = 0; i < d; ++i) { float x = v[i], y = v[i + d]; asm volatile("" : "+v"(x), "+v"(y));
            const float keep = up ? y : x; const float send = up ? x : y; v[i] = keep + __shfl_xor(send, d); }
    }
    return v[0];
}

__device__ __forceinline__ void conv_unit(const bf16* U, bf16* Y, const float* conv_w, const float* conv_b, const float* lng, const float* lnb, int tile, LAS unsigned char* lds, int tid, int lane, int wave) {
    LAS float* red = (LAS float*)(lds + MX_RED);
    LAS float* mr = (LAS float*)(lds + MX_MR);
    const int r0 = tile * 64, tl0 = r0 & (SEQ - 1), c0 = 2 * tid;
    for (int chunk = 0; chunk < 2; ++chunk) {
        const int rb = r0 + 32 * chunk; const bool head = (tl0 + 32 * chunk) == 0;
        f32x2 w[CK];
#pragma unroll
        for (int k = 0; k < CK; ++k) w[k] = *(const GAS f32x2*)(conv_w + k * CW + c0);
        const f32x2 bias = *(const GAS f32x2*)(conv_b + c0);
        f32x2 acc[32];
#pragma unroll
        for (int o = 0; o < 32; ++o) acc[o] = bias;
        const GAS unsigned* up = (const GAS unsigned*)(U + (size_t)rb * UW + c0);
        unsigned vb[2][4];
#pragma unroll
        for (int jj = 0; jj < 4; ++jj) { const long ro = head ? 0 : (long)(jj - 30); vb[0][jj] = up[ro * (UW / 2)]; }
#pragma unroll
        for (int jb = 0; jb < 16; ++jb) {
            if (jb < 15) {
#pragma unroll
                for (int jj = 0; jj < 4; ++jj) { const int j = 4 * (jb + 1) + jj; if (j < 62) { const long ro = (head && j < 30) ? 0 : (long)(j - 30); vb[(jb + 1) & 1][jj] = up[ro * (UW / 2)]; } } }
            const unsigned (&vv)[4] = vb[jb & 1];
#pragma unroll
            for (int jj = 0; jj < 4; ++jj) { const int j = 4 * jb + jj; if (j < 62) {
                f32x2 glu; glu.x = bf_lo(vv[jj]); glu.y = bf_hi(vv[jj]);
                if (head && j < 30) glu = (f32x2){0.f, 0.f};
#pragma unroll
                for (int o = 0; o < 32; ++o) { const int k = j - o; if (k >= 0 && k < CK) acc[o] += w[k] * glu; } } }
        }
        { float v[32];
#pragma unroll
          for (int o = 0; o < 32; ++o) v[o] = acc[o].x + acc[o].y;
          const float t1 = transpose_reduce32(v, lane); if (lane < 32) red[wave * 64 + lane] = t1;
#pragma unroll
          for (int o = 0; o < 32; ++o) v[o] = acc[o].x * acc[o].x + acc[o].y * acc[o].y;
          const float t2 = transpose_reduce32(v, lane); if (lane < 32) red[wave * 64 + 32 + lane] = t2; }
        __syncthreads();
        if (tid < 32) { float s1 = 0.f, s2 = 0.f;
#pragma unroll
            for (int wv = 0; wv < 8; ++wv) { s1 += red[wv * 64 + tid]; s2 += red[wv * 64 + 32 + tid]; }
            const float mean = s1 * (1.0f / CW); const float var = fmaxf(s2 * (1.0f / CW) - mean * mean, 0.f);
            mr[2 * tid] = mean; mr[2 * tid + 1] = __builtin_amdgcn_rsqf(var + EPS); }
        __syncthreads();
        const f32x2 lg = *(const GAS f32x2*)(lng + c0), lb = *(const GAS f32x2*)(lnb + c0);
        GAS unsigned* yp = (GAS unsigned*)(Y + (size_t)rb * D + c0);
#pragma unroll
        for (int o = 0; o < 32; ++o) { const float mean = mr[2 * o], rstd = mr[2 * o + 1];
            const float z0 = (acc[o].x - mean) * rstd * lg.x + lb.x, z1 = (acc[o].y - mean) * rstd * lg.y + lb.y;
            yp[(size_t)o * (D / 2)] = pk2(z0 * sigmoidf_(z0), z1 * sigmoidf_(z1)); }
        __syncthreads();
    }
}

__device__ __forceinline__ void lru_unit(const bf16* U, bf16* P1, bf16* P2, float* HAGG, float* CAGG, const bf16* WgT  ,
                                         const float* lcw, const float* lcb, const float* ba, const float* bxx, const float* lam, int tile, LAS unsigned char* lds, int tid, int lane, int wave) {
    const int r0 = tile * 64, tl0 = r0 & (SEQ - 1);
    const int fr = lane & 15, fq = lane >> 4;
    for (int hh = 0; hh < 2; ++hh) {
        { const int cp = tid & 255, th = tid >> 8, c = 512 * hh + 2 * cp;
          f32x2 w4[LK];
#pragma unroll
          for (int k = 0; k < LK; ++k) w4[k] = *(const GAS f32x2*)(lcw + k * LW + c);
          const f32x2 b4 = *(const GAS f32x2*)(lcb + c);
          const bool head = (tl0 == 0) && (th == 0);
          const GAS unsigned* up = (const GAS unsigned*)(U + (size_t)(r0 + 32 * th) * UW + CW + c);
          f32x2 win[3];
#pragma unroll
          for (int i = 0; i < 3; ++i) { const unsigned u = head ? 0u : up[(long)(i - 3) * (UW / 2)]; win[i] = (f32x2){bf_lo(u), bf_hi(u)}; }
          LAS unsigned* rxw = (LAS unsigned*)(lds + MX_RX + (32 * th) * MX_PITCH + 4 * cp);
          LAS unsigned* ggw = (LAS unsigned*)(lds + MX_GG + (32 * th) * MX_PITCH + 4 * cp);
#pragma unroll 8
          for (int i = 0; i < 32; ++i) { const unsigned u = up[(long)i * (UW / 2)], gt = up[(long)i * (UW / 2) + CW / 2];
              const f32x2 cur = (f32x2){bf_lo(u), bf_hi(u)};
              const f32x2 rx = b4 + w4[0] * win[0] + w4[1] * win[1] + w4[2] * win[2] + w4[3] * cur;
              win[0] = win[1]; win[1] = win[2]; win[2] = cur;
              rxw[i * (MX_PITCH / 4)] = pk2(rx.x, rx.y);
              ggw[i * (MX_PITCH / 4)] = pk2(gelu_tanh(bf_lo(gt)), gelu_tanh(bf_hi(gt))); } }
        __syncthreads();
        { const int hl = wave >> 1, hd = 4 * hh + hl, nb = 64 * (wave & 1);
          const bf16* WaT = WgT + (size_t)hd * LHD * LHD; const bf16* WxT = WgT + (size_t)(LH + hd) * LHD * LHD;
          bf16x8 bA[4], bX[4]; float ba_c, bx_c, lam_c;
#pragma unroll
          for (int ks = 0; ks < 4; ++ks) { bA[ks] = *(const GAS bf16x8*)(WaT + (size_t)(nb + fr) * LHD + 32 * ks + 8 * fq); bX[ks] = *(const GAS bf16x8*)(WxT + (size_t)(nb + fr) * LHD + 32 * ks + 8 * fq); }
          ba_c = ba[LHD * hd + nb + fr]; bx_c = bxx[LHD * hd + nb + fr]; lam_c = lam[LHD * hd + nb + fr];
#pragma unroll 1
          for (int nt = 0; nt < 4; ++nt) {
              const int n0 = nb + 16 * nt, ch = LHD * hd + n0 + fr, lcol = LHD * hl + n0 + fr;
              f32x4 aa[4], ax[4];
#pragma unroll
              for (int m = 0; m < 4; ++m) { aa[m] = (f32x4){0.f, 0.f, 0.f, 0.f}; ax[m] = aa[m]; }
#pragma unroll
              for (int ks = 0; ks < 4; ++ks)
#pragma unroll
                  for (int m = 0; m < 4; ++m) { const bf16x8 af = *(const LAS bf16x8*)(lds + MX_RX + (16 * m + fr) * MX_PITCH + (LHD * hl + 32 * ks + 8 * fq) * 2);
                      aa[m] = __builtin_amdgcn_mfma_f32_16x16x32_bf16(af, bA[ks], aa[m], 0, 0, 0); ax[m] = __builtin_amdgcn_mfma_f32_16x16x32_bf16(af, bX[ks], ax[m], 0, 0, 0); }
              const float ba_u = ba_c, bx_u = bx_c, lam_u = lam_c;
              if (nt < 3) {
                  asm volatile("" ::: "memory");
#pragma unroll
                  for (int ks = 0; ks < 4; ++ks) { bA[ks] = *(const GAS bf16x8*)(WaT + (size_t)(n0 + 16 + fr) * LHD + 32 * ks + 8 * fq); bX[ks] = *(const GAS bf16x8*)(WxT + (size_t)(n0 + 16 + fr) * LHD + 32 * ks + 8 * fq); }
                  ba_c = ba[ch + 16]; bx_c = bxx[ch + 16]; lam_c = lam[ch + 16]; }
              const float nl = -lam_u; const float sp8 = LRU_C * (fmaxf(nl, 0.f) + __logf(1.0f + __expf(-fabsf(nl))));
              const LAS bf16* rxr = (const LAS bf16*)(lds + MX_RX) + lcol; const LAS bf16* ggr = (const LAS bf16*)(lds + MX_GG) + lcol;
              float hl4[4][4], cl4[4][4], A[4], B[4];
#pragma unroll
              for (int m = 0; m < 4; ++m) { float h = 0.f, cp = 1.f;
#pragma unroll
                  for (int j = 0; j < 4; ++j) { const int tt = 16 * m + 4 * fq + j;
                      const float ga = sigmoidf_(aa[m][j] + ba_u), gx = sigmoidf_(ax[m][j] + bx_u);
                      const float la = -sp8 * ga, a = __builtin_amdgcn_exp2f(1.44269504089f * la);
                      const float x2 = 2.0f * la;
                      const float om_s = -x2 * (1.0f + x2 * (0.5f + x2 * (0.16666667f + x2 * (0.041666668f + x2 * 0.0083333338f))));
                      const float om = (x2 > -0.25f) ? om_s : (1.0f - a * a);
                      float mult = __builtin_amdgcn_sqrtf(fmaxf(om, 0.f)); if (tl0 == 0 && tt == 0) mult = 1.0f;
                      const float b = mult * gx * bf2f(rxr[tt * (MX_PITCH / 2)]);
                      h = a * h + b; cp *= a; hl4[m][j] = h; cl4[m][j] = cp; }
                  A[m] = cp; B[m] = h; }
#pragma unroll
              for (int m = 0; m < 4; ++m) { const float Ap = __shfl_up(A[m], 16), Bp = __shfl_up(B[m], 16); if (fq >= 1) { B[m] = A[m] * Bp + B[m]; A[m] = A[m] * Ap; } }
#pragma unroll
              for (int m = 0; m < 4; ++m) { const float Ap = __shfl_up(A[m], 32), Bp = __shfl_up(B[m], 32); if (fq >= 2) { B[m] = A[m] * Bp + B[m]; A[m] = A[m] * Ap; } }
              float TA[4], TB[4], EA[4], EB[4];
#pragma unroll
              for (int m = 0; m < 4; ++m) { TA[m] = __shfl(A[m], 48 + fr); TB[m] = __shfl(B[m], 48 + fr); EA[m] = __shfl_up(A[m], 16); EB[m] = __shfl_up(B[m], 16); if (fq == 0) { EA[m] = 1.f; EB[m] = 0.f; } }
              float Hc = 0.f, Cc = 1.f;
#pragma unroll
              for (int m = 0; m < 4; ++m) { const float Hin = EA[m] * Hc + EB[m], Cin = EA[m] * Cc;
#pragma unroll
                  for (int j = 0; j < 4; ++j) { const int tt = 16 * m + 4 * fq + j; const float g = bf2f(ggr[tt * (MX_PITCH / 2)]);
                      const float hf = hl4[m][j] + cl4[m][j] * Hin, cf = cl4[m][j] * Cin;
                      { const unsigned w = pk2(hf * g, cf * g); P1[(size_t)(r0 + tt) * LW + ch] = (bf16)(w & 0xffffu); P2[(size_t)(r0 + tt) * LW + ch] = (bf16)(w >> 16); } }
                  Hc = TA[m] * Hc + TB[m]; Cc = TA[m] * Cc; }
              if (fq == 0) { HAGG[(size_t)tile * LW + ch] = Hc; CAGG[(size_t)tile * LW + ch] = Cc; }
          } }
        __syncthreads();
    }
}

__device__ __forceinline__ void lru_fix_unit(const bf16* P1, const bf16* P2, const float* HAGG, const float* CAGG, bf16* Y, int tile, LAS unsigned char* lds, int tid) {
    const int tb = tile & ~(SEQ / 64 - 1), j = tile & (SEQ / 64 - 1);
    const int cg = tid & 127, ts = tid >> 7;
    float A[8], B[8];
#pragma unroll
    for (int q = 0; q < 8; ++q) { A[q] = 1.f; B[q] = 0.f; }
    const int i0 = (j * ts) >> 2, i1 = (j * (ts + 1)) >> 2;
    for (int i = i0; i < i1; ++i) { const GAS f32x4* cp = (const GAS f32x4*)(CAGG + (size_t)(tb + i) * LW + 8 * cg); const GAS f32x4* hp = (const GAS f32x4*)(HAGG + (size_t)(tb + i) * LW + 8 * cg);
        const f32x4 c0 = cp[0], c1 = cp[1], h0 = hp[0], h1 = hp[1];
#pragma unroll
        for (int q = 0; q < 4; ++q) { B[q] = c0[q] * B[q] + h0[q]; A[q] *= c0[q]; B[4 + q] = c1[q] * B[4 + q] + h1[q]; A[4 + q] *= c1[q]; } }
    LAS float* part = (LAS float*)lds;
#pragma unroll
    for (int q = 0; q < 8; ++q) { part[(ts * 128 + cg) * 16 + q] = A[q]; part[(ts * 128 + cg) * 16 + 8 + q] = B[q]; }
    __syncthreads();
    float hin[8];
#pragma unroll
    for (int q = 0; q < 8; ++q) hin[q] = 0.f;
#pragma unroll
    for (int sgm = 0; sgm < 4; ++sgm)
#pragma unroll
        for (int q = 0; q < 8; ++q) hin[q] = part[(sgm * 128 + cg) * 16 + q] * hin[q] + part[(sgm * 128 + cg) * 16 + 8 + q];
    __syncthreads();
    const int r0 = tile * 64;
#pragma unroll 4
    for (int tt = ts; tt < 64; tt += 4) { const v4u p1 = *(const GAS v4u*)(P1 + (size_t)(r0 + tt) * LW + 8 * cg), p2 = *(const GAS v4u*)(P2 + (size_t)(r0 + tt) * LW + 8 * cg);
        v4u o;
        o.x = pk2(bf_lo(p1.x) + bf_lo(p2.x) * hin[0], bf_hi(p1.x) + bf_hi(p2.x) * hin[1]); o.y = pk2(bf_lo(p1.y) + bf_lo(p2.y) * hin[2], bf_hi(p1.y) + bf_hi(p2.y) * hin[3]);
        o.z = pk2(bf_lo(p1.z) + bf_lo(p2.z) * hin[4], bf_hi(p1.z) + bf_hi(p2.z) * hin[5]); o.w = pk2(bf_lo(p1.w) + bf_lo(p2.w) * hin[6], bf_hi(p1.w) + bf_hi(p2.w) * hin[7]);
        *(GAS v4u*)(Y + (size_t)(r0 + tt) * D + CW + 8 * cg) = o; }
}


struct MoeItem { const float* W; unsigned char* WT; int K, N, mode, item; float sc; };
__device__ __forceinline__ MoeItem moe_item(int it, const float* wg, const float* wu, const float* wd, unsigned char* MWgu8, unsigned char* MWd8) {
    constexpr int I_GU = (D / 128) * (DFF / 128), I_DN = (DFF / 128) * (D / 128), N_MGU = NE * 2 * I_GU;
    MoeItem m;
    if (it < N_MGU) { const int e = it / (2 * I_GU), rr = it % (2 * I_GU), w = rr / I_GU; m.W = (w == 0 ? wg : wu) + (size_t)e * D * DFF; m.WT = MWgu8 + (size_t)e * 2 * DFF * D; m.K = D; m.N = DFF; m.mode = 1 + w; m.item = rr % I_GU; m.sc = MOE_SC_GU; }
    else { const int r = it - N_MGU, e = r / I_DN; m.W = wd + (size_t)e * DFF * D; m.WT = MWd8 + (size_t)e * D * DFF; m.K = DFF; m.N = D; m.mode = 0; m.item = r % I_DN; m.sc = MOE_SC_D; }
    return m;
}
__device__ __forceinline__ void tr8_load(const MoeItem& m, int sblk, f32x4 (&R)[16], int lane) {
    const int nblk = m.N >> 7, kb = m.item / nblk, nb = m.item - kb * nblk, k0 = (kb << 7) + 32 * sblk, n0 = nb << 7, q = lane & 31, r = lane >> 5;
#pragma unroll
    for (int i = 0; i < 4; ++i) { const float* src = m.W + (size_t)(k0 + 4 * (2 * i + r)) * m.N + n0 + 4 * q;
#pragma unroll
        for (int x = 0; x < 4; ++x) R[4 * i + x] = __builtin_nontemporal_load((const GAS f32x4*)(src + (size_t)x * m.N)); }
}
__device__ __forceinline__ void tr8_sub(const MoeItem& m, int sblk, const f32x4 (&R)[16], LAS unsigned* scr, int lane) {
    const int q = lane & 31, r = lane >> 5; const float sc = m.sc;
#pragma unroll
    for (int i = 0; i < 4; ++i) { const int p = 8 * sblk + 2 * i + r;
#pragma unroll
        for (int j = 0; j < 4; ++j) scr[(4 * q + j) * 32 + (p ^ (4 * (q & 7)))] = cvt4_fp8(R[4 * i][j] * sc, R[4 * i + 1][j] * sc, R[4 * i + 2][j] * sc, R[4 * i + 3][j] * sc); }
}
__device__ __forceinline__ void tr8_store(const MoeItem& m, LAS unsigned* scr, int lane) {
    const int nblk = m.N >> 7, kb = m.item / nblk, nb = m.item - kb * nblk, k0 = kb << 7, n0 = nb << 7;
    LDS_WAIT(); asm volatile("" ::: "memory");
    const int c = lane & 7;
#pragma unroll
    for (int jj = 0; jj < 16; ++jj) { const int n = (lane >> 3) + 8 * jj; const v4u o = *(const LAS v4u*)(scr + n * 32 + 4 * (c ^ ((n >> 2) & 7)));
        const int ng = n0 + n; const int row = m.mode == 0 ? ng : ((ng >> 7) * 256 + (ng & 127) + (m.mode == 2 ? 128 : 0));
        __builtin_nontemporal_store(o, (GAS v4u*)(m.WT + (size_t)row * m.K + k0 + 16 * c)); }
    LDS_WAIT(); asm volatile("" ::: "memory");
}
typedef float v16f __attribute__((ext_vector_type(16)));
typedef unsigned v6u __attribute__((ext_vector_type(6)));
__device__ __forceinline__ void tr6_load(const MoeItem& m, int sblk, f32x2 (&R)[32], int lane) {
    const int nblk = m.N >> 7, kb = m.item / nblk, nb = m.item - kb * nblk, k0 = 16 * kb + 4 * sblk, n0 = nb << 7;
    const __amdgpu_buffer_rsrc_t rs = __builtin_amdgcn_make_buffer_rsrc((void*)m.W, 0, m.K * m.N * 4, 0x00020000);
    const int vo = (n0 + 2 * lane) * 4, rowb = m.N * 4, so0 = k0 * rowb;
#pragma unroll
    for (int t = 0; t < 32; ++t) { const v2u w = __builtin_amdgcn_raw_buffer_load_b64(rs, vo, so0 + ((t & 3) + 256 * (t >> 2)) * rowb, 2  ); R[t] = (f32x2){__uint_as_float(w.x), __uint_as_float(w.y)}; }
}
__device__ __forceinline__ void tr6_sub(const MoeItem& m, int sblk, const f32x2 (&R)[32], LAS unsigned* scr, int lane) {
    const float sc = m.sc;
#pragma unroll
    for (int b = 0; b < 2; ++b) { v16f x, y;
#pragma unroll
        for (int k = 0; k < 16; ++k) { x[k] = R[k][b]; y[k] = R[16 + k][b]; }
        v6u d; asm volatile("v_cvt_scalef32_2xpk16_fp6_f32 %0, %1, %2, %3" : "=&v"(d) : "v"(x), "v"(y), "v"(1.0f / sc));
        const int row = 2 * lane + b, sw = (row >> 2) & 7;
        LAS unsigned* p1 = scr + row * 32 + 4 * (sblk ^ sw); LAS unsigned* p2 = scr + row * 32 + 4 * ((4 + sblk) ^ sw);
        p1[0] = d[0]; p1[1] = d[1]; p1[2] = d[2]; p1[3] = d[3]; p2[0] = d[4]; p2[1] = d[5]; }
}
__device__ __forceinline__ void moe_convert_share(const float* wg, const float* wu, const float* wd, unsigned char* MWgu8, unsigned char* MWd8, LAS unsigned char* lds, int gw, int NGW, int wave, int lane) {
    LAS unsigned* scr = (LAS unsigned*)(lds + RING_OFF + wave * 16384);
    constexpr int N_MGU = NE * 2 * (D / 128) * (DFF / 128), NTOT = N_MGU + NE * (DFF / 128) * (D / 128);
    int it = gw;
    { f32x2 Qa[32], Qb[32];
      for (; it < N_MGU; it += NGW) {
        const MoeItem m = moe_item(it, wg, wu, wd, MWgu8, MWd8);
        tr6_load(m, 0, Qa, lane);
        tr6_load(m, 1, Qb, lane); tr6_sub(m, 0, Qa, scr, lane);
        tr6_load(m, 2, Qa, lane); tr6_sub(m, 1, Qb, scr, lane);
        tr6_load(m, 3, Qb, lane); tr6_sub(m, 2, Qa, scr, lane);
        tr6_sub(m, 3, Qb, scr, lane);
        tr8_store(m, scr, lane);
      } }
    f32x4 Ra[16], Rb[16];
    for (; it < NTOT; it += NGW) {
        const MoeItem m = moe_item(it, wg, wu, wd, MWgu8, MWd8);
        tr8_load(m, 0, Ra, lane);
        tr8_load(m, 1, Rb, lane); tr8_sub(m, 0, Ra, scr, lane);
        tr8_load(m, 2, Ra, lane); tr8_sub(m, 1, Rb, scr, lane);
        tr8_load(m, 3, Rb, lane); tr8_sub(m, 2, Ra, scr, lane);
        tr8_sub(m, 3, Rb, scr, lane);
        tr8_store(m, scr, lane);
    }
}

struct Args { const float* in[24]; float* out; unsigned char* ws; int ph_lo, ph_hi; };
constexpr int N_PHASES = 15;

constexpr int DC_I_IN = (D / 64) * (DIN / 64), DC_I_OUT = (D / 64) * (D / 64), DC_I_GU = (D / 64) * (DFF / 64), DC_I_DN = (DFF / 64) * (D / 64), DC_I_GT = 4;
constexpr int DC_N_GT = DEPTH * 2 * LH * DC_I_GT, DC_N_EARLY = DC_I_IN + DC_N_GT, DC_N_ALL = DC_N_EARLY + DC_I_IN + 2 * DC_I_OUT + 2 * DC_I_GU + DC_I_DN;
__device__ __forceinline__ void dense_convert_items(const Args& args, unsigned char* ws, int lo, int hi, LAS unsigned char* lds, int gw, int NGW, int wave, int lane) {
    LAS unsigned* scr = (LAS unsigned*)(lds + RING_OFF + wave * 8192);
    bf16* Win_t = (bf16*)(ws + WS_WIN); bf16* Wout_t = (bf16*)(ws + WS_WOUT); bf16* Wgate_t = (bf16*)(ws + WS_WGATE); bf16* DWgu = (bf16*)(ws + WS_DWGU); bf16* DWd = (bf16*)(ws + WS_DWD);
    for (int it = lo + gw; it < hi; it += NGW) {
        int r = it;
        if (r < DC_I_IN) { tr_item(args.in[2], D, DIN, Win_t, 3, r, scr, lane, args.in[1]); continue; } r -= DC_I_IN;
        if (r < DC_N_GT) { const int m = r / DC_I_GT;
            const int l = m / 16, ax = (m / 8) & 1, h = m & 7;
            tr_item((ax == 0 ? args.in[9] : args.in[11]) + (size_t)(l * LH + h) * LHD * LHD, LHD, LHD, Wgate_t + (size_t)m * LHD * LHD, 0, r % DC_I_GT, scr, lane); continue; } r -= DC_N_GT;
        if (r < DC_I_IN) { tr_item(args.in[2] + (size_t)D * DIN, D, DIN, Win_t + (size_t)DIN * D, 3, r, scr, lane, args.in[1] + D); continue; } r -= DC_I_IN;
        if (r < 2 * DC_I_OUT) { const int l = r / DC_I_OUT; tr_item(args.in[14] + (size_t)l * D * D, D, D, Wout_t + (size_t)l * D * D, 0, r % DC_I_OUT, scr, lane); continue; } r -= 2 * DC_I_OUT;
        if (r < 2 * DC_I_GU) { const int w = r / DC_I_GU; tr_item(w == 0 ? args.in[16] : args.in[17], D, DFF, DWgu, 1 + w, r % DC_I_GU, scr, lane, args.in[15]); continue; } r -= 2 * DC_I_GU;
#if DENSE2_FP8
        tr_item8(args.in[18], DFF, D, (unsigned char*)DWd, 0, r, scr, lane, MOE_SC_D);
#else
        tr_item(args.in[18], DFF, D, DWd, 0, r, scr, lane);
#endif
    }
}


#define IN(k) (lo <= (k) && (k) < hi)
#define REPS(k) for (int rep_ = 0; rep_ < (((k) == PROBE_PHASE) ? PROBE_N : 1); ++rep_)
#define SEAM(k) do { if (IN(k) && IN((k) + 1)) xcd_barrier(bar); } while (0)
struct Ctx { LAS unsigned char* lds; unsigned char* ws; gu32* ctl; int tid, lane, wave, G, bx, gw, NGW, gtid, NGT, lo, hi, vbx; };
template <int L> __device__ __forceinline__ void layer_phases(const Args& args, const Ctx& C, const XcdBarrier& bar) {
    LAS unsigned char* lds = C.lds; unsigned char* ws = C.ws; gu32* ctl = C.ctl;
    const int tid = C.tid, lane = C.lane, wave = C.wave, G = C.G, bx = C.bx, gw = C.gw, NGW = C.NGW, gtid = C.gtid, NGT = C.NGT, lo = C.lo, hi = C.hi, vbx = C.vbx;
    const float* x_in = args.in[0];
    bf16* Win_t = (bf16*)(ws + WS_WIN); bf16* Wout_t = (bf16*)(ws + WS_WOUT); bf16* Wgate_t = (bf16*)(ws + WS_WGATE);
    bf16* DWgu = (bf16*)(ws + WS_DWGU); bf16* DWd = (bf16*)(ws + WS_DWD); bf16* MWgu = (bf16*)(ws + WS_MWGU); bf16* MWd = (bf16*)(ws + WS_MWD);
    float* X = (float*)(ws + WS_X); bf16* H = (bf16*)(ws + WS_H); bf16* U = (bf16*)(ws + WS_U); bf16* Y = (bf16*)(ws + WS_Y);
    bf16* HID = (bf16*)(ws + WS_HID); bf16* XG8 = (bf16*)(ws + WS_XG8); bf16* YB = (bf16*)(ws + WS_YB);
    int* ROUTE = (int*)(ws + WS_ROUTE); int* POS = (int*)(ws + WS_POS);

    {
        constexpr int l = L, pb = 1 + 6 * L;
        if (IN(pb)) REPS(pb) {
            pg8::Gemm g{H, Win_t + (size_t)l * DIN * D, T, DIN, D}; pg8::StaticOrder S; S.init(T, DIN, G, vbx);
            pg8::EpiInProj E{U, UW, (const float*)(ws + WS_SSQB)};
            if constexpr (L == 0) {
                const int rounds = (S.nwg + G - 1) / G, grp = (vbx * 4) / G, cut = (rounds * grp) / 4;
                S.i0 = 0; S.i1 = cut;
                pg8::gemm_phase<pg8::EpiInProj, pg8::StaticOrder, true, true>(lds + RING_OFF, g, S, E);
                dense_convert_items(args, ws, DC_N_EARLY, DC_N_ALL, lds, gw, NGW, wave, lane);
                __syncthreads();
                S.i0 = cut; S.i1 = 0x7fffffff;
            }
            pg8::gemm_phase<pg8::EpiInProj, pg8::StaticOrder, true, true>(lds + RING_OFF, g, S, E);
#if GEMM_PV >= 0
            if (L == 0) { __syncthreads(); pg8::gemm_phase<pg8::EpiInProj, pg8::StaticOrder, true, true, false, GEMM_PV>(lds + RING_OFF, g, S, E); }
#endif
        }
        SEAM(pb);
        if (IN(pb + 1)) { constexpr int TR = (PROBE_PHASE == pb + 1) ? PROBE_N : 1;
            const float* conv_w = args.in[3] + (size_t)l * CK * CW; const float* conv_b = args.in[4] + (size_t)l * CW;
            const float* lcw = args.in[7] + (size_t)l * LK * LW; const float* lcb = args.in[8] + (size_t)l * LW;
#if NAIVE_CONV || NAIVE_LRU
            float* NCONV = (float*)(ws + WS_NCONV); float* NRX = (float*)(ws + WS_NRX);
            for (int idx = gtid; idx < T * CW; idx += NGT) {
                const int t = idx >> 10, c = idx & 1023, tl = t & (SEQ - 1);
                float s = conv_b[c];
                for (int k = 0; k < CK; ++k) { const int tt = tl - (CK - 1) + k; if (tt >= 0) { const size_t ro = (size_t)(t - (CK - 1) + k) * DIN; const float v = bf2f(U[ro + c]), gt = bf2f(U[ro + CW + c]); s += conv_w[k * CW + c] * (v * sigmoidf_(gt)); } }
                NCONV[idx] = s;
                float r = lcb[c];
                for (int k = 0; k < LK; ++k) { const int tt = tl - (LK - 1) + k; if (tt >= 0) r += lcw[k * LW + c] * bf2f(U[(size_t)(t - (LK - 1) + k) * DIN + 2 * CW + c]); }
                NRX[idx] = r;
            }
#endif
#if !NAIVE_LRU
            for (int tile_ = bx; tile_ < (PROBE_SUB == 2 ? 1 : TR) * (T / 64); tile_ += G) { const int tile = tile_ % (T / 64);
                lru_unit(U, (bf16*)(ws + WS_P1), (bf16*)(ws + WS_P2), (float*)(ws + WS_HAGG), (float*)(ws + WS_CAGG), Wgate_t + (size_t)l * 2 * LH * LHD * LHD, lcw, lcb,
                         args.in[10] + (size_t)l * LW, args.in[12] + (size_t)l * LW, args.in[13] + (size_t)l * LW, tile, lds, tid, lane, wave); }
#endif
#if !NAIVE_CONV
            for (int tile_ = bx; tile_ < (PROBE_SUB == 1 ? 1 : TR) * (T / 64); tile_ += G) { const int tile = tile_ % (T / 64);
                conv_unit(U, Y, conv_w, conv_b, args.in[5] + (size_t)l * CW, args.in[6] + (size_t)l * CW, tile, lds, tid, lane, wave); }
#endif
        }
        SEAM(pb + 1);
        if (IN(pb + 2)) REPS(pb + 2) {
#if NAIVE_CONV
            { const float* lng = args.in[5] + (size_t)l * CW; const float* lnb = args.in[6] + (size_t)l * CW; const float* NCONV = (const float*)(ws + WS_NCONV);
            for (int m = gw; m < T; m += NGW) {
                float v[16]; float s = 0.f;
#pragma unroll
                for (int j = 0; j < 16; ++j) { v[j] = NCONV[(size_t)m * CW + lane + 64 * j]; s += v[j]; }
                const float mean = wave_sum(s) * (1.0f / CW); float q = 0.f;
#pragma unroll
                for (int j = 0; j < 16; ++j) { v[j] -= mean; q += v[j] * v[j]; }
                const float rstd = 1.0f / sqrtf(wave_sum(q) * (1.0f / CW) + EPS);
#pragma unroll
                for (int j = 0; j < 16; ++j) { const int c = lane + 64 * j; const float z = v[j] * rstd * lng[c] + lnb[c]; Y[(size_t)m * D + c] = (bf16)f2bf(z * sigmoidf_(z)); }
            } }
#endif
#if NAIVE_LRU
            { const float* NRX = (const float*)(ws + WS_NRX); float* NA = (float*)(ws + WS_NA); float* NB = (float*)(ws + WS_NB);
            const float* wa = args.in[9] + (size_t)l * LH * LHD * LHD; const float* wx = args.in[11] + (size_t)l * LH * LHD * LHD;
            const float* ba = args.in[10] + (size_t)l * LW; const float* bxx = args.in[12] + (size_t)l * LW; const float* lam = args.in[13] + (size_t)l * LW;
            for (int idx = gtid; idx < T * LW; idx += NGT) {
                const int t = idx >> 10, c = idx & 1023, h = c >> 7, j = c & 127, tl = t & (SEQ - 1);
                float da = ba[c], dx = bxx[c];
                const float* rxr = NRX + (size_t)t * LW + h * LHD; const float* war = wa + (size_t)h * LHD * LHD + j; const float* wxr = wx + (size_t)h * LHD * LHD + j;
                for (int i = 0; i < LHD; ++i) { const float r = rxr[i]; da += r * war[i * LHD]; dx += r * wxr[i * LHD]; }
                const float ga = sigmoidf_(da), gx = sigmoidf_(dx);
                const float nl = -lam[c]; const float sp = (nl > 20.f) ? nl : log1pf(expf(nl));
                const float la = -LRU_C * ga * sp; const float a = expf(la);
                float mult = sqrtf(fmaxf(-expm1f(2.0f * la), 0.f)); if (tl == 0) mult = 1.0f;
                NA[idx] = a; NB[idx] = mult * gx * NRX[idx];
            }
            xcd_barrier(bar);
            if (gtid < BATCH * LW) { const int b = gtid >> 10, c = gtid & 1023; float h = 0.f;
                for (int t = 0; t < SEQ; ++t) { const size_t row = (size_t)b * SEQ + t; h = NA[row * LW + c] * h + NB[row * LW + c];
                    Y[row * D + CW + c] = (bf16)f2bf(h * gelu_tanh(bf2f(U[row * DIN + 3 * CW + c]))); } } }
#else
            for (int tile = bx; tile < T / 64; tile += G)
                lru_fix_unit((const bf16*)(ws + WS_P1), (const bf16*)(ws + WS_P2), (const float*)(ws + WS_HAGG), (const float*)(ws + WS_CAGG), Y, tile, lds, tid);
#endif
        }
        SEAM(pb + 2);
        if (IN(pb + 3)) REPS(pb + 3) {
            pg8::Gemm g{Y, Wout_t + (size_t)l * D * D, T, D, D}; pg8::StaticOrder S; S.init(T, D, G, vbx);
            if constexpr (L == 0) { pg8::EpiResNormT<true> E{H, H, (float*)(ws + WS_SSQA), D, 1.0f, (LAS float*)(lds + RING_BYTES)};
                pg8::gemm_phase<pg8::EpiResNormT<true>, pg8::StaticOrder, true, true>(lds + RING_OFF, g, S, E); }
            else { pg8::EpiResB16 E{H, D};
                pg8::gemm_phase<pg8::EpiResB16, pg8::StaticOrder, true, true>(lds + RING_OFF, g, S, E); }
        }
        SEAM(pb + 3);
        if constexpr (L == 0) {
            if (IN(5)) {
                pg8::Gemm g{H, DWgu, T, 2 * DFF, D}; pg8::StaticOrder S; S.init(T, 2 * DFF, G, vbx);
                typedef pg8::EpiSwiGlu8 EpiD1; EpiD1 E{(unsigned char*)HID, DFF, 1.0f, (const float*)(ws + WS_SSQA)};
                const int rounds = (S.nwg + G - 1) / G, grp = (vbx * 8) / G, cut = (rounds * grp) / 8;
                S.i0 = 0; S.i1 = cut;
                pg8::gemm_phase<EpiD1, pg8::StaticOrder, true, true>(lds + RING_OFF, g, S, E);
                moe_convert_share(args.in[20], args.in[21], args.in[22], (unsigned char*)MWgu, (unsigned char*)MWd, lds, gw, NGW, wave, lane);
                __syncthreads();
                S.i0 = cut; S.i1 = 0x7fffffff;
                pg8::gemm_phase<EpiD1, pg8::StaticOrder, true, true>(lds + RING_OFF, g, S, E);
            }
            SEAM(5);
            if (IN(6)) {
                pg8::Gemm g{HID, DWd, T, D, DFF / 2}; pg8::StaticOrder S; S.init(T, D, G, vbx);
                pg8::EpiResNormT<true> E{H, H, (float*)(ws + WS_SSQB), D, 1.0f / MOE_SC_D, (LAS float*)(lds + RING_BYTES)};
                pg8::gemm_phase<pg8::EpiResNormT<true>, pg8::StaticOrder, true, true, true>(lds + RING_OFF, g, S, E);
            }
            SEAM(6);
        } else {
            if (IN(11)) {
                LAS f32x4* wl = (LAS f32x4*)lds;
                LAS unsigned* rows8 = (LAS unsigned*)(lds + 65536);
                LAS unsigned* meta = (LAS unsigned*)(lds + 131072);
                LAS unsigned* lc = meta + 128;
                LAS unsigned* lbase = meta + 136;
                const float* wrt = args.in[19]; const float* gain = args.in[15] + D;
                for (int q = tid; q < D * NE / 4; q += NTHR) { const f32x4 w = ((const GAS f32x4*)wrt)[q]; const int k = q >> 1, half = q & 1, i = k & 3, ln = (k >> 2) & 63, j = k >> 8; wl[((j * 4 + i) * 2 + half) * 64 + ln] = w; }
                __syncthreads();
                for (int sub = bx; sub < T / 32; sub += G) {
                    if (tid < NE) lc[tid] = 0u;
                    __syncthreads();
#pragma unroll 1
                    for (int rr = 0; rr < 4; ++rr) { const int row = 4 * wave + rr, m = sub * 32 + row;
                        const GAS v2u* xr = (const GAS v2u*)(H + (size_t)m * D) + lane; const GAS f32x4* gr = (const GAS f32x4*)gain + lane;
                        f32x4 v[8]; float ss = 0.f;
#pragma unroll
                        for (int j = 0; j < 8; ++j) { const v2u a = xr[64 * j]; v[j] = (f32x4){bf_lo(a.x), bf_hi(a.x), bf_lo(a.y), bf_hi(a.y)}; ss += (v[j].x * v[j].x + v[j].y * v[j].y) + (v[j].z * v[j].z + v[j].w * v[j].w); }
                        const float rstd = 1.0f / sqrtf(wave_sum(ss) * (1.0f / D) + EPS);
                        f32x4 l0 = (f32x4){0.f, 0.f, 0.f, 0.f}, l1 = l0;
                        v16f hx, hy;
#pragma unroll
                        for (int j = 0; j < 8; ++j) { const f32x4 g = gr[64 * j]; const f32x4 hv = v[j] * rstd * g;
#pragma unroll
                            for (int i = 0; i < 4; ++i) { if (j < 4) hx[4 * j + i] = hv[i] * MOE_SC_A; else hy[4 * (j - 4) + i] = hv[i] * MOE_SC_A;
                                l0 += hv[i] * wl[((j * 4 + i) * 2 + 0) * 64 + lane]; l1 += hv[i] * wl[((j * 4 + i) * 2 + 1) * 64 + lane]; } }
                        { v6u d; asm volatile("v_cvt_scalef32_2xpk16_fp6_f32 %0, %1, %2, 1.0" : "=&v"(d) : "v"(hx), "v"(hy));
                          LAS unsigned* p1 = rows8 + row * 512 + (lane >> 2) * 32 + 4 * (lane & 3); p1[0] = d[0]; p1[1] = d[1]; p1[2] = d[2]; p1[3] = d[3]; p1[16] = d[4]; p1[17] = d[5]; }
                        float p4[4], p2[2], p1;
                        { const bool up = (lane & 32) != 0; float a0[4] = {l0.x, l0.y, l0.z, l0.w}, a1[4] = {l1.x, l1.y, l1.z, l1.w};
#pragma unroll
                          for (int i = 0; i < 4; ++i) { float x = a0[i], y = a1[i]; asm volatile("" : "+v"(x), "+v"(y)); p4[i] = (up ? y : x) + __shfl_xor(up ? x : y, 32); } }
                        { const bool up = (lane & 16) != 0;
#pragma unroll
                          for (int i = 0; i < 2; ++i) { float x = p4[i], y = p4[i + 2]; asm volatile("" : "+v"(x), "+v"(y)); p2[i] = (up ? y : x) + __shfl_xor(up ? x : y, 16); } }
                        { const bool up = (lane & 8) != 0; float x = p2[0], y = p2[1]; asm volatile("" : "+v"(x), "+v"(y)); p1 = (up ? y : x) + __shfl_xor(up ? x : y, 8); }
                        p1 += __shfl_xor(p1, 4); p1 += __shfl_xor(p1, 2); p1 += __shfl_xor(p1, 1);
                        float lg[8];
#pragma unroll
                        for (int e = 0; e < 8; ++e) lg[e] = __int_as_float(__builtin_amdgcn_readlane(__float_as_int(p1), ((e & 4) ? 32 : 0) + ((e & 2) ? 16 : 0) + ((e & 1) ? 8 : 0)));
                        float m1 = lg[0]; int i1 = 0;
#pragma unroll
                        for (int e = 1; e < 8; ++e) if (lg[e] > m1) { m1 = lg[e]; i1 = e; }
                        float m2 = -3.0e38f; int i2 = 0;
#pragma unroll
                        for (int e = 0; e < 8; ++e) if (e != i1 && lg[e] > m2) { m2 = lg[e]; i2 = e; }
                        const float ex = expf(m2 - m1), w1 = 1.0f / (1.0f + ex), w2 = ex / (1.0f + ex);
                        if (lane == 0) { int4 r; r.x = i1; r.y = i2; r.z = __float_as_int(w1); r.w = __float_as_int(w2); ((int4*)ROUTE)[m] = r;
                            meta[row * 4 + 0] = (unsigned)i1; meta[row * 4 + 1] = (unsigned)i2;
                            meta[row * 4 + 2] = __hip_atomic_fetch_add(lc + i1, 1u, __ATOMIC_RELAXED, __HIP_MEMORY_SCOPE_WORKGROUP); meta[row * 4 + 3] = __hip_atomic_fetch_add(lc + i2, 1u, __ATOMIC_RELAXED, __HIP_MEMORY_SCOPE_WORKGROUP); }
                    }
                    __syncthreads();
                    if (tid < NE) lbase[tid] = __hip_atomic_fetch_add(ctl + CW_CNT + 64 * tid, lc[tid], RLX_AGENT);
                    __syncthreads();
#pragma unroll 1
                    for (int rr = 0; rr < 4; ++rr) { const int row = 4 * wave + rr, m = sub * 32 + row;
                        const unsigned e1 = meta[row * 4 + 0], e2 = meta[row * 4 + 1]; const unsigned s1 = lbase[e1] + meta[row * 4 + 2], s2 = lbase[e2] + meta[row * 4 + 3];
                        if (lane == 0) { POS[2 * m] = (int)s1; POS[2 * m + 1] = (int)s2; }
                        const LAS v4u* src = (const LAS v4u*)(rows8 + row * 512) + lane; const v4u q0 = src[0], q1 = src[64];
                        GAS v4u* d1 = (GAS v4u*)((unsigned char*)XG8 + ((size_t)e1 * T + s1) * (D + XPAD)) + lane; GAS v4u* d2 = (GAS v4u*)((unsigned char*)XG8 + ((size_t)e2 * T + s2) * (D + XPAD)) + lane;
                        d1[0] = q0; d1[64] = q1; d2[0] = q0; d2[64] = q1; }
                    __syncthreads();
                }
            }
            SEAM(11);
            if (IN(12) || IN(13)) {
                pg8::MoeOrder S; unsigned acc = 0;
#pragma unroll
                for (int e = 0; e < NE; ++e) { const unsigned c = (unsigned)__builtin_amdgcn_readfirstlane((int)__hip_atomic_load(ctl + CW_CNT + 64 * e, RLX_AGENT)); const unsigned nt = (c + 255u) >> 8; acc += nt; S.te[e] = (int)acc; if (e < 7) S.dg[e] = T / 256 - (int)nt; }
                const int ntiles = (int)acc;
                if (IN(12)) { S.rep = (PROBE_PHASE == 12) ? PROBE_N : 1;
                    S.nM = ntiles; S.nN = 2 * DFF / 256; S.nwg = S.nM * S.nN; S.G = G; S.c = vbx; S.estride = (size_t)2 * DFF * D;
                    pg8::Gemm g{XG8, MWgu, ntiles * 256, 2 * DFF, D / 2, (D + XPAD) / 2};
                    pg8::EpiSwiGlu8 E{(unsigned char*)HID, DFF, 1.0f / (MOE_SC_GU * MOE_SC_A), nullptr};
                    pg8::gemm_phase<pg8::EpiSwiGlu8, pg8::MoeOrder, true, true, true, 0, true>(lds + RING_OFF, g, S, E);
                }
                SEAM(12);
                if (IN(13)) { S.rep = (PROBE_PHASE == 13) ? PROBE_N : 1;
#pragma unroll
                    for (int k = 0; k < 7; ++k) S.dg[k] = 0;
                    S.nM = ntiles; S.nN = D / 256; S.nwg = S.nM * S.nN; S.G = G; S.c = vbx; S.estride = (size_t)D * DFF;
                    pg8::Gemm g{HID, MWd, ntiles * 256, D, DFF / 2};
                    pg8::EpiBf16S E{YB, D, 1.0f / MOE_SC_D};
                    pg8::gemm_phase<pg8::EpiBf16S, pg8::MoeOrder, true, true, true>(lds + RING_OFF, g, S, E);
                }
                SEAM(13);
            }
            if (IN(14)) REPS(14) {
                const float* fn = args.in[23];
                LAS unsigned* tst = (LAS unsigned*)(lds + RING_OFF);
                if (tid == 0) { unsigned acc = 0; for (int e = 0; e < NE; ++e) { tst[e] = acc << 8; acc += (__hip_atomic_load(ctl + CW_CNT + 64 * e, RLX_AGENT) + 255u) >> 8; } }
                __syncthreads();
                const GAS f32x4* gr = (const GAS f32x4*)fn + lane;
                int m = gw; int4 r = (int4){0, 0, 0, 0}; int q1 = 0, q2 = 0;
                v2u xa[8], ya[8], yb[8];
                if (m < T) { r = ((const int4*)ROUTE)[m]; q1 = POS[2 * m]; q2 = POS[2 * m + 1];
                    const int p1 = (int)tst[r.x] + q1, p2 = (int)tst[r.y] + q2;
                    const GAS v2u* xr = (const GAS v2u*)(H + (size_t)m * D) + lane; const GAS v2u* y1 = (const GAS v2u*)(YB + (size_t)p1 * D) + lane; const GAS v2u* y2 = (const GAS v2u*)(YB + (size_t)p2 * D) + lane;
#pragma unroll
                    for (int j = 0; j < 8; ++j) { xa[j] = xr[64 * j]; ya[j] = y1[64 * j]; yb[j] = y2[64 * j]; } }
                int4 rn = (int4){0, 0, 0, 0}; int qn1 = 0, qn2 = 0;
                { const int mn = m + NGW; if (mn < T) { rn = ((const int4*)ROUTE)[mn]; qn1 = POS[2 * mn]; qn2 = POS[2 * mn + 1]; } }
#pragma unroll 1
                for (; m < T; m += NGW) {
                    const float w1 = __int_as_float(r.z), w2 = __int_as_float(r.w);
                    const int mn = m + NGW, mnn = mn + NGW;
                    v2u xb_[8], yc[8], yd[8];
                    if (mn < T) { const int p1 = (int)tst[rn.x] + qn1, p2 = (int)tst[rn.y] + qn2;
                        const GAS v2u* xr = (const GAS v2u*)(H + (size_t)mn * D) + lane; const GAS v2u* y1 = (const GAS v2u*)(YB + (size_t)p1 * D) + lane; const GAS v2u* y2 = (const GAS v2u*)(YB + (size_t)p2 * D) + lane;
#pragma unroll
                        for (int j = 0; j < 8; ++j) { xb_[j] = xr[64 * j]; yc[j] = y1[64 * j]; yd[j] = y2[64 * j]; } }
                    else {
#pragma unroll
                        for (int j = 0; j < 8; ++j) { xb_[j] = (v2u){0u, 0u}; yc[j] = xb_[j]; yd[j] = xb_[j]; } }
                    int4 rnn = (int4){0, 0, 0, 0}; int qa = 0, qb = 0;
                    if (mnn < T) { rnn = ((const int4*)ROUTE)[mnn]; qa = POS[2 * mnn]; qb = POS[2 * mnn + 1]; }
                    f32x4 v[8]; float s = 0.f;
#pragma unroll
                    for (int j = 0; j < 8; ++j) { const v2u x3 = xa[j], a = ya[j], b = yb[j]; v[j] = (f32x4){bf_lo(x3.x), bf_hi(x3.x), bf_lo(x3.y), bf_hi(x3.y)};
                        v[j].x += w1 * bf_lo(a.x) + w2 * bf_lo(b.x); v[j].y += w1 * bf_hi(a.x) + w2 * bf_hi(b.x); v[j].z += w1 * bf_lo(a.y) + w2 * bf_lo(b.y); v[j].w += w1 * bf_hi(a.y) + w2 * bf_hi(b.y);
                        s += (v[j].x * v[j].x + v[j].y * v[j].y) + (v[j].z * v[j].z + v[j].w * v[j].w); }
                    const float rstd = 1.0f / sqrtf(wave_sum(s) * (1.0f / D) + EPS);
                    GAS f32x4* o = (GAS f32x4*)(args.out + (size_t)m * D) + lane;
#pragma unroll
                    for (int j = 0; j < 8; ++j) o[64 * j] = v[j] * rstd * gr[64 * j];
#pragma unroll
                    for (int j = 0; j < 8; ++j) { xa[j] = xb_[j]; ya[j] = yc[j]; yb[j] = yd[j]; }
                    r = rn; rn = rnn; qn1 = qa; qn2 = qb;
                }
            }
        }
    }
}

__global__ void __launch_bounds__(NTHR, 2) trunk_fwd(Args args) {
    extern __shared__ __attribute__((aligned(16))) unsigned char lds_raw[];
    LAS unsigned char* lds = (LAS unsigned char*)lds_raw;
    volatile LAS unsigned* MISC = (volatile LAS unsigned*)(lds + MISC_OFF);
    const int tid = threadIdx.x, lane = tid & 63, wave = __builtin_amdgcn_readfirstlane(tid >> 6);
    const int G = gridDim.x, bx = blockIdx.x;
    const int gw = bx * NWAVES + wave, NGW = G * NWAVES;
    const int gtid = bx * NTHR + tid, NGT = G * NTHR;
    unsigned char* ws = args.ws;
    gu32* ctl = (gu32*)(ws + WS_CTL);
    for (int u = tid; u < (LDS_BYTES - LDSCTL_OFF) / 4; u += NTHR) ((LAS unsigned*)(lds + LDSCTL_OFF))[u] = 0u;
    __syncthreads();
    XcdBarrier bar; bar.bar = (unsigned*)(ctl + CW_BAR); bar.x = 0; bar.st = nullptr;
    if (!MK_PER_PHASE) bar = xcd_barrier_post((unsigned*)(ctl + CW_BAR), MISC + 8);
    const int lo = args.ph_lo, hi = args.ph_hi;
    if (tid == 0) { const unsigned xcc = xb_xcc_id() & 7u; const unsigned r = __hip_atomic_fetch_add(ctl + CW_XRANK + 64 * xcc, 1u, RLX_AGENT); MISC[12] = xcc + 8u * r; }

    const float* x_in = args.in[0];
    bf16* Win_t = (bf16*)(ws + WS_WIN); bf16* Wout_t = (bf16*)(ws + WS_WOUT); bf16* Wgate_t = (bf16*)(ws + WS_WGATE);
    bf16* DWgu = (bf16*)(ws + WS_DWGU); bf16* DWd = (bf16*)(ws + WS_DWD); bf16* MWgu = (bf16*)(ws + WS_MWGU); bf16* MWd = (bf16*)(ws + WS_MWD);
    float* X = (float*)(ws + WS_X); bf16* H = (bf16*)(ws + WS_H); bf16* U = (bf16*)(ws + WS_U); bf16* Y = (bf16*)(ws + WS_Y);
    bf16* HID = (bf16*)(ws + WS_HID); bf16* XG8 = (bf16*)(ws + WS_XG8); bf16* YB = (bf16*)(ws + WS_YB);
    int* ROUTE = (int*)(ws + WS_ROUTE); int* POS = (int*)(ws + WS_POS);

    if (IN(0)) REPS(0) {
        dense_convert_items(args, ws, 0, DC_N_EARLY, lds, gw, NGW, wave, lane);
        for (int m = gw; m < T; m += NGW) row_to_bf16_ssq(x_in + (size_t)m * D, H + (size_t)m * D, (float*)(ws + WS_SSQB) + (size_t)m * 8, lane);
    }
    SEAM(0);

    int vbx = bx;
    if (G == 256 && lo == 0 && hi > 1) {
        bool ok = true;
#pragma unroll
        for (int x = 0; x < 8; ++x) ok = ok && (__builtin_amdgcn_readfirstlane((int)__hip_atomic_load(ctl + CW_XRANK + 64 * x, RLX_AGENT)) == 32);
        const int v = __builtin_amdgcn_readfirstlane((int)MISC[12]);
        if (ok && v >= 0 && v < G) vbx = v;
    }
    Ctx C; C.vbx = vbx; C.lds = lds; C.ws = ws; C.ctl = ctl; C.tid = tid; C.lane = lane; C.wave = wave; C.G = G; C.bx = bx; C.gw = gw; C.NGW = NGW; C.gtid = gtid; C.NGT = NGT; C.lo = lo; C.hi = hi;
    layer_phases<0>(args, C, bar);
    layer_phases<1>(args, C, bar);
#undef IN
#undef SEAM
}

extern "C" void kernel_launch(void* const* d_in, const int* in_sizes, int n_in, void* d_out, int out_size, void* d_ws, size_t ws_size, hipStream_t stream) {
    static int grid = 0;
    if (grid == 0) {
        if (n_in != 24 || in_sizes[0] != T * D || out_size != T * D || ws_size < WS_END) { fprintf(stderr, "kernel_launch: unexpected shapes (n_in %d, in0 %d, out %d, ws %zu < %zu?); nothing launched\n", n_in, n_in > 0 ? in_sizes[0] : -1, out_size, ws_size, (size_t)WS_END); grid = -1; return; }
        int dev = 0, cus = 0, per_cu = 0;
        if (hipGetDevice(&dev) != hipSuccess || hipDeviceGetAttribute(&cus, hipDeviceAttributeMultiprocessorCount, dev) != hipSuccess) { grid = -1; return; }
        if (hipFuncSetAttribute((const void*)trunk_fwd, hipFuncAttributeMaxDynamicSharedMemorySize, LDS_BYTES) != hipSuccess) { fprintf(stderr, "kernel_launch: hipFuncSetAttribute failed\n"); grid = -1; return; }
        if (hipOccupancyMaxActiveBlocksPerMultiprocessor(&per_cu, (const void*)trunk_fwd, NTHR, LDS_BYTES) != hipSuccess || per_cu < 1) fprintf(stderr, "kernel_launch: occupancy query reports %d blocks per CU\n", per_cu);
        (void)hipGetLastError();
        grid = cus;
    }
    if (grid < 0) return;
    if (hipMemsetAsync((char*)d_ws + WS_CTL, 0, CTL_ZERO_BYTES, stream) != hipSuccess) return;
    Args a{};
    for (int i = 0; i < 24; ++i) a.in[i] = (const float*)d_in[i];
    a.out = (float*)d_out; a.ws = (unsigned char*)d_ws;
#if MK_PER_PHASE
    for (int p = 0; p < N_PHASES; ++p) { a.ph_lo = p; a.ph_hi = p + 1; hipLaunchKernelGGL(trunk_fwd, dim3(grid), dim3(NTHR), LDS_BYTES, stream, a); }
#else
    a.ph_lo = 0; a.ph_hi = N_PHASES;
    hipLaunchKernelGGL(trunk_fwd, dim3(grid), dim3(NTHR), LDS_BYTES, stream, a);
#endif
}
```

```cpp
#include <hip/hip_runtime.h>
#include <cstdio>
#include <cstdint>

#define NAIVE_CONV 0
#define NAIVE_LRU 0
#ifndef DENSE2_FP8
#define DENSE2_FP8 1
#endif
#ifndef GEMM_PV
#define GEMM_PV -1
#endif
#ifndef XPAD
#define XPAD 128
#endif
#ifndef PROBE_PHASE
#define PROBE_PHASE -1
#endif
#ifndef PROBE_N
#define PROBE_N 2
#endif
#ifndef PROBE_SUB
#define PROBE_SUB 0
#endif
#ifndef PROBE_SKIP_EPI
#define PROBE_SKIP_EPI 0
#endif
#ifndef MK_PER_PHASE
#define MK_PER_PHASE 0
#endif

namespace pg8 {
#define PG8_LAS __attribute__((address_space(3)))
typedef unsigned short bf16_t;
typedef short bf16x8 __attribute__((ext_vector_type(8)));
typedef float f32x4 __attribute__((ext_vector_type(4)));
typedef unsigned u32x4 __attribute__((ext_vector_type(4)));
typedef int v4i __attribute__((ext_vector_type(4)));
typedef int v8i __attribute__((ext_vector_type(8)));
typedef int v6i __attribute__((ext_vector_type(6)));
typedef int v2i __attribute__((ext_vector_type(2)));
typedef unsigned u32x2 __attribute__((ext_vector_type(2)));
constexpr int BM = 256, BK = 64, HALF = 128, HTB = HALF * BK * 2  , STAGE_BYTES = 8 * HTB, NXCD = 8, WGM = 6;

__host__ __device__ __forceinline__ int lds_byte(int r, int c) { const int st = (r >> 4) * 2 + (c >> 5), rr = r & 15, cc = c & 31, ob = rr * 64 + cc * 2; return st * 1024 + (ob ^ (((ob >> 9) & 1) << 5)); }
__host__ __device__ __forceinline__ void stage_rc(int b, int& R, int& C) { const int st = b / 1024, sb = b % 1024, swz = sb ^ (((sb >> 9) & 1) << 5); R = (st >> 1) * 16 + swz / 64; C = (st & 1) * 32 + (swz % 64) / 2; }
__host__ __device__ __forceinline__ int perm32(int rho) { const int n = rho >> 4, i = rho & 15; return 8 * (i >> 2) + 4 * n + (i & 3); }

struct Unit { int pm, pn; bool skip_epi; };
struct Gemm { const bf16_t* A; const bf16_t* Bt; int M, N, K; int lda = 0; };

struct StaticOrder {
    int nM, nN, nwg, G, c, rep = 1;
    int i0 = 0, i1 = 0x7fffffff;
    __host__ __device__ void init(int M, int N, int G_, int c_) { nM = M / BM; nN = N / BM; nwg = nM * nN; G = G_; c = c_; }
    __host__ __device__ bool next(int i, Unit& u) const {
        i += i0; if (i >= i1) return false;
        long L = (long)i * G + c; if (L >= (long)nwg * rep) return false;
        u.skip_epi = false;
        if (rep > 1) { u.skip_epi = PROBE_SKIP_EPI && (L >= nwg); L %= nwg; }
        int wgid = (int)L; { const int q = nwg / NXCD, r = nwg % NXCD, xcd = wgid % NXCD, off = wgid / NXCD; wgid = (xcd < r ? xcd * (q + 1) : r * (q + 1) + (xcd - r) * q) + off; }
        const int nig = WGM * nN, gid = wgid / nig, fm = gid * WGM, gsz = (nM - fm) < WGM ? (nM - fm) : WGM;
        u.pm = fm + ((wgid % nig) % gsz); u.pn = (wgid % nig) / gsz; return true;
    }
    __device__ __forceinline__ size_t b_off(const Unit&) const { return 0; }
    __device__ __forceinline__ int a_tile(const Unit& u) const { return u.pm; }
    __device__ __forceinline__ void a_ready(const Unit&) const {}
    __device__ __forceinline__ void done(const Unit&) const {}
};
struct MoeOrder : StaticOrder {
    int te[8]; int dg[7]; size_t estride;
    __device__ __forceinline__ size_t b_off(const Unit& u) const { int e = 0;
#pragma unroll
        for (int k = 0; k < 7; ++k) e += (u.pm >= te[k]) ? 1 : 0;
        return (size_t)e * estride; }
    __device__ __forceinline__ int a_tile(const Unit& u) const { int t = u.pm;
#pragma unroll
        for (int k = 0; k < 7; ++k) t += (u.pm >= te[k]) ? dg[k] : 0;
        return t; }
};

__device__ __forceinline__ unsigned cvt_pk_bf16(float lo, float hi) { unsigned r; asm volatile("v_cvt_pk_bf16_f32 %0, %1, %2" : "=v"(r) : "v"(lo), "v"(hi)); return r; }

constexpr float NORM_EPS = 1e-6f, NORM_INV_D = 1.0f / 2048.0f;
struct EpiBf16 {
    static constexpr bool PERM = true, AFTER_DRAIN = false;
    bf16_t* O; int ldc; const float* ssq;
    __device__ __forceinline__ void operator()(const f32x4 (&acc)[2][2][4][2], const Unit& u, int wr, int wc, int fr, int fq) const {
        const int row0 = u.pm * BM + wr * 64 + fr, col0 = u.pn * BM + wc * 32 + 8 * fq;
#pragma unroll
        for (int ai = 0; ai < 2; ++ai)
#pragma unroll
            for (int m = 0; m < 4; ++m) { bf16_t* rowp = O + (size_t)(row0 + ai * HALF + m * 16) * ldc + col0;
                float rs = 1.0f; if (ssq) { const f32x4* p = (const f32x4*)(ssq + (size_t)(row0 + ai * HALF + m * 16) * 8); const f32x4 a = p[0], b = p[1]; rs = __builtin_amdgcn_rsqf((((a[0] + a[1]) + (a[2] + a[3])) + ((b[0] + b[1]) + (b[2] + b[3]))) * NORM_INV_D + NORM_EPS); }
#pragma unroll
                for (int bj = 0; bj < 2; ++bj) { const f32x4 v0 = acc[ai][bj][m][0] * rs, v1 = acc[ai][bj][m][1] * rs;
                    u32x4 w; w.x = cvt_pk_bf16(v0[0], v0[1]); w.y = cvt_pk_bf16(v0[2], v0[3]); w.z = cvt_pk_bf16(v1[0], v1[1]); w.w = cvt_pk_bf16(v1[2], v1[3]);
                    *(u32x4*)(rowp + bj * HALF) = w; } }
    }
};
struct EpiInProj {
    static constexpr bool PERM = true, AFTER_DRAIN = false;
    bf16_t* O; int ldc; const float* ssq;
    __device__ __forceinline__ void operator()(const f32x4 (&acc)[2][2][4][2], const Unit& u, int wr, int wc, int fr, int fq) const {
        const int row0 = u.pm * BM + wr * 64 + fr;
        const bool glu = u.pn < 8;
        const int col0 = glu ? (u.pn * HALF + wc * 32 + 8 * fq) : (1024 + (u.pn - 8) * BM + wc * 32 + 8 * fq);
#pragma unroll
        for (int ai = 0; ai < 2; ++ai)
#pragma unroll
            for (int m = 0; m < 4; ++m) { bf16_t* rowp = O + (size_t)(row0 + ai * HALF + m * 16) * ldc + col0;
                float rs = 1.0f; if (ssq) { const f32x4* p = (const f32x4*)(ssq + (size_t)(row0 + ai * HALF + m * 16) * 8); const f32x4 a = p[0], b = p[1]; rs = __builtin_amdgcn_rsqf((((a[0] + a[1]) + (a[2] + a[3])) + ((b[0] + b[1]) + (b[2] + b[3]))) * NORM_INV_D + NORM_EPS); }
                if (glu) { float h[8];
#pragma unroll
                    for (int n = 0; n < 2; ++n)
#pragma unroll
                        for (int j = 0; j < 4; ++j) { const float v = acc[ai][0][m][n][j] * rs, g = acc[ai][1][m][n][j] * rs;
                            h[4 * n + j] = v * __builtin_amdgcn_rcpf(1.0f + __builtin_amdgcn_exp2f(-1.44269504089f * g)); }
                    u32x4 w; w.x = cvt_pk_bf16(h[0], h[1]); w.y = cvt_pk_bf16(h[2], h[3]); w.z = cvt_pk_bf16(h[4], h[5]); w.w = cvt_pk_bf16(h[6], h[7]);
                    *(u32x4*)rowp = w;
                } else {
#pragma unroll
                    for (int bj = 0; bj < 2; ++bj) { const f32x4 v0 = acc[ai][bj][m][0] * rs, v1 = acc[ai][bj][m][1] * rs;
                        u32x4 w; w.x = cvt_pk_bf16(v0[0], v0[1]); w.y = cvt_pk_bf16(v0[2], v0[3]); w.z = cvt_pk_bf16(v1[0], v1[1]); w.w = cvt_pk_bf16(v1[2], v1[3]);
                        *(u32x4*)(rowp + bj * HALF) = w; } } }
    }
};
struct EpiSwiGlu {
    static constexpr bool PERM = true, AFTER_DRAIN = false;
    bf16_t* O; int ldc;
    __device__ __forceinline__ void operator()(const f32x4 (&acc)[2][2][4][2], const Unit& u, int wr, int wc, int fr, int fq) const {
        const int row0 = u.pm * BM + wr * 64 + fr, col0 = u.pn * HALF + wc * 32 + 8 * fq;
#pragma unroll
        for (int ai = 0; ai < 2; ++ai)
#pragma unroll
            for (int m = 0; m < 4; ++m) { bf16_t* rowp = O + (size_t)(row0 + ai * HALF + m * 16) * ldc + col0;
                float h[8];
#pragma unroll
                for (int n = 0; n < 2; ++n)
#pragma unroll
                    for (int j = 0; j < 4; ++j) { const float g = acc[ai][0][m][n][j], v = acc[ai][1][m][n][j];
                        h[4 * n + j] = g * __builtin_amdgcn_rcpf(1.0f + __builtin_amdgcn_exp2f(-1.44269504089f * g)) * v; }
                u32x4 w; w.x = cvt_pk_bf16(h[0], h[1]); w.y = cvt_pk_bf16(h[2], h[3]); w.z = cvt_pk_bf16(h[4], h[5]); w.w = cvt_pk_bf16(h[6], h[7]);
                *(u32x4*)rowp = w; }
    }
};

__device__ __forceinline__ unsigned cvt4_fp8(float a, float b, float c, float d) { int w = 0; w = __builtin_amdgcn_cvt_pk_fp8_f32(a, b, w, false); w = __builtin_amdgcn_cvt_pk_fp8_f32(c, d, w, true); return (unsigned)w; }
struct EpiBf16S {
    static constexpr bool PERM = true, AFTER_DRAIN = false;
    bf16_t* O; int ldc; float sc;
    __device__ __forceinline__ void operator()(const f32x4 (&acc)[2][2][4][2], const Unit& u, int wr, int wc, int fr, int fq) const {
        const int row0 = u.pm * BM + wr * 64 + fr, col0 = u.pn * BM + wc * 32 + 8 * fq;
#pragma unroll
        for (int ai = 0; ai < 2; ++ai)
#pragma unroll
            for (int m = 0; m < 4; ++m) { bf16_t* rowp = O + (size_t)(row0 + ai * HALF + m * 16) * ldc + col0;
#pragma unroll
                for (int bj = 0; bj < 2; ++bj) { const f32x4 v0 = acc[ai][bj][m][0] * sc, v1 = acc[ai][bj][m][1] * sc;
                    u32x4 w; w.x = cvt_pk_bf16(v0[0], v0[1]); w.y = cvt_pk_bf16(v0[2], v0[3]); w.z = cvt_pk_bf16(v1[0], v1[1]); w.w = cvt_pk_bf16(v1[2], v1[3]);
                    *(u32x4*)(rowp + bj * HALF) = w; } }
    }
};
struct EpiSwiGlu8 {
    static constexpr bool PERM = true, AFTER_DRAIN = false;
    unsigned char* O; int ldc; float sc; const float* ssq;
    __device__ __forceinline__ void operator()(const f32x4 (&acc)[2][2][4][2], const Unit& u, int wr, int wc, int fr, int fq) const {
        const int row0 = u.pm * BM + wr * 64 + fr, col0 = u.pn * HALF + wc * 32 + 8 * fq;
#pragma unroll
        for (int ai = 0; ai < 2; ++ai)
#pragma unroll
            for (int m = 0; m < 4; ++m) { unsigned char* rowp = O + (size_t)(row0 + ai * HALF + m * 16) * ldc + col0;
                float rs = sc; if (ssq) { const f32x4* p = (const f32x4*)(ssq + (size_t)(row0 + ai * HALF + m * 16) * 8); const f32x4 a = p[0], b = p[1]; rs = sc * __builtin_amdgcn_rsqf((((a[0] + a[1]) + (a[2] + a[3])) + ((b[0] + b[1]) + (b[2] + b[3]))) * NORM_INV_D + NORM_EPS); }
                float h[8]; const float c1 = -1.44269504089f * rs, c2 = rs * rs;
#pragma unroll
                for (int n = 0; n < 2; ++n) { const f32x4 ag = acc[ai][0][m][n], av = acc[ai][1][m][n]; const f32x4 t = ag * c1; f32x4 e;
#pragma unroll
                    for (int j = 0; j < 4; ++j) e[j] = __builtin_amdgcn_exp2f(t[j]);
                    const f32x4 d = e + 1.0f; f32x4 r;
#pragma unroll
                    for (int j = 0; j < 4; ++j) r[j] = __builtin_amdgcn_rcpf(d[j]);
                    const f32x4 hq = (ag * av) * (r * c2);
#pragma unroll
                    for (int j = 0; j < 4; ++j) h[4 * n + j] = hq[j]; }
                u32x2 w; w.x = cvt4_fp8(h[0], h[1], h[2], h[3]); w.y = cvt4_fp8(h[4], h[5], h[6], h[7]);
                *(u32x2*)rowp = w; }
    }
};
struct EpiResF32 {
    static constexpr bool PERM = false, AFTER_DRAIN = false;
    const float* base; float* out; int ldc;
    __device__ __forceinline__ void operator()(const f32x4 (&acc)[2][2][4][2], const Unit& u, int wr, int wc, int fr, int fq) const {
        const int row0 = u.pm * BM + wr * 64 + fr, col0 = u.pn * BM + wc * 32 + 4 * fq;
#pragma unroll
        for (int ai = 0; ai < 2; ++ai)
#pragma unroll
            for (int m = 0; m < 4; ++m) { const size_t off = (size_t)(row0 + ai * HALF + m * 16) * ldc + col0;
#pragma unroll
                for (int bj = 0; bj < 2; ++bj)
#pragma unroll
                    for (int n = 0; n < 2; ++n) { const f32x4 bs = *(const f32x4*)(base + off + bj * HALF + n * 16); *(f32x4*)(out + off + bj * HALF + n * 16) = bs + acc[ai][bj][m][n]; }
                if (m == 3) asm volatile("" ::: "memory"); }
    }
};

struct EpiResNorm {
    static constexpr bool PERM = false, AFTER_DRAIN = false;
    const float* base; float* out; bf16_t* xb; float* ssq8; int ldc; float sc; PG8_LAS float* part;
    __device__ __forceinline__ void operator()(const f32x4 (&acc)[2][2][4][2], const Unit& u, int wr, int wc, int fr, int fq) const {
        const int row0 = u.pm * BM + wr * 64 + fr, col0 = u.pn * BM + wc * 32 + 4 * fq;
#pragma unroll
        for (int ai = 0; ai < 2; ++ai) {
            float q[4];
#pragma unroll
            for (int m = 0; m < 4; ++m) { const size_t off = (size_t)(row0 + ai * HALF + m * 16) * ldc + col0; q[m] = 0.f;
#pragma unroll
                for (int bj = 0; bj < 2; ++bj)
#pragma unroll
                    for (int n = 0; n < 2; ++n) { const f32x4 bs = *(const f32x4*)(base + off + bj * HALF + n * 16); const f32x4 v = bs + acc[ai][bj][m][n] * sc;
                        *(f32x4*)(out + off + bj * HALF + n * 16) = v; q[m] += (v[0] * v[0] + v[1] * v[1]) + (v[2] * v[2] + v[3] * v[3]);
                        u32x2 w; w.x = cvt_pk_bf16(v[0], v[1]); w.y = cvt_pk_bf16(v[2], v[3]); *(u32x2*)(xb + off + bj * HALF + n * 16) = w; } }
            asm volatile("" ::: "memory");
#pragma unroll
            for (int m = 0; m < 4; ++m) { float t = q[m]; t += __shfl_xor(t, 16); t += __shfl_xor(t, 32);
                if (fq == 0) part[(ai * HALF + wr * 64 + m * 16 + fr) * 4 + wc] = t; } }
        asm volatile("s_waitcnt lgkmcnt(0)" ::: "memory"); __builtin_amdgcn_s_barrier(); asm volatile("" ::: "memory");
        if (threadIdx.x < 256) { const PG8_LAS f32x4* p4 = (const PG8_LAS f32x4*)part + threadIdx.x; const f32x4 p = *p4;
            ssq8[(size_t)(u.pm * BM + threadIdx.x) * 8 + u.pn] = (p[0] + p[1]) + (p[2] + p[3]); }
    }
};
template <bool BASE_BF16> struct EpiResNormT {
    static constexpr bool PERM = false, AFTER_DRAIN = false;
    const void* base; bf16_t* xb; float* ssq8; int ldc; float sc; PG8_LAS float* part;
    __device__ __forceinline__ void operator()(const f32x4 (&acc)[2][2][4][2], const Unit& u, int wr, int wc, int fr, int fq) const {
        const int row0 = u.pm * BM + wr * 64 + fr, col0 = u.pn * BM + wc * 32 + 4 * fq;
        u32x2 bb[2][4][4];
        if constexpr (BASE_BF16) {
#pragma unroll
            for (int ai = 0; ai < 2; ++ai)
#pragma unroll
                for (int m = 0; m < 4; ++m)
#pragma unroll
                    for (int c = 0; c < 4; ++c) bb[ai][m][c] = *(const u32x2*)((const bf16_t*)base + (size_t)(row0 + ai * HALF + m * 16) * ldc + col0 + (c >> 1) * HALF + (c & 1) * 16);
            asm volatile("" ::: "memory"); }
#pragma unroll
        for (int ai = 0; ai < 2; ++ai) {
            float q[4];
#pragma unroll
            for (int m = 0; m < 4; ++m) { const size_t off = (size_t)(row0 + ai * HALF + m * 16) * ldc + col0; q[m] = 0.f;
#pragma unroll
                for (int bj = 0; bj < 2; ++bj)
#pragma unroll
                    for (int n = 0; n < 2; ++n) { f32x4 bs;
                        if constexpr (BASE_BF16) { const u32x2 b = bb[ai][m][bj * 2 + n];
                            bs[0] = __uint_as_float(b.x << 16); bs[1] = __uint_as_float(b.x & 0xffff0000u); bs[2] = __uint_as_float(b.y << 16); bs[3] = __uint_as_float(b.y & 0xffff0000u); }
                        else bs = *(const f32x4*)((const float*)base + off + bj * HALF + n * 16);
                        const f32x4 v = bs + acc[ai][bj][m][n] * sc;
                        u32x2 w; w.x = cvt_pk_bf16(v[0], v[1]); w.y = cvt_pk_bf16(v[2], v[3]); *(u32x2*)(xb + off + bj * HALF + n * 16) = w;
                        const float r0 = __uint_as_float(w.x << 16), r1 = __uint_as_float(w.x & 0xffff0000u), r2 = __uint_as_float(w.y << 16), r3 = __uint_as_float(w.y & 0xffff0000u);
                        q[m] += (r0 * r0 + r1 * r1) + (r2 * r2 + r3 * r3); } }
            asm volatile("" ::: "memory");
#pragma unroll
            for (int m = 0; m < 4; ++m) { float t = q[m]; t += __shfl_xor(t, 16); t += __shfl_xor(t, 32);
                if (fq == 0) part[(ai * HALF + wr * 64 + m * 16 + fr) * 4 + wc] = t; } }
        asm volatile("s_waitcnt lgkmcnt(0)" ::: "memory"); __builtin_amdgcn_s_barrier(); asm volatile("" ::: "memory");
        if (threadIdx.x < 256) { const PG8_LAS f32x4* p4 = (const PG8_LAS f32x4*)part + threadIdx.x; const f32x4 p = *p4;
            ssq8[(size_t)(u.pm * BM + threadIdx.x) * 8 + u.pn] = (p[0] + p[1]) + (p[2] + p[3]); }
    }
};
struct EpiResB16 {
    static constexpr bool PERM = false, AFTER_DRAIN = false;
    bf16_t* x; int ldc;
    __device__ __forceinline__ void operator()(const f32x4 (&acc)[2][2][4][2], const Unit& u, int wr, int wc, int fr, int fq) const {
        const int row0 = u.pm * BM + wr * 64 + fr, col0 = u.pn * BM + wc * 32 + 4 * fq;
        u32x2 bb[2][4][4];
#pragma unroll
        for (int ai = 0; ai < 2; ++ai)
#pragma unroll
            for (int m = 0; m < 4; ++m)
#pragma unroll
                for (int c = 0; c < 4; ++c) bb[ai][m][c] = *(const u32x2*)(x + (size_t)(row0 + ai * HALF + m * 16) * ldc + col0 + (c >> 1) * HALF + (c & 1) * 16);
        asm volatile("" ::: "memory");
#pragma unroll
        for (int ai = 0; ai < 2; ++ai)
#pragma unroll
            for (int m = 0; m < 4; ++m) { const size_t off = (size_t)(row0 + ai * HALF + m * 16) * ldc + col0;
#pragma unroll
                for (int bj = 0; bj < 2; ++bj)
#pragma unroll
                    for (int n = 0; n < 2; ++n) { u32x2* p = (u32x2*)(x + off + bj * HALF + n * 16); const u32x2 b = bb[ai][m][bj * 2 + n]; const f32x4 a = acc[ai][bj][m][n];
                        u32x2 w; w.x = cvt_pk_bf16(__uint_as_float(b.x << 16) + a[0], __uint_as_float(b.x & 0xffff0000u) + a[1]); w.y = cvt_pk_bf16(__uint_as_float(b.y << 16) + a[2], __uint_as_float(b.y & 0xffff0000u) + a[3]); *p = w; }
                if (m == 3) asm volatile("" ::: "memory"); }
    }
};
struct EpiResF32S {
    static constexpr bool PERM = false, AFTER_DRAIN = false;
    const float* base; float* out; int ldc; float sc;
    __device__ __forceinline__ void operator()(const f32x4 (&acc)[2][2][4][2], const Unit& u, int wr, int wc, int fr, int fq) const {
        const int row0 = u.pm * BM + wr * 64 + fr, col0 = u.pn * BM + wc * 32 + 4 * fq;
#pragma unroll
        for (int ai = 0; ai < 2; ++ai)
#pragma unroll
            for (int m = 0; m < 4; ++m) { const size_t off = (size_t)(row0 + ai * HALF + m * 16) * ldc + col0;
#pragma unroll
                for (int bj = 0; bj < 2; ++bj)
#pragma unroll
                    for (int n = 0; n < 2; ++n) { const f32x4 bs = *(const f32x4*)(base + off + bj * HALF + n * 16); *(f32x4*)(out + off + bj * HALF + n * 16) = bs + acc[ai][bj][m][n] * sc; }
                if (m == 3) asm volatile("" ::: "memory"); }
    }
};

template <class Epi, class Sched, bool ALIGN_EPI = false, bool SP2 = false, bool FP8 = false, int PV = 0, bool FP6 = false>
__device__ __forceinline__ void gemm_phase(PG8_LAS unsigned char* lds, const Gemm g, const Sched& S, const Epi& E) {
    const int tid = threadIdx.x, wid = __builtin_amdgcn_readfirstlane(tid >> 6), lane = tid & 63, wr = wid >> 2, wc = wid & 3, fr = lane & 15, fq = lane >> 4;
    const int K = g.K, nt = K / BK, LDA = g.lda ? g.lda : g.K;
    unsigned voffA[2], voffB[2];
#pragma unroll
    for (int i = 0; i < 2; ++i) { int R, C; stage_rc(tid * 16 + i * 8192, R, C); const int Rb = Epi::PERM ? ((R & ~31) + perm32(R & 31)) : R;
        voffA[i] = (unsigned)(R * LDA + C) * 2u; voffB[i] = (unsigned)(Rb * K + C) * 2u; }
    const size_t kstep = (size_t)(BK * 2);
    const size_t hstep = (size_t)HALF * K * 2;
    const size_t tstep = 2 * hstep;
    const size_t hstepA = (size_t)HALF * LDA * 2, tstepA = 2 * hstepA;
    const unsigned ldsw = (unsigned)wid * 1024u;
    const int aoff = lds_byte(wr * 64 + fr, fq * 8), boff = lds_byte(wc * 32 + fr, fq * 8);
    const unsigned abase6 = (unsigned)(unsigned long)(lds + aoff), bbase6 = (unsigned)(unsigned long)(lds + 4 * HTB + boff);
#define PG8_SA(b, h) (((b) * 2 + (h)) * HTB)
#define PG8_SB(b, h) ((4 + (b) * 2 + (h)) * HTB)
#define PG8_STAGE(bufoff, gbase, voff) do { if constexpr (PV != 2) _Pragma("unroll") for (int _i = 0; _i < 2; ++_i) \
        __builtin_amdgcn_global_load_lds((const unsigned*)((const char*)(gbase) + (voff)[_i]), (PG8_LAS unsigned*)(lds + (bufoff) + ldsw + _i * 8192), 16, 0, 0); } while (0)
#define PG8_LDA(dst, b, h) do { if constexpr (PV == 3) {} else if constexpr (FP6) { _Pragma("unroll") for (int m = 0; m < 4; ++m) { v4i lo_; v2i hi_; \
            asm volatile("ds_read_b128 %0, %2 offset:%3\n\tds_read_b64 %1, %2 offset:%4" : "=&v"(lo_), "=&v"(hi_) : "v"(abase6), "n"(PG8_SA(b, h) + m * 2048), "n"(PG8_SA(b, h) + m * 2048 + 1024)); \
            dst##6[m] = __builtin_shufflevector(lo_, __builtin_shufflevector(hi_, hi_, 0, 1, -1, -1), 0, 1, 2, 3, 4, 5); } } \
        else if constexpr (FP8) { _Pragma("unroll") for (int m = 0; m < 4; ++m) { dst##8[m].lo = *(const PG8_LAS v4i*)(lds + PG8_SA(b, h) + aoff + m * 2048); dst##8[m].hi = *(const PG8_LAS v4i*)(lds + PG8_SA(b, h) + aoff + m * 2048 + 1024); } } \
        else { _Pragma("unroll") for (int m = 0; m < 4; ++m) _Pragma("unroll") for (int k = 0; k < 2; ++k) dst[m][k] = *(const PG8_LAS bf16x8*)(lds + PG8_SA(b, h) + aoff + m * 2048 + k * 1024); } } while (0)
#define PG8_LDB(dst, b, h) do { if constexpr (PV == 3) {} else if constexpr (FP6) { _Pragma("unroll") for (int n = 0; n < 2; ++n) { v4i lo_; v2i hi_; \
            asm volatile("ds_read_b128 %0, %2 offset:%3\n\tds_read_b64 %1, %2 offset:%4" : "=&v"(lo_), "=&v"(hi_) : "v"(bbase6), "n"(PG8_SB(b, h) - 4 * HTB + n * 2048), "n"(PG8_SB(b, h) - 4 * HTB + n * 2048 + 1024)); \
            dst##6[n] = __builtin_shufflevector(lo_, __builtin_shufflevector(hi_, hi_, 0, 1, -1, -1), 0, 1, 2, 3, 4, 5); } } \
        else if constexpr (FP8) { _Pragma("unroll") for (int n = 0; n < 2; ++n) { dst##8[n].lo = *(const PG8_LAS v4i*)(lds + PG8_SB(b, h) + boff + n * 2048); dst##8[n].hi = *(const PG8_LAS v4i*)(lds + PG8_SB(b, h) + boff + n * 2048 + 1024); } } \
        else { _Pragma("unroll") for (int n = 0; n < 2; ++n) _Pragma("unroll") for (int k = 0; k < 2; ++k) dst[n][k] = *(const PG8_LAS bf16x8*)(lds + PG8_SB(b, h) + boff + n * 2048 + k * 1024); } } while (0)
#define PG8_MMA(ai, bj, At, Bt) do { __builtin_amdgcn_s_setprio(1); \
        if constexpr (PV == 1) { _Pragma("unroll") for (int m = 0; m < 4; ++m) _Pragma("unroll") for (int k = 0; k < 2; ++k) asm volatile("" :: "v"(At[m][k])); _Pragma("unroll") for (int n = 0; n < 2; ++n) _Pragma("unroll") for (int k = 0; k < 2; ++k) asm volatile("" :: "v"(Bt[n][k])); } \
        else if constexpr (FP6) { _Pragma("unroll") for (int m = 0; m < 4; ++m) _Pragma("unroll") for (int n = 0; n < 2; ++n) \
            asm volatile("v_mfma_scale_f32_16x16x128_f8f6f4 %0, %1, %2, %0, %3, %3 op_sel_hi:[0,0,0] cbsz:2 blgp:2" : "+v"(acc[ai][bj][m][n]) : "v"(Bt##6[n]), "v"(At##6[m]), "v"(sc1)); } \
        else if constexpr (FP8) { _Pragma("unroll") for (int m = 0; m < 4; ++m) _Pragma("unroll") for (int n = 0; n < 2; ++n) \
            asm volatile("v_mfma_scale_f32_16x16x128_f8f6f4 %0, %1, %2, %0, %3, %3 op_sel_hi:[0,0,0]" : "+v"(acc[ai][bj][m][n]) : "v"(Bt##8[n]), "v"(At##8[m]), "v"(sc1)); } \
        else { _Pragma("unroll") for (int m = 0; m < 4; ++m) _Pragma("unroll") for (int n = 0; n < 2; ++n) _Pragma("unroll") for (int k = 0; k < 2; ++k) \
            acc[ai][bj][m][n] = __builtin_amdgcn_mfma_f32_16x16x32_bf16(Bt[n][k], At[m][k], acc[ai][bj][m][n], 0, 0, 0); } \
        __builtin_amdgcn_s_setprio(0); } while (0)
#define PG8_WAIT_V(n) asm volatile("s_waitcnt vmcnt(" #n ")" ::: "memory")
#define PG8_WAIT_L(n) asm volatile("s_waitcnt lgkmcnt(" #n ")" ::: "memory")
#define PG8_BAR __builtin_amdgcn_s_barrier()
#define PG8_SCHED __builtin_amdgcn_sched_barrier(0)
    Unit cur, nxt; int ui = 0;
    if (!S.next(0, cur)) return;
    f32x4 acc[2][2][4][2];
#pragma unroll
    for (int a = 0; a < 2; ++a)
#pragma unroll
        for (int b = 0; b < 2; ++b)
#pragma unroll
            for (int m = 0; m < 4; ++m)
#pragma unroll
                for (int n = 0; n < 2; ++n) acc[a][b][m][n] = (f32x4){0.f, 0.f, 0.f, 0.f};
    const int sc1 = 0x7f7f7f7f;
    bf16x8 At[4][2], B0[2][2], B1[2][2];
    v8i At8[4], B08[2], B18[2];
    v6i At6[4], B06[2], B16[2];
    if constexpr (PV == 3) {
#pragma unroll
        for (int m = 0; m < 4; ++m)
#pragma unroll
            for (int k = 0; k < 2; ++k) At[m][k] = (bf16x8){0, 0, 0, 0, 0, 0, 0, 0};
#pragma unroll
        for (int n = 0; n < 2; ++n)
#pragma unroll
            for (int k = 0; k < 2; ++k) { B0[n][k] = (bf16x8){0, 0, 0, 0, 0, 0, 0, 0}; B1[n][k] = B0[n][k]; } }
    const char* cA = (const char*)g.A + (size_t)S.a_tile(cur) * tstepA; const char* cB = (const char*)g.Bt + S.b_off(cur) + (size_t)cur.pn * tstep;
    S.a_ready(cur);
    if constexpr (SP2) {
        PG8_STAGE(PG8_SB(0, 0), cB, voffB); PG8_STAGE(PG8_SB(0, 1), cB + hstep, voffB); PG8_STAGE(PG8_SA(0, 0), cA, voffA); PG8_STAGE(PG8_SA(0, 1), cA + hstepA, voffA);
        if (wr == 1) PG8_BAR;
        PG8_WAIT_V(2); PG8_BAR;
        PG8_STAGE(PG8_SB(1, 0), cB + kstep, voffB); PG8_STAGE(PG8_SA(1, 0), cA + kstep, voffA); PG8_STAGE(PG8_SB(1, 1), cB + hstep + kstep, voffB);
        PG8_WAIT_V(6); PG8_BAR;
    } else {
        PG8_STAGE(PG8_SB(0, 0), cB, voffB); PG8_STAGE(PG8_SA(0, 0), cA, voffA); PG8_STAGE(PG8_SB(0, 1), cB + hstep, voffB); PG8_STAGE(PG8_SA(0, 1), cA + hstepA, voffA);
        if (wr == 1) PG8_BAR;
        PG8_WAIT_V(4); PG8_BAR;
        PG8_STAGE(PG8_SB(1, 0), cB + kstep, voffB); PG8_STAGE(PG8_SA(1, 0), cA + kstep, voffA); PG8_STAGE(PG8_SB(1, 1), cB + hstep + kstep, voffB);
        PG8_WAIT_V(6); PG8_BAR;
    }
    for (;;) {
        const bool has_next = S.next(ui + 1, nxt);
        const char* nA = has_next ? (const char*)g.A + (size_t)S.a_tile(nxt) * tstepA : cA; const char* nB = has_next ? (const char*)g.Bt + S.b_off(nxt) + (size_t)nxt.pn * tstep : cB;
        for (int t = 0; t < nt; t += 2) {
            const bool last = (t == nt - 2);
            const char* a1 = cA + (size_t)(t + 1) * kstep;
            const char* a2 = last ? nA : cA + (size_t)(t + 2) * kstep; const char* b2 = last ? nB : cB + (size_t)(t + 2) * kstep;
            const char* a3 = a2 + kstep; const char* b3 = b2 + kstep;
            if (last && has_next) S.a_ready(nxt);
            if constexpr (SP2) {
            PG8_LDB(B0, 0, 0); PG8_LDB(B1, 0, 1); PG8_SCHED; PG8_LDA(At, 0, 0); PG8_STAGE(PG8_SA(1, 1), a1 + hstepA, voffA);
            PG8_WAIT_V(8); PG8_WAIT_L(0); PG8_BAR; PG8_MMA(0, 0, At, B0); PG8_MMA(0, 1, At, B1); PG8_BAR; PG8_SCHED;
            PG8_LDA(At, 0, 1); PG8_STAGE(PG8_SB(0, 0), b2, voffB); PG8_STAGE(PG8_SB(0, 1), b2 + hstep, voffB); PG8_STAGE(PG8_SA(0, 0), a2, voffA);
            PG8_WAIT_V(8); PG8_WAIT_L(0); PG8_BAR; PG8_MMA(1, 0, At, B0); PG8_MMA(1, 1, At, B1); PG8_BAR; PG8_SCHED;
            PG8_LDB(B0, 1, 0); PG8_LDB(B1, 1, 1); PG8_SCHED; PG8_LDA(At, 1, 0); PG8_STAGE(PG8_SA(0, 1), a2 + hstepA, voffA);
            PG8_WAIT_V(8); PG8_WAIT_L(0); PG8_BAR; PG8_MMA(0, 0, At, B0); PG8_MMA(0, 1, At, B1); PG8_BAR; PG8_SCHED;
            PG8_LDA(At, 1, 1); PG8_STAGE(PG8_SB(1, 0), b3, voffB); PG8_STAGE(PG8_SB(1, 1), b3 + hstep, voffB); PG8_STAGE(PG8_SA(1, 0), a3, voffA);
            PG8_WAIT_V(8); PG8_WAIT_L(0); PG8_BAR; PG8_MMA(1, 0, At, B0); PG8_MMA(1, 1, At, B1); PG8_BAR; PG8_SCHED;
            } else {
            PG8_LDB(B0, 0, 0); PG8_SCHED; PG8_LDA(At, 0, 0); PG8_STAGE(PG8_SA(1, 1), a1 + hstepA, voffA);
            PG8_WAIT_L(8); PG8_BAR; PG8_WAIT_L(0); PG8_MMA(0, 0, At, B0); PG8_BAR; PG8_SCHED;
            PG8_LDB(B1, 0, 1); PG8_STAGE(PG8_SB(0, 0), b2, voffB);
            PG8_BAR; PG8_WAIT_L(0); PG8_MMA(0, 1, At, B1); PG8_BAR;
            PG8_LDA(At, 0, 1); PG8_STAGE(PG8_SA(0, 0), a2, voffA);
            PG8_BAR; PG8_WAIT_L(0); PG8_MMA(1, 0, At, B0); PG8_BAR; PG8_SCHED;
            PG8_STAGE(PG8_SB(0, 1), b2 + hstep, voffB);
            PG8_WAIT_V(6); PG8_BAR; PG8_MMA(1, 1, At, B1); PG8_BAR;
            PG8_LDB(B0, 1, 0); PG8_SCHED; PG8_LDA(At, 1, 0); PG8_STAGE(PG8_SA(0, 1), a2 + hstepA, voffA);
            PG8_WAIT_L(8); PG8_BAR; PG8_WAIT_L(0); PG8_MMA(0, 0, At, B0); PG8_BAR; PG8_SCHED;
            PG8_LDB(B1, 1, 1); PG8_STAGE(PG8_SB(1, 0), b3, voffB);
            PG8_BAR; PG8_WAIT_L(0); PG8_MMA(0, 1, At, B1); PG8_BAR;
            PG8_LDA(At, 1, 1); PG8_STAGE(PG8_SA(1, 0), a3, voffA);
            PG8_BAR; PG8_WAIT_L(0); PG8_MMA(1, 0, At, B0); PG8_BAR; PG8_SCHED;
            PG8_STAGE(PG8_SB(1, 1), b3 + hstep, voffB);
            PG8_WAIT_V(6); PG8_BAR; PG8_MMA(1, 1, At, B1); PG8_BAR;
            }
        }
        if constexpr (ALIGN_EPI) { if (wr == 0) PG8_BAR; }
        if constexpr (FP8) asm volatile("s_nop 15\n\ts_nop 15" ::: "memory");
        if constexpr (PV == 0) { if (!cur.skip_epi) { E(acc, cur, wr, wc, fr, fq); } } else { asm volatile("" :: "v"(acc[0][0][0][0]), "v"(acc[1][1][3][1])); } S.done(cur);
        if (!has_next) break;
#pragma unroll
        for (int a = 0; a < 2; ++a)
#pragma unroll
            for (int b = 0; b < 2; ++b)
#pragma unroll
                for (int m = 0; m < 4; ++m)
#pragma unroll
                    for (int n = 0; n < 2; ++n) acc[a][b][m][n] = (f32x4){0.f, 0.f, 0.f, 0.f};
        cur = nxt; cA = nA; cB = nB; ++ui;
        if constexpr (ALIGN_EPI) { if (wr == 1) PG8_BAR; }
    }
    PG8_WAIT_V(0);
    if constexpr (!ALIGN_EPI) { if (wr == 0) PG8_BAR; }
    PG8_BAR;
#undef PG8_SA
#undef PG8_SB
#undef PG8_STAGE
#undef PG8_LDA
#undef PG8_LDB
#undef PG8_MMA
#undef PG8_WAIT_V
#undef PG8_WAIT_L
#undef PG8_BAR
#undef PG8_SCHED
}
}

constexpr int NWAVES = 8, NTHR = NWAVES * 64;
constexpr int D = 2048, BATCH = 2, SEQ = 8192, T = BATCH * SEQ, DEPTH = 2;
constexpr int CW = 1024, LW = 1024, LH = 8, LHD = 128, DIN = 4096, CK = 31, LK = 4;
constexpr int UW = 3 * 1024;
constexpr int DFF = 6144, NE = 8;
constexpr float EPS = 1e-6f, LRU_C = 8.0f;
constexpr int MOE_ROWS_MAX = T * 2 + NE * 256;
constexpr float MOE_SC_A = 2.0f;
constexpr float MOE_SC_GU = 64.0f, MOE_SC_D = 128.0f;

constexpr size_t MiB = 1u << 20;
constexpr size_t WS_CTL = 0, CTL_ZERO_BYTES = 1 * MiB;
constexpr size_t WS_WIN = 2 * MiB;
constexpr size_t WS_WOUT = 34 * MiB;
constexpr size_t WS_WGATE = 50 * MiB;
constexpr size_t WS_DWGU = 52 * MiB;
constexpr size_t WS_DWD = 100 * MiB;
constexpr size_t WS_MWGU = 124 * MiB;
constexpr size_t WS_MWD = 316 * MiB;
constexpr size_t WS_X = 700 * MiB;
constexpr size_t WS_H = 828 * MiB;
constexpr size_t WS_ROUTE = 892 * MiB;
constexpr size_t WS_POS = WS_ROUTE + 512 * 1024;
constexpr size_t WS_HAGG = 893 * MiB;
constexpr size_t WS_CAGG = 894 * MiB;
constexpr size_t WS_SSQA = 895 * MiB, WS_SSQB = 895 * MiB + 512 * 1024;
constexpr size_t WS_XG8 = 412 * MiB;
constexpr size_t WS_YB = 896 * MiB;
constexpr size_t WS_XG = WS_YB;
constexpr size_t WS_BIG = 1032 * MiB;
constexpr size_t WS_U = WS_BIG;
constexpr size_t WS_Y = WS_BIG + 128 * MiB;
constexpr size_t WS_P1 = WS_BIG + 192 * MiB;
constexpr size_t WS_P2 = WS_BIG + 224 * MiB;
constexpr size_t WS_HID = WS_BIG;
constexpr size_t WS_END = 1440 * MiB;
constexpr size_t WS_NCONV = WS_XG;
constexpr size_t WS_NRX = WS_XG + 64 * MiB;
constexpr size_t WS_NA = WS_BIG + 256 * MiB;
constexpr size_t WS_NB = WS_BIG + 320 * MiB;
static_assert(WS_NB + 64 * MiB <= WS_END && WS_XG8 + (size_t)NE * T * (D + 128) <= WS_X, "ws map");
constexpr int CW_TMO = 0, CW_CODE = 1;
constexpr int CW_BAR = 4096;
constexpr int CW_CNT = 8192;
constexpr int CW_CUR = 8192 + 1024;
constexpr int CW_XRANK = 8192 + 2048;

constexpr int RING_OFF = 0, RING_BYTES = 131072;
constexpr int LDS_BYTES = 147456;
constexpr int LDSCTL_OFF = LDS_BYTES - 512, MISC_OFF = LDSCTL_OFF + 64;
constexpr int MX_PITCH = 1040, MX_RX = 0, MX_GG = 64 * MX_PITCH, MX_RED = 2 * 64 * MX_PITCH, MX_MR = MX_RED + 2048;
static_assert(MX_MR + 256 <= LDSCTL_OFF, "mixer LDS map");

#define GAS __attribute__((address_space(1)))
#define LAS __attribute__((address_space(3)))
typedef unsigned short bf16;
typedef unsigned v4u __attribute__((ext_vector_type(4)));
typedef unsigned v2u __attribute__((ext_vector_type(2)));
typedef float f32x4 __attribute__((ext_vector_type(4)));
typedef float f32x2 __attribute__((ext_vector_type(2)));
typedef short bf16x8 __attribute__((ext_vector_type(8)));
typedef GAS unsigned gu32;
#define RLX_AGENT __ATOMIC_RELAXED, __HIP_MEMORY_SCOPE_AGENT
#define LDS_WAIT() asm volatile("s_waitcnt lgkmcnt(0)" ::: "memory")
#define VM_WAIT() asm volatile("s_waitcnt vmcnt(0)" ::: "memory")
__device__ __forceinline__ unsigned f2bf(float f) { unsigned u = __builtin_bit_cast(unsigned, f); return (u + 0x7fffu + ((u >> 16) & 1u)) >> 16; }
__device__ __forceinline__ unsigned pk2(float lo, float hi) { unsigned r; asm("v_cvt_pk_bf16_f32 %0, %1, %2" : "=v"(r) : "v"(lo), "v"(hi)); return r; }
__device__ __forceinline__ float bf_lo(unsigned w) { return __uint_as_float(w << 16); }
__device__ __forceinline__ float bf_hi(unsigned w) { return __uint_as_float(w & 0xffff0000u); }
__device__ __forceinline__ float bf2f(bf16 b) { return __uint_as_float(((unsigned)b) << 16); }
__device__ __forceinline__ float sigmoidf_(float x) { return __builtin_amdgcn_rcpf(1.0f + __builtin_amdgcn_exp2f(-1.44269504089f * x)); }
__device__ __forceinline__ float gelu_tanh(float x) { const float u = 0.7978845608f * (x + 0.044715f * x * x * x); return x * sigmoidf_(2.0f * u); }

#define XB_TMO      128
#define XB_XCNT(j)  (256  + 64 * (j))
#define XB_XSUB(j)  (1280 + 64 * (j))
#define XB_XGEN(j)  (2304 + 64 * (j))
#define XB_TOP      3328
#define XB_TOPGEN   3392
#define XCD_BAR_WORDS 3456
#define XB_SPIN_CAP (1u << 18)
__device__ __forceinline__ unsigned xb_ld(unsigned* p)              { return __hip_atomic_load(p, __ATOMIC_RELAXED, __HIP_MEMORY_SCOPE_AGENT); }
__device__ __forceinline__ unsigned xb_add(unsigned* p, unsigned v) { return __hip_atomic_fetch_add(p, v, __ATOMIC_RELAXED, __HIP_MEMORY_SCOPE_AGENT); }
__device__ __forceinline__ unsigned xb_xcc_id() { return (unsigned)__builtin_amdgcn_s_getreg((3 << 11) | 20) & 0xFu; }
#define XB_SPIN(cond, bar) do { unsigned _sp = 0; while (cond) { __builtin_amdgcn_s_sleep(1); \
    if ((++_sp & 255u) == 0u) { if (xb_ld(&(bar)[XB_TMO])) break; if (_sp > XB_SPIN_CAP) { atomicAdd(&(bar)[XB_TMO], 1u); break; } } } } while (0)
struct XcdBarrier { unsigned* bar; unsigned x; volatile LAS unsigned* st; };
__device__ __forceinline__ XcdBarrier xcd_barrier_post(unsigned* bar, volatile LAS unsigned* st) {
    XcdBarrier b; b.bar = bar; b.x = xb_xcc_id(); b.st = st;
    if (threadIdx.x == 0) (void)xb_add(&bar[XB_XCNT(b.x)], 1u);
    return b;
}
__device__ __forceinline__ void xcd_barrier_complete(unsigned* bar, unsigned x, unsigned& nloc, unsigned& nx) {
    const unsigned G = gridDim.x * gridDim.y * gridDim.z;
    unsigned sum, cnt, mine, sp = 0u;
    for (;;) {
        sum = 0u; cnt = 0u; mine = 0u;
#pragma unroll
        for (unsigned j = 0; j < 16; ++j) { const unsigned c = xb_ld(&bar[XB_XCNT(j)]); sum += c; cnt += (c > 0u) ? 1u : 0u; mine = (j == x) ? c : mine; }
        if (sum == G) break;
        __builtin_amdgcn_s_sleep(1);
        if ((++sp & 255u) == 0u) { if (xb_ld(&bar[XB_TMO])) break; if (sp > XB_SPIN_CAP) { atomicAdd(&bar[XB_TMO], 1u); break; } }
    }
    nloc = mine > 0u ? mine : 1u; nx = cnt > 0u ? cnt : 1u;
}
__device__ __forceinline__ void xcd_barrier(const XcdBarrier& b) {
    asm volatile("s_waitcnt vmcnt(0)" ::: "memory");
    __syncthreads();
    if (threadIdx.x == 0) {
        unsigned* bar = b.bar;
        __builtin_amdgcn_s_waitcnt(0);
        unsigned nloc = b.st[0], nx = b.st[1];
        if (nloc == 0u) { xcd_barrier_complete(bar, b.x, nloc, nx); b.st[0] = nloc; b.st[1] = nx; }
        const unsigned old = xb_add(&bar[XB_XSUB(b.x)], 1u);
        const unsigned gen = old / nloc;
        if (old + 1u == (gen + 1u) * nloc) {
            __builtin_amdgcn_fence(__ATOMIC_RELEASE, "agent");
            asm volatile("s_waitcnt vmcnt(0)" ::: "memory");
            const unsigned og = xb_add(&bar[XB_TOP], 1u);
            const unsigned tg = og / nx;
            if (og + 1u == (tg + 1u) * nx) xb_add(&bar[XB_TOPGEN], 1u);
            else XB_SPIN(xb_ld(&bar[XB_TOPGEN]) == tg, bar);
            __builtin_amdgcn_fence(__ATOMIC_ACQUIRE, "agent");
            xb_add(&bar[XB_XGEN(b.x)], 1u);
            asm volatile("s_waitcnt vmcnt(0)" ::: "memory");
        } else {
            XB_SPIN(xb_ld(&bar[XB_XGEN(b.x)]) == gen, bar);
            __builtin_amdgcn_fence(__ATOMIC_ACQUIRE, "agent");
            asm volatile("s_waitcnt vmcnt(0)" ::: "memory");
        }
    }
    __syncthreads();
}

__device__ __forceinline__ float wave_sum(float v) {
#pragma unroll
    for (int o = 1; o < 64; o <<= 1) v += __shfl_xor(v, o);
    return v;
}

constexpr int CW_ = 1024;
__device__ __forceinline__ void tr_item(const float* __restrict__ W, int K, int N, bf16* WT, int mode, int item, LAS unsigned* scr, int lane, const float* kgain = nullptr) {
    const int nblk = N >> 6, kb = item / nblk, nb = item - kb * nblk, k0 = kb << 6, n0 = nb << 6;
    const int q = lane & 15, r = lane >> 4;
    f32x4 A[8], B[8];
#pragma unroll
    for (int i = 0; i < 8; ++i) { const float* p = W + (size_t)(k0 + 2 * (4 * i + r)) * N + n0 + 4 * q; A[i] = __builtin_nontemporal_load((const GAS f32x4*)p); B[i] = __builtin_nontemporal_load((const GAS f32x4*)(p + N)); }
    if (kgain) {
#pragma unroll
        for (int i = 0; i < 8; ++i) { const f32x2 g2 = *(const GAS f32x2*)(kgain + k0 + 2 * (4 * i + r)); A[i] *= g2.x; B[i] *= g2.y; } }
#pragma unroll
    for (int i = 0; i < 8; ++i)
#pragma unroll
        for (int j = 0; j < 4; ++j) scr[(4 * q + j) * 32 + ((4 * i + r) ^ (4 * (q & 7)))] = pk2(A[i][j], B[i][j]);
    LDS_WAIT(); asm volatile("" ::: "memory");
    const int c = lane & 7;
#pragma unroll
    for (int jj = 0; jj < 8; ++jj) { const int n = (lane >> 3) + 8 * jj; const v4u o = *(const LAS v4u*)(scr + n * 32 + 4 * (c ^ ((n >> 2) & 7)));
        const int ng = n0 + n; int row = mode == 0 ? ng : ((ng >> 7) * 256 + (ng & 127) + (mode == 2 ? 128 : 0));
        if (mode == 3) row = ng >= 2 * CW_ ? ng : (ng < CW_ ? ((ng >> 7) * 256 + (ng & 127)) : ((((ng - CW_) >> 7) * 256) + 128 + ((ng - CW_) & 127)));
        *(GAS v4u*)(WT + (size_t)row * K + k0 + 8 * c) = o; }
    LDS_WAIT(); asm volatile("" ::: "memory");
}


__device__ __forceinline__ unsigned cvt4_fp8(float a, float b, float c, float d) { int w = 0; w = __builtin_amdgcn_cvt_pk_fp8_f32(a, b, w, false); w = __builtin_amdgcn_cvt_pk_fp8_f32(c, d, w, true); return (unsigned)w; }
__device__ __forceinline__ void tr_item8(const float* __restrict__ W, int K, int N, unsigned char* WT, int mode, int item, LAS unsigned* scr, int lane, float sc) {
    const int nblk = N >> 5, kb = item / nblk, nb = item - kb * nblk, k0 = kb << 7, n0 = nb << 5;
    const int q = lane & 7, r = lane >> 3;
#pragma unroll
    for (int i = 0; i < 4; ++i) { const int p = 8 * i + r; const float* src = W + (size_t)(k0 + 4 * p) * N + n0 + 4 * q;
        const f32x4 R0 = __builtin_nontemporal_load((const GAS f32x4*)src), R1 = __builtin_nontemporal_load((const GAS f32x4*)(src + N)), R2 = __builtin_nontemporal_load((const GAS f32x4*)(src + 2 * (size_t)N)), R3 = __builtin_nontemporal_load((const GAS f32x4*)(src + 3 * (size_t)N));
#pragma unroll
        for (int j = 0; j < 4; ++j) scr[(4 * q + j) * 32 + (p ^ (4 * q))] = cvt4_fp8(R0[j] * sc, R1[j] * sc, R2[j] * sc, R3[j] * sc); }
    LDS_WAIT(); asm volatile("" ::: "memory");
    const int c = lane & 7;
#pragma unroll
    for (int jj = 0; jj < 4; ++jj) { const int n = (lane >> 3) + 8 * jj; const v4u o = *(const LAS v4u*)(scr + n * 32 + 4 * (c ^ ((n >> 2) & 7)));
        const int ng = n0 + n; const int row = mode == 0 ? ng : ((ng >> 7) * 256 + (ng & 127) + (mode == 2 ? 128 : 0));
        *(GAS v4u*)(WT + (size_t)row * K + k0 + 16 * c) = o; }
    LDS_WAIT(); asm volatile("" ::: "memory");
}

__device__ __forceinline__ void row_to_bf16_ssq(const float* xrow, bf16* orow, float* ssq8row, int lane) {
    const GAS f32x4* xr = (const GAS f32x4*)xrow + lane;
    f32x4 v[8]; float s = 0.f;
#pragma unroll
    for (int j = 0; j < 8; ++j) v[j] = xr[64 * j];
    GAS v2u* o8 = (GAS v2u*)orow + lane;
#pragma unroll
    for (int j = 0; j < 8; ++j) { v2u o; o.x = pk2(v[j].x, v[j].y); o.y = pk2(v[j].z, v[j].w); o8[64 * j] = o;
        const float r0 = bf_lo(o.x), r1 = bf_hi(o.x), r2 = bf_lo(o.y), r3 = bf_hi(o.y); s += (r0 * r0 + r1 * r1) + (r2 * r2 + r3 * r3); }
    s = wave_sum(s);
    if (lane < 2) ((GAS f32x4*)ssq8row)[lane] = (f32x4){lane == 0 ? s : 0.f, 0.f, 0.f, 0.f};
}
__device__ __forceinline__ void rms_row_to_bf16(const float* xrow, const float* gain, bf16* orow, int lane) {
    const GAS f32x4* xr = (const GAS f32x4*)xrow + lane; const GAS f32x4* gr = (const GAS f32x4*)gain + lane;
    f32x4 v[8]; float s = 0.f;
#pragma unroll
    for (int j = 0; j < 8; ++j) { v[j] = xr[64 * j]; s += (v[j].x * v[j].x + v[j].y * v[j].y) + (v[j].z * v[j].z + v[j].w * v[j].w); }
    const float rstd = 1.0f / sqrtf(wave_sum(s) * (1.0f / D) + EPS);
    GAS v2u* o8 = (GAS v2u*)orow + lane;
#pragma unroll
    for (int j = 0; j < 8; ++j) { const f32x4 g = gr[64 * j]; v2u o; o.x = pk2(v[j].x * rstd * g.x, v[j].y * rstd * g.y); o.y = pk2(v[j].z * rstd * g.z, v[j].w * rstd * g.w); o8[64 * j] = o; }
}


__device__ __forceinline__ float transpose_reduce64(float (&v)[64], int lane) {
#pragma unroll
    for (int d = 32; d >= 1; d >>= 1) {
        const bool up = (lane & d) != 0;
#pragma unroll
        for (int i = 0; i < d; ++i) { float x = v[i], y = v[i + d]; asm volatile("" : "+v"(x), "+v"(y));
            const float keep = up ? y : x; const float send = up ? x : y; v[i] = keep + __shfl_xor(send, d); }
    }
    return v[0];
}

__device__ __forceinline__ void swap32f(float& a, float& b) { const auto r = __builtin_amdgcn_permlane32_swap(__float_as_uint(a), __float_as_uint(b), false, false); a = __uint_as_float(r[0]); b = __uint_as_float(r[1]); }
__device__ __forceinline__ void swap16f(float& a, float& b) { const auto r = __builtin_amdgcn_permlane16_swap(__float_as_uint(a), __float_as_uint(b), false, false); a = __uint_as_float(r[0]); b = __uint_as_float(r[1]); }
__device__ __forceinline__ float transpose_reduce32(float (&v)[32], int lane) {
#pragma unroll
    for (int i = 0; i < 16; ++i) { float x = v[i], y = v[i + 16]; swap32f(x, y); v[i] = x + y; }
#pragma unroll
    for (int i = 0; i < 8; ++i) { float x = v[i], y = v[i + 8]; swap16f(x, y); v[i] = x + y; }
#pragma unroll
    for (int d = 8; d >= 2; d >>= 1) {
        const bool up = (lane & d) != 0;
#pragma unroll
        for (int i = 0; i < d / 2; ++i) { float x = v[i], y = v[i + d / 2]; asm volatile("" : "+v"(x), "+v"(y));
            const float keep = up ? y : x; const float send = up ? x : y; v[i] = keep + __shfl_xor(send, d); }
    }
    v[0] += __shfl_xor(v[0], 1);
    return v[0];
}

__device__ __forceinline__ void conv_unit(const bf16* U, bf16* Y, const float* conv_w, const float* conv_b, const float* lng, const float* lnb, int tile, LAS unsigned char* lds, int tid, int lane, int wave) {
    LAS float* red = (LAS float*)(lds + MX_RED);
    LAS float* mr = (LAS float*)(lds + MX_MR);
    const int r0 = tile * 64, tl0 = r0 & (SEQ - 1), c0 = 2 * tid;
    for (int chunk = 0; chunk < 2; ++chunk) {
        const int rb = r0 + 32 * chunk; const bool head = (tl0 + 32 * chunk) == 0;
        f32x2 w[CK];
#pragma unroll
        for (int k = 0; k < CK; ++k) w[k] = *(const GAS f32x2*)(conv_w + k * CW + c0);
        const f32x2 bias = *(const GAS f32x2*)(conv_b + c0);
        f32x2 acc[32];
#pragma unroll
        for (int o = 0; o < 32; ++o) acc[o] = bias;
        const GAS unsigned* up = (const GAS unsigned*)(U + (size_t)rb * UW + c0);
        unsigned vb[2][4];
#pragma unroll
        for (int jj = 0; jj < 4; ++jj) { const long ro = head ? 0 : (long)(jj - 30); vb[0][jj] = up[ro * (UW / 2)]; }
#pragma unroll
        for (int jb = 0; jb < 16; ++jb) {
            if (jb < 15) {
#pragma unroll
                for (int jj = 0; jj < 4; ++jj) { const int j = 4 * (jb + 1) + jj; if (j < 62) { const long ro = (head && j < 30) ? 0 : (long)(j - 30); vb[(jb + 1) & 1][jj] = up[ro * (UW / 2)]; } } }
            const unsigned (&vv)[4] = vb[jb & 1];
#pragma unroll
            for (int jj = 0; jj < 4; ++jj) { const int j = 4 * jb + jj; if (j < 62) {
                f32x2 glu; glu.x = bf_lo(vv[jj]); glu.y = bf_hi(vv[jj]);
                if (head && j < 30) glu = (f32x2){0.f, 0.f};
#pragma unroll
                for (int o = 0; o < 32; ++o) { const int k = j - o; if (k >= 0 && k < CK) acc[o] += w[k] * glu; } } }
        }
        { float v[32];
#pragma unroll
          for (int o = 0; o < 32; ++o) v[o] = acc[o].x + acc[o].y;
          const float t1 = transpose_reduce32(v, lane); if (!(lane & 1)) red[wave * 64 + (lane >> 1)] = t1;
#pragma unroll
          for (int o = 0; o < 32; ++o) v[o] = acc[o].x * acc[o].x + acc[o].y * acc[o].y;
          const float t2 = transpose_reduce32(v, lane); if (!(lane & 1)) red[wave * 64 + 32 + (lane >> 1)] = t2; }
        __syncthreads();
        if (tid < 32) { float s1 = 0.f, s2 = 0.f;
#pragma unroll
            for (int wv = 0; wv < 8; ++wv) { s1 += red[wv * 64 + tid]; s2 += red[wv * 64 + 32 + tid]; }
            const float mean = s1 * (1.0f / CW); const float var = fmaxf(s2 * (1.0f / CW) - mean * mean, 0.f);
            mr[2 * tid] = mean; mr[2 * tid + 1] = __builtin_amdgcn_rsqf(var + EPS); }
        __syncthreads();
        const f32x2 lg = *(const GAS f32x2*)(lng + c0), lb = *(const GAS f32x2*)(lnb + c0);
        GAS unsigned* yp = (GAS unsigned*)(Y + (size_t)rb * D + c0);
#pragma unroll
        for (int o = 0; o < 32; ++o) { const float mean = mr[2 * o], rstd = mr[2 * o + 1];
            const float z0 = (acc[o].x - mean) * rstd * lg.x + lb.x, z1 = (acc[o].y - mean) * rstd * lg.y + lb.y;
            yp[(size_t)o * (D / 2)] = pk2(z0 * sigmoidf_(z0), z1 * sigmoidf_(z1)); }
        __syncthreads();
    }
}

__device__ __forceinline__ void lru_unit(const bf16* U, bf16* P1, bf16* P2, float* HAGG, float* CAGG, const bf16* WgT  ,
                                         const float* lcw, const float* lcb, const float* ba, const float* bxx, const float* lam, int tile, LAS unsigned char* lds, int tid, int lane, int wave) {
    const int r0 = tile * 64, tl0 = r0 & (SEQ - 1);
    const int fr = lane & 15, fq = lane >> 4;
    for (int hh = 0; hh < 2; ++hh) {
        { const int cp = tid & 255, th = tid >> 8, c = 512 * hh + 2 * cp;
          f32x2 w4[LK];
#pragma unroll
          for (int k = 0; k < LK; ++k) w4[k] = *(const GAS f32x2*)(lcw + k * LW + c);
          const f32x2 b4 = *(const GAS f32x2*)(lcb + c);
          const bool head = (tl0 == 0) && (th == 0);
          const GAS unsigned* up = (const GAS unsigned*)(U + (size_t)(r0 + 32 * th) * UW + CW + c);
          f32x2 win[3];
#pragma unroll
          for (int i = 0; i < 3; ++i) { const unsigned u = head ? 0u : up[(long)(i - 3) * (UW / 2)]; win[i] = (f32x2){bf_lo(u), bf_hi(u)}; }
          LAS unsigned* rxw = (LAS unsigned*)(lds + MX_RX + (32 * th) * MX_PITCH + 4 * cp);
          LAS unsigned* ggw = (LAS unsigned*)(lds + MX_GG + (32 * th) * MX_PITCH + 4 * cp);
#pragma unroll 8
          for (int i = 0; i < 32; ++i) { const unsigned u = up[(long)i * (UW / 2)], gt = up[(long)i * (UW / 2) + CW / 2];
              const f32x2 cur = (f32x2){bf_lo(u), bf_hi(u)};
              const f32x2 rx = b4 + w4[0] * win[0] + w4[1] * win[1] + w4[2] * win[2] + w4[3] * cur;
              win[0] = win[1]; win[1] = win[2]; win[2] = cur;
              rxw[i * (MX_PITCH / 4)] = pk2(rx.x, rx.y);
              ggw[i * (MX_PITCH / 4)] = pk2(gelu_tanh(bf_lo(gt)), gelu_tanh(bf_hi(gt))); } }
        __syncthreads();
        { const int hl = wave >> 1, hd = 4 * hh + hl, nb = 64 * (wave & 1);
          const bf16* WaT = WgT + (size_t)hd * LHD * LHD; const bf16* WxT = WgT + (size_t)(LH + hd) * LHD * LHD;
          bf16x8 bA[4], bX[4]; float ba_c, bx_c, lam_c;
#pragma unroll
          for (int ks = 0; ks < 4; ++ks) { bA[ks] = *(const GAS bf16x8*)(WaT + (size_t)(nb + fr) * LHD + 32 * ks + 8 * fq); bX[ks] = *(const GAS bf16x8*)(WxT + (size_t)(nb + fr) * LHD + 32 * ks + 8 * fq); }
          ba_c = ba[LHD * hd + nb + fr]; bx_c = bxx[LHD * hd + nb + fr]; lam_c = lam[LHD * hd + nb + fr];
#pragma unroll 1
          for (int nt = 0; nt < 4; ++nt) {
              const int n0 = nb + 16 * nt, ch = LHD * hd + n0 + fr, lcol = LHD * hl + n0 + fr;
              f32x4 aa[4], ax[4];
#pragma unroll
              for (int m = 0; m < 4; ++m) { aa[m] = (f32x4){0.f, 0.f, 0.f, 0.f}; ax[m] = aa[m]; }
#pragma unroll
              for (int ks = 0; ks < 4; ++ks)
#pragma unroll
                  for (int m = 0; m < 4; ++m) { const bf16x8 af = *(const LAS bf16x8*)(lds + MX_RX + (16 * m + fr) * MX_PITCH + (LHD * hl + 32 * ks + 8 * fq) * 2);
                      aa[m] = __builtin_amdgcn_mfma_f32_16x16x32_bf16(af, bA[ks], aa[m], 0, 0, 0); ax[m] = __builtin_amdgcn_mfma_f32_16x16x32_bf16(af, bX[ks], ax[m], 0, 0, 0); }
              const float ba_u = ba_c, bx_u = bx_c, lam_u = lam_c;
              if (nt < 3) {
                  asm volatile("" ::: "memory");
#pragma unroll
                  for (int ks = 0; ks < 4; ++ks) { bA[ks] = *(const GAS bf16x8*)(WaT + (size_t)(n0 + 16 + fr) * LHD + 32 * ks + 8 * fq); bX[ks] = *(const GAS bf16x8*)(WxT + (size_t)(n0 + 16 + fr) * LHD + 32 * ks + 8 * fq); }
                  ba_c = ba[ch + 16]; bx_c = bxx[ch + 16]; lam_c = lam[ch + 16]; }
              const float nl = -lam_u; const float sp8 = LRU_C * (fmaxf(nl, 0.f) + __logf(1.0f + __expf(-fabsf(nl))));
              const LAS bf16* rxr = (const LAS bf16*)(lds + MX_RX) + lcol; const LAS bf16* ggr = (const LAS bf16*)(lds + MX_GG) + lcol;
              float hl4[4][4], cl4[4][4], A[4], B[4];
#pragma unroll
              for (int m = 0; m < 4; ++m) { float h = 0.f, cp = 1.f;
#pragma unroll
                  for (int j = 0; j < 4; ++j) { const int tt = 16 * m + 4 * fq + j;
                      const float ga = sigmoidf_(aa[m][j] + ba_u), gx = sigmoidf_(ax[m][j] + bx_u);
                      const float la = -sp8 * ga, a = __builtin_amdgcn_exp2f(1.44269504089f * la);
                      const float x2 = 2.0f * la;
                      const float om_s = -x2 * (1.0f + x2 * (0.5f + x2 * (0.16666667f + x2 * (0.041666668f + x2 * 0.0083333338f))));
                      const float om = (x2 > -0.25f) ? om_s : (1.0f - a * a);
                      float mult = __builtin_amdgcn_sqrtf(fmaxf(om, 0.f)); if (tl0 == 0 && tt == 0) mult = 1.0f;
                      const float b = mult * gx * bf2f(rxr[tt * (MX_PITCH / 2)]);
                      h = a * h + b; cp *= a; hl4[m][j] = h; cl4[m][j] = cp; }
                  A[m] = cp; B[m] = h; }
#pragma unroll
              for (int m = 0; m < 4; ++m) { const float Ap = __shfl_up(A[m], 16), Bp = __shfl_up(B[m], 16); if (fq >= 1) { B[m] = A[m] * Bp + B[m]; A[m] = A[m] * Ap; } }
#pragma unroll
              for (int m = 0; m < 4; ++m) { const float Ap = __shfl_up(A[m], 32), Bp = __shfl_up(B[m], 32); if (fq >= 2) { B[m] = A[m] * Bp + B[m]; A[m] = A[m] * Ap; } }
              float TA[4], TB[4], EA[4], EB[4];
#pragma unroll
              for (int m = 0; m < 4; ++m) { TA[m] = __shfl(A[m], 48 + fr); TB[m] = __shfl(B[m], 48 + fr); EA[m] = __shfl_up(A[m], 16); EB[m] = __shfl_up(B[m], 16); if (fq == 0) { EA[m] = 1.f; EB[m] = 0.f; } }
              float Hc = 0.f, Cc = 1.f;
#pragma unroll
              for (int m = 0; m < 4; ++m) { const float Hin = EA[m] * Hc + EB[m], Cin = EA[m] * Cc;
#pragma unroll
                  for (int j = 0; j < 4; ++j) { const int tt = 16 * m + 4 * fq + j; const float g = bf2f(ggr[tt * (MX_PITCH / 2)]);
                      const float hf = hl4[m][j] + cl4[m][j] * Hin, cf = cl4[m][j] * Cin;
                      { const unsigned w = pk2(hf * g, cf * g); P1[(size_t)(r0 + tt) * LW + ch] = (bf16)(w & 0xffffu); P2[(size_t)(r0 + tt) * LW + ch] = (bf16)(w >> 16); } }
                  Hc = TA[m] * Hc + TB[m]; Cc = TA[m] * Cc; }
              if (fq == 0) { HAGG[(size_t)tile * LW + ch] = Hc; CAGG[(size_t)tile * LW + ch] = Cc; }
          } }
        __syncthreads();
    }
}

__device__ __forceinline__ void lru_fix_unit(const bf16* P1, const bf16* P2, const float* HAGG, const float* CAGG, bf16* Y, int tile, LAS unsigned char* lds, int tid) {
    const int tb = tile & ~(SEQ / 64 - 1), j = tile & (SEQ / 64 - 1);
    const int cg = tid & 127, ts = tid >> 7;
    float A[8], B[8];
#pragma unroll
    for (int q = 0; q < 8; ++q) { A[q] = 1.f; B[q] = 0.f; }
    const int i0 = (j * ts) >> 2, i1 = (j * (ts + 1)) >> 2;
    for (int i = i0; i < i1; ++i) { const GAS f32x4* cp = (const GAS f32x4*)(CAGG + (size_t)(tb + i) * LW + 8 * cg); const GAS f32x4* hp = (const GAS f32x4*)(HAGG + (size_t)(tb + i) * LW + 8 * cg);
        const f32x4 c0 = cp[0], c1 = cp[1], h0 = hp[0], h1 = hp[1];
#pragma unroll
        for (int q = 0; q < 4; ++q) { B[q] = c0[q] * B[q] + h0[q]; A[q] *= c0[q]; B[4 + q] = c1[q] * B[4 + q] + h1[q]; A[4 + q] *= c1[q]; } }
    LAS float* part = (LAS float*)lds;
#pragma unroll
    for (int q = 0; q < 8; ++q) { part[(ts * 128 + cg) * 16 + q] = A[q]; part[(ts * 128 + cg) * 16 + 8 + q] = B[q]; }
    __syncthreads();
    float hin[8];
#pragma unroll
    for (int q = 0; q < 8; ++q) hin[q] = 0.f;
#pragma unroll
    for (int sgm = 0; sgm < 4; ++sgm)
#pragma unroll
        for (int q = 0; q < 8; ++q) hin[q] = part[(sgm * 128 + cg) * 16 + q] * hin[q] + part[(sgm * 128 + cg) * 16 + 8 + q];
    __syncthreads();
    const int r0 = tile * 64;
#pragma unroll 4
    for (int tt = ts; tt < 64; tt += 4) { const v4u p1 = *(const GAS v4u*)(P1 + (size_t)(r0 + tt) * LW + 8 * cg), p2 = *(const GAS v4u*)(P2 + (size_t)(r0 + tt) * LW + 8 * cg);
        v4u o;
        o.x = pk2(bf_lo(p1.x) + bf_lo(p2.x) * hin[0], bf_hi(p1.x) + bf_hi(p2.x) * hin[1]); o.y = pk2(bf_lo(p1.y) + bf_lo(p2.y) * hin[2], bf_hi(p1.y) + bf_hi(p2.y) * hin[3]);
        o.z = pk2(bf_lo(p1.z) + bf_lo(p2.z) * hin[4], bf_hi(p1.z) + bf_hi(p2.z) * hin[5]); o.w = pk2(bf_lo(p1.w) + bf_lo(p2.w) * hin[6], bf_hi(p1.w) + bf_hi(p2.w) * hin[7]);
        *(GAS v4u*)(Y + (size_t)(r0 + tt) * D + CW + 8 * cg) = o; }
}


struct MoeItem { const float* W; unsigned char* WT; int K, N, mode, item; float sc; };
__device__ __forceinline__ MoeItem moe_item(int it, const float* wg, const float* wu, const float* wd, unsigned char* MWgu8, unsigned char* MWd8) {
    constexpr int I_GU = (D / 128) * (DFF / 128), I_DN = (DFF / 128) * (D / 128), N_MGU = NE * 2 * I_GU;
    MoeItem m;
    if (it < N_MGU) { const int e = it / (2 * I_GU), rr = it % (2 * I_GU), w = rr / I_GU; m.W = (w == 0 ? wg : wu) + (size_t)e * D * DFF; m.WT = MWgu8 + (size_t)e * 2 * DFF * D; m.K = D; m.N = DFF; m.mode = 1 + w; m.item = rr % I_GU; m.sc = MOE_SC_GU; }
    else { const int r = it - N_MGU, e = r / I_DN; m.W = wd + (size_t)e * DFF * D; m.WT = MWd8 + (size_t)e * D * DFF; m.K = DFF; m.N = D; m.mode = 0; m.item = r % I_DN; m.sc = MOE_SC_D; }
    return m;
}
__device__ __forceinline__ void tr8_load(const MoeItem& m, int sblk, f32x4 (&R)[16], int lane) {
    const int nblk = m.N >> 7, kb = m.item / nblk, nb = m.item - kb * nblk, k0 = (kb << 7) + 32 * sblk, n0 = nb << 7, q = lane & 31, r = lane >> 5;
#pragma unroll
    for (int i = 0; i < 4; ++i) { const float* src = m.W + (size_t)(k0 + 4 * (2 * i + r)) * m.N + n0 + 4 * q;
#pragma unroll
        for (int x = 0; x < 4; ++x) R[4 * i + x] = __builtin_nontemporal_load((const GAS f32x4*)(src + (size_t)x * m.N)); }
}
__device__ __forceinline__ void tr8_sub(const MoeItem& m, int sblk, const f32x4 (&R)[16], LAS unsigned* scr, int lane) {
    const int q = lane & 31, r = lane >> 5; const float sc = m.sc;
#pragma unroll
    for (int i = 0; i < 4; ++i) { const int p = 8 * sblk + 2 * i + r;
#pragma unroll
        for (int j = 0; j < 4; ++j) scr[(4 * q + j) * 32 + (p ^ (4 * (q & 7)))] = cvt4_fp8(R[4 * i][j] * sc, R[4 * i + 1][j] * sc, R[4 * i + 2][j] * sc, R[4 * i + 3][j] * sc); }
}
__device__ __forceinline__ void tr8_store(const MoeItem& m, LAS unsigned* scr, int lane) {
    const int nblk = m.N >> 7, kb = m.item / nblk, nb = m.item - kb * nblk, k0 = kb << 7, n0 = nb << 7;
    LDS_WAIT(); asm volatile("" ::: "memory");
    const int c = lane & 7;
#pragma unroll
    for (int jj = 0; jj < 16; ++jj) { const int n = (lane >> 3) + 8 * jj; const v4u o = *(const LAS v4u*)(scr + n * 32 + 4 * (c ^ ((n >> 2) & 7)));
        const int ng = n0 + n; const int row = m.mode == 0 ? ng : ((ng >> 7) * 256 + (ng & 127) + (m.mode == 2 ? 128 : 0));
        __builtin_nontemporal_store(o, (GAS v4u*)(m.WT + (size_t)row * m.K + k0 + 16 * c)); }
    LDS_WAIT(); asm volatile("" ::: "memory");
}
typedef float v16f __attribute__((ext_vector_type(16)));
typedef unsigned v6u __attribute__((ext_vector_type(6)));
__device__ __forceinline__ void tr6_load(const MoeItem& m, int sblk, f32x2 (&R)[32], int lane) {
    const int nblk = m.N >> 7, kb = m.item / nblk, nb = m.item - kb * nblk, k0 = 16 * kb + 4 * sblk, n0 = nb << 7;
    const __amdgpu_buffer_rsrc_t rs = __builtin_amdgcn_make_buffer_rsrc((void*)m.W, 0, m.K * m.N * 4, 0x00020000);
    const int vo = (n0 + 2 * lane) * 4, rowb = m.N * 4, so0 = k0 * rowb;
#pragma unroll
    for (int t = 0; t < 32; ++t) { const v2u w = __builtin_amdgcn_raw_buffer_load_b64(rs, vo, so0 + ((t & 3) + 256 * (t >> 2)) * rowb, 2  ); R[t] = (f32x2){__uint_as_float(w.x), __uint_as_float(w.y)}; }
}
__device__ __forceinline__ void tr6_sub(const MoeItem& m, int sblk, const f32x2 (&R)[32], LAS unsigned* scr, int lane) {
    const float sc = m.sc;
#pragma unroll
    for (int b = 0; b < 2; ++b) { v16f x, y;
#pragma unroll
        for (int k = 0; k < 16; ++k) { x[k] = R[k][b]; y[k] = R[16 + k][b]; }
        v6u d; asm volatile("v_cvt_scalef32_2xpk16_fp6_f32 %0, %1, %2, %3" : "=&v"(d) : "v"(x), "v"(y), "v"(1.0f / sc));
        const int row = 2 * lane + b, sw = (row >> 2) & 7;
        LAS unsigned* p1 = scr + row * 32 + 4 * (sblk ^ sw); LAS unsigned* p2 = scr + row * 32 + 4 * ((4 + sblk) ^ sw);
        p1[0] = d[0]; p1[1] = d[1]; p1[2] = d[2]; p1[3] = d[3]; p2[0] = d[4]; p2[1] = d[5]; }
}
__device__ __forceinline__ void moe_convert_share(const float* wg, const float* wu, const float* wd, unsigned char* MWgu8, unsigned char* MWd8, LAS unsigned char* lds, int gw, int NGW, int wave, int lane) {
    LAS unsigned* scr = (LAS unsigned*)(lds + RING_OFF + wave * 16384);
    constexpr int N_MGU = NE * 2 * (D / 128) * (DFF / 128), NTOT = N_MGU + NE * (DFF / 128) * (D / 128);
    int it = gw;
    { f32x2 Qa[32], Qb[32];
      for (; it < N_MGU; it += NGW) {
        const MoeItem m = moe_item(it, wg, wu, wd, MWgu8, MWd8);
        tr6_load(m, 0, Qa, lane);
        tr6_load(m, 1, Qb, lane); tr6_sub(m, 0, Qa, scr, lane);
        tr6_load(m, 2, Qa, lane); tr6_sub(m, 1, Qb, scr, lane);
        tr6_load(m, 3, Qb, lane); tr6_sub(m, 2, Qa, scr, lane);
        tr6_sub(m, 3, Qb, scr, lane);
        tr8_store(m, scr, lane);
      } }
    f32x4 Ra[16], Rb[16];
    for (; it < NTOT; it += NGW) {
        const MoeItem m = moe_item(it, wg, wu, wd, MWgu8, MWd8);
        tr8_load(m, 0, Ra, lane);
        tr8_load(m, 1, Rb, lane); tr8_sub(m, 0, Ra, scr, lane);
        tr8_load(m, 2, Ra, lane); tr8_sub(m, 1, Rb, scr, lane);
        tr8_load(m, 3, Rb, lane); tr8_sub(m, 2, Ra, scr, lane);
        tr8_sub(m, 3, Rb, scr, lane);
        tr8_store(m, scr, lane);
    }
}

struct Args { const float* in[24]; float* out; unsigned char* ws; int ph_lo, ph_hi; };
constexpr int N_PHASES = 15;

constexpr int DC_I_IN = (D / 64) * (DIN / 64), DC_I_OUT = (D / 64) * (D / 64), DC_I_GU = (D / 64) * (DFF / 64), DC_I_DN = (DFF / 64) * (D / 64), DC_I_GT = 4;
constexpr int DC_N_GT = DEPTH * 2 * LH * DC_I_GT, DC_N_EARLY = DC_I_IN + DC_N_GT, DC_N_ALL = DC_N_EARLY + DC_I_IN + 2 * DC_I_OUT + 2 * DC_I_GU + DC_I_DN;
__device__ __forceinline__ void dense_convert_items(const Args& args, unsigned char* ws, int lo, int hi, LAS unsigned char* lds, int gw, int NGW, int wave, int lane) {
    LAS unsigned* scr = (LAS unsigned*)(lds + RING_OFF + wave * 8192);
    bf16* Win_t = (bf16*)(ws + WS_WIN); bf16* Wout_t = (bf16*)(ws + WS_WOUT); bf16* Wgate_t = (bf16*)(ws + WS_WGATE); bf16* DWgu = (bf16*)(ws + WS_DWGU); bf16* DWd = (bf16*)(ws + WS_DWD);
    for (int it = lo + gw; it < hi; it += NGW) {
        int r = it;
        if (r < DC_I_IN) { tr_item(args.in[2], D, DIN, Win_t, 3, r, scr, lane, args.in[1]); continue; } r -= DC_I_IN;
        if (r < DC_N_GT) { const int m = r / DC_I_GT;
            const int l = m / 16, ax = (m / 8) & 1, h = m & 7;
            tr_item((ax == 0 ? args.in[9] : args.in[11]) + (size_t)(l * LH + h) * LHD * LHD, LHD, LHD, Wgate_t + (size_t)m * LHD * LHD, 0, r % DC_I_GT, scr, lane); continue; } r -= DC_N_GT;
        if (r < DC_I_IN) { tr_item(args.in[2] + (size_t)D * DIN, D, DIN, Win_t + (size_t)DIN * D, 3, r, scr, lane, args.in[1] + D); continue; } r -= DC_I_IN;
        if (r < 2 * DC_I_OUT) { const int l = r / DC_I_OUT; tr_item(args.in[14] + (size_t)l * D * D, D, D, Wout_t + (size_t)l * D * D, 0, r % DC_I_OUT, scr, lane); continue; } r -= 2 * DC_I_OUT;
        if (r < 2 * DC_I_GU) { const int w = r / DC_I_GU; tr_item(w == 0 ? args.in[16] : args.in[17], D, DFF, DWgu, 1 + w, r % DC_I_GU, scr, lane, args.in[15]); continue; } r -= 2 * DC_I_GU;
#if DENSE2_FP8
        tr_item8(args.in[18], DFF, D, (unsigned char*)DWd, 0, r, scr, lane, MOE_SC_D);
#else
        tr_item(args.in[18], DFF, D, DWd, 0, r, scr, lane);
#endif
    }
}


#define IN(k) (lo <= (k) && (k) < hi)
#define REPS(k) for (int rep_ = 0; rep_ < (((k) == PROBE_PHASE) ? PROBE_N : 1); ++rep_)
#define SEAM(k) do { if (IN(k) && IN((k) + 1)) xcd_barrier(bar); } while (0)
struct Ctx { LAS unsigned char* lds; unsigned char* ws; gu32* ctl; int tid, lane, wave, G, bx, gw, NGW, gtid, NGT, lo, hi, vbx; };
template <int L> __device__ __forceinline__ void layer_phases(const Args& args, const Ctx& C, const XcdBarrier& bar) {
    LAS unsigned char* lds = C.lds; unsigned char* ws = C.ws; gu32* ctl = C.ctl;
    const int tid = C.tid, lane = C.lane, wave = C.wave, G = C.G, bx = C.bx, gw = C.gw, NGW = C.NGW, gtid = C.gtid, NGT = C.NGT, lo = C.lo, hi = C.hi, vbx = C.vbx;
    const float* x_in = args.in[0];
    bf16* Win_t = (bf16*)(ws + WS_WIN); bf16* Wout_t = (bf16*)(ws + WS_WOUT); bf16* Wgate_t = (bf16*)(ws + WS_WGATE);
    bf16* DWgu = (bf16*)(ws + WS_DWGU); bf16* DWd = (bf16*)(ws + WS_DWD); bf16* MWgu = (bf16*)(ws + WS_MWGU); bf16* MWd = (bf16*)(ws + WS_MWD);
    float* X = (float*)(ws + WS_X); bf16* H = (bf16*)(ws + WS_H); bf16* U = (bf16*)(ws + WS_U); bf16* Y = (bf16*)(ws + WS_Y);
    bf16* HID = (bf16*)(ws + WS_HID); bf16* XG8 = (bf16*)(ws + WS_XG8); bf16* YB = (bf16*)(ws + WS_YB);
    int* ROUTE = (int*)(ws + WS_ROUTE); int* POS = (int*)(ws + WS_POS);

    {
        constexpr int l = L, pb = 1 + 6 * L;
        if (IN(pb)) REPS(pb) {
            pg8::Gemm g{H, Win_t + (size_t)l * DIN * D, T, DIN, D}; pg8::StaticOrder S; S.init(T, DIN, G, vbx);
            pg8::EpiInProj E{U, UW, (const float*)(ws + WS_SSQB)};
            if constexpr (L == 0) {
                const int rounds = (S.nwg + G - 1) / G, grp = (vbx * 4) / G, cut = (rounds * grp) / 4;
                S.i0 = 0; S.i1 = cut;
                pg8::gemm_phase<pg8::EpiInProj, pg8::StaticOrder, true, true>(lds + RING_OFF, g, S, E);
                dense_convert_items(args, ws, DC_N_EARLY, DC_N_ALL, lds, gw, NGW, wave, lane);
                __syncthreads();
                S.i0 = cut; S.i1 = 0x7fffffff;
            }
            pg8::gemm_phase<pg8::EpiInProj, pg8::StaticOrder, true, true>(lds + RING_OFF, g, S, E);
#if GEMM_PV >= 0
            if (L == 0) { __syncthreads(); pg8::gemm_phase<pg8::EpiInProj, pg8::StaticOrder, true, true, false, GEMM_PV>(lds + RING_OFF, g, S, E); }
#endif
        }
        SEAM(pb);
        if (IN(pb + 1)) { constexpr int TR = (PROBE_PHASE == pb + 1) ? PROBE_N : 1;
            const float* conv_w = args.in[3] + (size_t)l * CK * CW; const float* conv_b = args.in[4] + (size_t)l * CW;
            const float* lcw = args.in[7] + (size_t)l * LK * LW; const float* lcb = args.in[8] + (size_t)l * LW;
#if NAIVE_CONV || NAIVE_LRU
            float* NCONV = (float*)(ws + WS_NCONV); float* NRX = (float*)(ws + WS_NRX);
            for (int idx = gtid; idx < T * CW; idx += NGT) {
                const int t = idx >> 10, c = idx & 1023, tl = t & (SEQ - 1);
                float s = conv_b[c];
                for (int k = 0; k < CK; ++k) { const int tt = tl - (CK - 1) + k; if (tt >= 0) { const size_t ro = (size_t)(t - (CK - 1) + k) * DIN; const float v = bf2f(U[ro + c]), gt = bf2f(U[ro + CW + c]); s += conv_w[k * CW + c] * (v * sigmoidf_(gt)); } }
                NCONV[idx] = s;
                float r = lcb[c];
                for (int k = 0; k < LK; ++k) { const int tt = tl - (LK - 1) + k; if (tt >= 0) r += lcw[k * LW + c] * bf2f(U[(size_t)(t - (LK - 1) + k) * DIN + 2 * CW + c]); }
                NRX[idx] = r;
            }
#endif
#if !NAIVE_LRU
            for (int tile_ = bx; tile_ < (PROBE_SUB == 2 ? 1 : TR) * (T / 64); tile_ += G) { const int tile = tile_ % (T / 64);
                lru_unit(U, (bf16*)(ws + WS_P1), (bf16*)(ws + WS_P2), (float*)(ws + WS_HAGG), (float*)(ws + WS_CAGG), Wgate_t + (size_t)l * 2 * LH * LHD * LHD, lcw, lcb,
                         args.in[10] + (size_t)l * LW, args.in[12] + (size_t)l * LW, args.in[13] + (size_t)l * LW, tile, lds, tid, lane, wave); }
#endif
#if !NAIVE_CONV
            for (int tile_ = bx; tile_ < (PROBE_SUB == 1 ? 1 : TR) * (T / 64); tile_ += G) { const int tile = tile_ % (T / 64);
                conv_unit(U, Y, conv_w, conv_b, args.in[5] + (size_t)l * CW, args.in[6] + (size_t)l * CW, tile, lds, tid, lane, wave); }
#endif
        }
        SEAM(pb + 1);
        if (IN(pb + 2)) REPS(pb + 2) {
#if NAIVE_CONV
            { const float* lng = args.in[5] + (size_t)l * CW; const float* lnb = args.in[6] + (size_t)l * CW; const float* NCONV = (const float*)(ws + WS_NCONV);
            for (int m = gw; m < T; m += NGW) {
                float v[16]; float s = 0.f;
#pragma unroll
                for (int j = 0; j < 16; ++j) { v[j] = NCONV[(size_t)m * CW + lane + 64 * j]; s += v[j]; }
                const float mean = wave_sum(s) * (1.0f / CW); float q = 0.f;
#pragma unroll
                for (int j = 0; j < 16; ++j) { v[j] -= mean; q += v[j] * v[j]; }
                const float rstd = 1.0f / sqrtf(wave_sum(q) * (1.0f / CW) + EPS);
#pragma unroll
                for (int j = 0; j < 16; ++j) { const int c = lane + 64 * j; const float z = v[j] * rstd * lng[c] + lnb[c]; Y[(size_t)m * D + c] = (bf16)f2bf(z * sigmoidf_(z)); }
            } }
#endif
#if NAIVE_LRU
            { const float* NRX = (const float*)(ws + WS_NRX); float* NA = (float*)(ws + WS_NA); float* NB = (float*)(ws + WS_NB);
            const float* wa = args.in[9] + (size_t)l * LH * LHD * LHD; const float* wx = args.in[11] + (size_t)l * LH * LHD * LHD;
            const float* ba = args.in[10] + (size_t)l * LW; const float* bxx = args.in[12] + (size_t)l * LW; const float* lam = args.in[13] + (size_t)l * LW;
            for (int idx = gtid; idx < T * LW; idx += NGT) {
                const int t = idx >> 10, c = idx & 1023, h = c >> 7, j = c & 127, tl = t & (SEQ - 1);
                float da = ba[c], dx = bxx[c];
                const float* rxr = NRX + (size_t)t * LW + h * LHD; const float* war = wa + (size_t)h * LHD * LHD + j; const float* wxr = wx + (size_t)h * LHD * LHD + j;
                for (int i = 0; i < LHD; ++i) { const float r = rxr[i]; da += r * war[i * LHD]; dx += r * wxr[i * LHD]; }
                const float ga = sigmoidf_(da), gx = sigmoidf_(dx);
                const float nl = -lam[c]; const float sp = (nl > 20.f) ? nl : log1pf(expf(nl));
                const float la = -LRU_C * ga * sp; const float a = expf(la);
                float mult = sqrtf(fmaxf(-expm1f(2.0f * la), 0.f)); if (tl == 0) mult = 1.0f;
                NA[idx] = a; NB[idx] = mult * gx * NRX[idx];
            }
            xcd_barrier(bar);
            if (gtid < BATCH * LW) { const int b = gtid >> 10, c = gtid & 1023; float h = 0.f;
                for (int t = 0; t < SEQ; ++t) { const size_t row = (size_t)b * SEQ + t; h = NA[row * LW + c] * h + NB[row * LW + c];
                    Y[row * D + CW + c] = (bf16)f2bf(h * gelu_tanh(bf2f(U[row * DIN + 3 * CW + c]))); } } }
#else
            for (int tile = bx; tile < T / 64; tile += G)
                lru_fix_unit((const bf16*)(ws + WS_P1), (const bf16*)(ws + WS_P2), (const float*)(ws + WS_HAGG), (const float*)(ws + WS_CAGG), Y, tile, lds, tid);
#endif
        }
        SEAM(pb + 2);
        if (IN(pb + 3)) REPS(pb + 3) {
            pg8::Gemm g{Y, Wout_t + (size_t)l * D * D, T, D, D}; pg8::StaticOrder S; S.init(T, D, G, vbx);
            if constexpr (L == 0) { pg8::EpiResNormT<true> E{H, H, (float*)(ws + WS_SSQA), D, 1.0f, (LAS float*)(lds + RING_BYTES)};
                pg8::gemm_phase<pg8::EpiResNormT<true>, pg8::StaticOrder, true, true>(lds + RING_OFF, g, S, E); }
            else { pg8::EpiResB16 E{H, D};
                pg8::gemm_phase<pg8::EpiResB16, pg8::StaticOrder, true, true>(lds + RING_OFF, g, S, E); }
        }
        SEAM(pb + 3);
        if constexpr (L == 0) {
            if (IN(5)) {
                pg8::Gemm g{H, DWgu, T, 2 * DFF, D}; pg8::StaticOrder S; S.init(T, 2 * DFF, G, vbx);
                typedef pg8::EpiSwiGlu8 EpiD1; EpiD1 E{(unsigned char*)HID, DFF, 1.0f, (const float*)(ws + WS_SSQA)};
                const int rounds = (S.nwg + G - 1) / G, grp = (vbx * 8) / G, cut = (rounds * grp) / 8;
                S.i0 = 0; S.i1 = cut;
                pg8::gemm_phase<EpiD1, pg8::StaticOrder, true, true>(lds + RING_OFF, g, S, E);
                moe_convert_share(args.in[20], args.in[21], args.in[22], (unsigned char*)MWgu, (unsigned char*)MWd, lds, gw, NGW, wave, lane);
                __syncthreads();
                S.i0 = cut; S.i1 = 0x7fffffff;
                pg8::gemm_phase<EpiD1, pg8::StaticOrder, true, true>(lds + RING_OFF, g, S, E);
            }
            SEAM(5);
            if (IN(6)) {
                pg8::Gemm g{HID, DWd, T, D, DFF / 2}; pg8::StaticOrder S; S.init(T, D, G, vbx);
                pg8::EpiResNormT<true> E{H, H, (float*)(ws + WS_SSQB), D, 1.0f / MOE_SC_D, (LAS float*)(lds + RING_BYTES)};
                pg8::gemm_phase<pg8::EpiResNormT<true>, pg8::StaticOrder, true, true, true>(lds + RING_OFF, g, S, E);
            }
            SEAM(6);
        } else {
            if (IN(11)) {
                LAS f32x4* wl = (LAS f32x4*)lds;
                LAS unsigned* rows8 = (LAS unsigned*)(lds + 65536);
                LAS unsigned* meta = (LAS unsigned*)(lds + 131072);
                LAS unsigned* lc = meta + 128;
                LAS unsigned* lbase = meta + 136;
                const float* wrt = args.in[19]; const float* gain = args.in[15] + D;
                for (int q = tid; q < D * NE / 4; q += NTHR) { const f32x4 w = ((const GAS f32x4*)wrt)[q]; const int k = q >> 1, half = q & 1, i = k & 3, ln = (k >> 2) & 63, j = k >> 8; wl[((j * 4 + i) * 2 + half) * 64 + ln] = w; }
                __syncthreads();
                for (int sub = bx; sub < T / 32; sub += G) {
                    if (tid < NE) lc[tid] = 0u;
                    __syncthreads();
#pragma unroll 1
                    for (int rr = 0; rr < 4; ++rr) { const int row = 4 * wave + rr, m = sub * 32 + row;
                        const GAS v2u* xr = (const GAS v2u*)(H + (size_t)m * D) + lane; const GAS f32x4* gr = (const GAS f32x4*)gain + lane;
                        f32x4 v[8]; float ss = 0.f;
#pragma unroll
                        for (int j = 0; j < 8; ++j) { const v2u a = xr[64 * j]; v[j] = (f32x4){bf_lo(a.x), bf_hi(a.x), bf_lo(a.y), bf_hi(a.y)}; ss += (v[j].x * v[j].x + v[j].y * v[j].y) + (v[j].z * v[j].z + v[j].w * v[j].w); }
                        const float rstd = 1.0f / sqrtf(wave_sum(ss) * (1.0f / D) + EPS);
                        f32x4 l0 = (f32x4){0.f, 0.f, 0.f, 0.f}, l1 = l0;
                        v16f hx, hy;
#pragma unroll
                        for (int j = 0; j < 8; ++j) { const f32x4 g = gr[64 * j]; const f32x4 hv = v[j] * rstd * g;
#pragma unroll
                            for (int i = 0; i < 4; ++i) { if (j < 4) hx[4 * j + i] = hv[i] * MOE_SC_A; else hy[4 * (j - 4) + i] = hv[i] * MOE_SC_A;
                                l0 += hv[i] * wl[((j * 4 + i) * 2 + 0) * 64 + lane]; l1 += hv[i] * wl[((j * 4 + i) * 2 + 1) * 64 + lane]; } }
                        { v6u d; asm volatile("v_cvt_scalef32_2xpk16_fp6_f32 %0, %1, %2, 1.0" : "=&v"(d) : "v"(hx), "v"(hy));
                          LAS unsigned* p1 = rows8 + row * 512 + (lane >> 2) * 32 + 4 * (lane & 3); p1[0] = d[0]; p1[1] = d[1]; p1[2] = d[2]; p1[3] = d[3]; p1[16] = d[4]; p1[17] = d[5]; }
                        float p4[4], p2[2], p1;
                        { const bool up = (lane & 32) != 0; float a0[4] = {l0.x, l0.y, l0.z, l0.w}, a1[4] = {l1.x, l1.y, l1.z, l1.w};
#pragma unroll
                          for (int i = 0; i < 4; ++i) { float x = a0[i], y = a1[i]; asm volatile("" : "+v"(x), "+v"(y)); p4[i] = (up ? y : x) + __shfl_xor(up ? x : y, 32); } }
                        { const bool up = (lane & 16) != 0;
#pragma unroll
                          for (int i = 0; i < 2; ++i) { float x = p4[i], y = p4[i + 2]; asm volatile("" : "+v"(x), "+v"(y)); p2[i] = (up ? y : x) + __shfl_xor(up ? x : y, 16); } }
                        { const bool up = (lane & 8) != 0; float x = p2[0], y = p2[1]; asm volatile("" : "+v"(x), "+v"(y)); p1 = (up ? y : x) + __shfl_xor(up ? x : y, 8); }
                        p1 += __shfl_xor(p1, 4); p1 += __shfl_xor(p1, 2); p1 += __shfl_xor(p1, 1);
                        float lg[8];
#pragma unroll
                        for (int e = 0; e < 8; ++e) lg[e] = __int_as_float(__builtin_amdgcn_readlane(__float_as_int(p1), ((e & 4) ? 32 : 0) + ((e & 2) ? 16 : 0) + ((e & 1) ? 8 : 0)));
                        float m1 = lg[0]; int i1 = 0;
#pragma unroll
                        for (int e = 1; e < 8; ++e) if (lg[e] > m1) { m1 = lg[e]; i1 = e; }
                        float m2 = -3.0e38f; int i2 = 0;
#pragma unroll
                        for (int e = 0; e < 8; ++e) if (e != i1 && lg[e] > m2) { m2 = lg[e]; i2 = e; }
                        const float ex = expf(m2 - m1), w1 = 1.0f / (1.0f + ex), w2 = ex / (1.0f + ex);
                        if (lane == 0) { int4 r; r.x = i1; r.y = i2; r.z = __float_as_int(w1); r.w = __float_as_int(w2); ((int4*)ROUTE)[m] = r;
                            meta[row * 4 + 0] = (unsigned)i1; meta[row * 4 + 1] = (unsigned)i2;
                            meta[row * 4 + 2] = __hip_atomic_fetch_add(lc + i1, 1u, __ATOMIC_RELAXED, __HIP_MEMORY_SCOPE_WORKGROUP); meta[row * 4 + 3] = __hip_atomic_fetch_add(lc + i2, 1u, __ATOMIC_RELAXED, __HIP_MEMORY_SCOPE_WORKGROUP); }
                    }
                    __syncthreads();
                    if (tid < NE) lbase[tid] = __hip_atomic_fetch_add(ctl + CW_CNT + 64 * tid, lc[tid], RLX_AGENT);
                    __syncthreads();
#pragma unroll 1
                    for (int rr = 0; rr < 4; ++rr) { const int row = 4 * wave + rr, m = sub * 32 + row;
                        const unsigned e1 = meta[row * 4 + 0], e2 = meta[row * 4 + 1]; const unsigned s1 = lbase[e1] + meta[row * 4 + 2], s2 = lbase[e2] + meta[row * 4 + 3];
                        if (lane == 0) { POS[2 * m] = (int)s1; POS[2 * m + 1] = (int)s2; }
                        const LAS v4u* src = (const LAS v4u*)(rows8 + row * 512) + lane; const v4u q0 = src[0], q1 = src[64];
                        GAS v4u* d1 = (GAS v4u*)((unsigned char*)XG8 + ((size_t)e1 * T + s1) * (D + XPAD)) + lane; GAS v4u* d2 = (GAS v4u*)((unsigned char*)XG8 + ((size_t)e2 * T + s2) * (D + XPAD)) + lane;
                        d1[0] = q0; d1[64] = q1; d2[0] = q0; d2[64] = q1; }
                    __syncthreads();
                }
            }
            SEAM(11);
            if (IN(12) || IN(13)) {
                pg8::MoeOrder S; unsigned acc = 0;
#pragma unroll
                for (int e = 0; e < NE; ++e) { const unsigned c = (unsigned)__builtin_amdgcn_readfirstlane((int)__hip_atomic_load(ctl + CW_CNT + 64 * e, RLX_AGENT)); const unsigned nt = (c + 255u) >> 8; acc += nt; S.te[e] = (int)acc; if (e < 7) S.dg[e] = T / 256 - (int)nt; }
                const int ntiles = (int)acc;
                if (IN(12)) { S.rep = (PROBE_PHASE == 12) ? PROBE_N : 1;
                    S.nM = ntiles; S.nN = 2 * DFF / 256; S.nwg = S.nM * S.nN; S.G = G; S.c = vbx; S.estride = (size_t)2 * DFF * D;
                    pg8::Gemm g{XG8, MWgu, ntiles * 256, 2 * DFF, D / 2, (D + XPAD) / 2};
                    pg8::EpiSwiGlu8 E{(unsigned char*)HID, DFF, 1.0f / (MOE_SC_GU * MOE_SC_A), nullptr};
                    pg8::gemm_phase<pg8::EpiSwiGlu8, pg8::MoeOrder, true, true, true, 0, true>(lds + RING_OFF, g, S, E);
                }
                SEAM(12);
                if (IN(13)) { S.rep = (PROBE_PHASE == 13) ? PROBE_N : 1;
#pragma unroll
                    for (int k = 0; k < 7; ++k) S.dg[k] = 0;
                    S.nM = ntiles; S.nN = D / 256; S.nwg = S.nM * S.nN; S.G = G; S.c = vbx; S.estride = (size_t)D * DFF;
                    pg8::Gemm g{HID, MWd, ntiles * 256, D, DFF / 2};
                    pg8::EpiBf16S E{YB, D, 1.0f / MOE_SC_D};
                    pg8::gemm_phase<pg8::EpiBf16S, pg8::MoeOrder, true, true, true>(lds + RING_OFF, g, S, E);
                }
                SEAM(13);
            }
            if (IN(14)) REPS(14) {
                const float* fn = args.in[23];
                LAS unsigned* tst = (LAS unsigned*)(lds + RING_OFF);
                if (tid == 0) { unsigned acc = 0; for (int e = 0; e < NE; ++e) { tst[e] = acc << 8; acc += (__hip_atomic_load(ctl + CW_CNT + 64 * e, RLX_AGENT) + 255u) >> 8; } }
                __syncthreads();
                const GAS f32x4* gr = (const GAS f32x4*)fn + lane;
                int m = gw; int4 r = (int4){0, 0, 0, 0}; int q1 = 0, q2 = 0;
                v2u xa[8], ya[8], yb[8];
                if (m < T) { r = ((const int4*)ROUTE)[m]; q1 = POS[2 * m]; q2 = POS[2 * m + 1];
                    const int p1 = (int)tst[r.x] + q1, p2 = (int)tst[r.y] + q2;
                    const GAS v2u* xr = (const GAS v2u*)(H + (size_t)m * D) + lane; const GAS v2u* y1 = (const GAS v2u*)(YB + (size_t)p1 * D) + lane; const GAS v2u* y2 = (const GAS v2u*)(YB + (size_t)p2 * D) + lane;
#pragma unroll
                    for (int j = 0; j < 8; ++j) { xa[j] = xr[64 * j]; ya[j] = y1[64 * j]; yb[j] = y2[64 * j]; } }
                int4 rn = (int4){0, 0, 0, 0}; int qn1 = 0, qn2 = 0;
                { const int mn = m + NGW; if (mn < T) { rn = ((const int4*)ROUTE)[mn]; qn1 = POS[2 * mn]; qn2 = POS[2 * mn + 1]; } }
#pragma unroll 1
                for (; m < T; m += NGW) {
                    const float w1 = __int_as_float(r.z), w2 = __int_as_float(r.w);
                    const int mn = m + NGW, mnn = mn + NGW;
                    v2u xb_[8], yc[8], yd[8];
                    if (mn < T) { const int p1 = (int)tst[rn.x] + qn1, p2 = (int)tst[rn.y] + qn2;
                        const GAS v2u* xr = (const GAS v2u*)(H + (size_t)mn * D) + lane; const GAS v2u* y1 = (const GAS v2u*)(YB + (size_t)p1 * D) + lane; const GAS v2u* y2 = (const GAS v2u*)(YB + (size_t)p2 * D) + lane;
#pragma unroll
                        for (int j = 0; j < 8; ++j) { xb_[j] = xr[64 * j]; yc[j] = y1[64 * j]; yd[j] = y2[64 * j]; } }
                    else {
#pragma unroll
                        for (int j = 0; j < 8; ++j) { xb_[j] = (v2u){0u, 0u}; yc[j] = xb_[j]; yd[j] = xb_[j]; } }
                    int4 rnn = (int4){0, 0, 0, 0}; int qa = 0, qb = 0;
                    if (mnn < T) { rnn = ((const int4*)ROUTE)[mnn]; qa = POS[2 * mnn]; qb = POS[2 * mnn + 1]; }
                    f32x4 v[8]; float s = 0.f;
#pragma unroll
                    for (int j = 0; j < 8; ++j) { const v2u x3 = xa[j], a = ya[j], b = yb[j]; v[j] = (f32x4){bf_lo(x3.x), bf_hi(x3.x), bf_lo(x3.y), bf_hi(x3.y)};
                        v[j].x += w1 * bf_lo(a.x) + w2 * bf_lo(b.x); v[j].y += w1 * bf_hi(a.x) + w2 * bf_hi(b.x); v[j].z += w1 * bf_lo(a.y) + w2 * bf_lo(b.y); v[j].w += w1 * bf_hi(a.y) + w2 * bf_hi(b.y);
                        s += (v[j].x * v[j].x + v[j].y * v[j].y) + (v[j].z * v[j].z + v[j].w * v[j].w); }
                    const float rstd = 1.0f / sqrtf(wave_sum(s) * (1.0f / D) + EPS);
                    GAS f32x4* o = (GAS f32x4*)(args.out + (size_t)m * D) + lane;
#pragma unroll
                    for (int j = 0; j < 8; ++j) o[64 * j] = v[j] * rstd * gr[64 * j];
#pragma unroll
                    for (int j = 0; j < 8; ++j) { xa[j] = xb_[j]; ya[j] = yc[j]; yb[j] = yd[j]; }
                    r = rn; rn = rnn; qn1 = qa; qn2 = qb;
                }
            }
        }
    }
}

__global__ void __launch_bounds__(NTHR, 2) trunk_fwd(Args args) {
    extern __shared__ __attribute__((aligned(16))) unsigned char lds_raw[];
    LAS unsigned char* lds = (LAS unsigned char*)lds_raw;
    volatile LAS unsigned* MISC = (volatile LAS unsigned*)(lds + MISC_OFF);
    const int tid = threadIdx.x, lane = tid & 63, wave = __builtin_amdgcn_readfirstlane(tid >> 6);
    const int G = gridDim.x, bx = blockIdx.x;
    const int gw = bx * NWAVES + wave, NGW = G * NWAVES;
    const int gtid = bx * NTHR + tid, NGT = G * NTHR;
    unsigned char* ws = args.ws;
    gu32* ctl = (gu32*)(ws + WS_CTL);
    for (int u = tid; u < (LDS_BYTES - LDSCTL_OFF) / 4; u += NTHR) ((LAS unsigned*)(lds + LDSCTL_OFF))[u] = 0u;
    __syncthreads();
    XcdBarrier bar; bar.bar = (unsigned*)(ctl + CW_BAR); bar.x = 0; bar.st = nullptr;
    if (!MK_PER_PHASE) bar = xcd_barrier_post((unsigned*)(ctl + CW_BAR), MISC + 8);
    const int lo = args.ph_lo, hi = args.ph_hi;
    if (tid == 0) { const unsigned xcc = xb_xcc_id() & 7u; const unsigned r = __hip_atomic_fetch_add(ctl + CW_XRANK + 64 * xcc, 1u, RLX_AGENT); MISC[12] = xcc + 8u * r; }

    const float* x_in = args.in[0];
    bf16* Win_t = (bf16*)(ws + WS_WIN); bf16* Wout_t = (bf16*)(ws + WS_WOUT); bf16* Wgate_t = (bf16*)(ws + WS_WGATE);
    bf16* DWgu = (bf16*)(ws + WS_DWGU); bf16* DWd = (bf16*)(ws + WS_DWD); bf16* MWgu = (bf16*)(ws + WS_MWGU); bf16* MWd = (bf16*)(ws + WS_MWD);
    float* X = (float*)(ws + WS_X); bf16* H = (bf16*)(ws + WS_H); bf16* U = (bf16*)(ws + WS_U); bf16* Y = (bf16*)(ws + WS_Y);
    bf16* HID = (bf16*)(ws + WS_HID); bf16* XG8 = (bf16*)(ws + WS_XG8); bf16* YB = (bf16*)(ws + WS_YB);
    int* ROUTE = (int*)(ws + WS_ROUTE); int* POS = (int*)(ws + WS_POS);

    if (IN(0)) REPS(0) {
        dense_convert_items(args, ws, 0, DC_N_EARLY, lds, gw, NGW, wave, lane);
        for (int m = gw; m < T; m += NGW) row_to_bf16_ssq(x_in + (size_t)m * D, H + (size_t)m * D, (float*)(ws + WS_SSQB) + (size_t)m * 8, lane);
    }
    SEAM(0);

    int vbx = bx;
    if (G == 256 && lo == 0 && hi > 1) {
        bool ok = true;
#pragma unroll
        for (int x = 0; x < 8; ++x) ok = ok && (__builtin_amdgcn_readfirstlane((int)__hip_atomic_load(ctl + CW_XRANK + 64 * x, RLX_AGENT)) == 32);
        const int v = __builtin_amdgcn_readfirstlane((int)MISC[12]);
        if (ok && v >= 0 && v < G) vbx = v;
    }
    Ctx C; C.vbx = vbx; C.lds = lds; C.ws = ws; C.ctl = ctl; C.tid = tid; C.lane = lane; C.wave = wave; C.G = G; C.bx = bx; C.gw = gw; C.NGW = NGW; C.gtid = gtid; C.NGT = NGT; C.lo = lo; C.hi = hi;
    layer_phases<0>(args, C, bar);
    layer_phases<1>(args, C, bar);
#undef IN
#undef SEAM
}

extern "C" void kernel_launch(void* const* d_in, const int* in_sizes, int n_in, void* d_out, int out_size, void* d_ws, size_t ws_size, hipStream_t stream) {
    static int grid = 0;
    if (grid == 0) {
        if (n_in != 24 || in_sizes[0] != T * D || out_size != T * D || ws_size < WS_END) { fprintf(stderr, "kernel_launch: unexpected shapes (n_in %d, in0 %d, out %d, ws %zu < %zu?); nothing launched\n", n_in, n_in > 0 ? in_sizes[0] : -1, out_size, ws_size, (size_t)WS_END); grid = -1; return; }
        int dev = 0, cus = 0, per_cu = 0;
        if (hipGetDevice(&dev) != hipSuccess || hipDeviceGetAttribute(&cus, hipDeviceAttributeMultiprocessorCount, dev) != hipSuccess) { grid = -1; return; }
        if (hipFuncSetAttribute((const void*)trunk_fwd, hipFuncAttributeMaxDynamicSharedMemorySize, LDS_BYTES) != hipSuccess) { fprintf(stderr, "kernel_launch: hipFuncSetAttribute failed\n"); grid = -1; return; }
        if (hipOccupancyMaxActiveBlocksPerMultiprocessor(&per_cu, (const void*)trunk_fwd, NTHR, LDS_BYTES) != hipSuccess || per_cu < 1) fprintf(stderr, "kernel_launch: occupancy query reports %d blocks per CU\n", per_cu);
        (void)hipGetLastError();
        grid = cus;
    }
    if (grid < 0) return;
    if (hipMemsetAsync((char*)d_ws + WS_CTL, 0, CTL_ZERO_BYTES, stream) != hipSuccess) return;
    Args a{};
    for (int i = 0; i < 24; ++i) a.in[i] = (const float*)d_in[i];
    a.out = (float*)d_out; a.ws = (unsigned char*)d_ws;
#if MK_PER_PHASE
    for (int p = 0; p < N_PHASES; ++p) { a.ph_lo = p; a.ph_hi = p + 1; hipLaunchKernelGGL(trunk_fwd, dim3(grid), dim3(NTHR), LDS_BYTES, stream, a); }
#else
    a.ph_lo = 0; a.ph_hi = N_PHASES;
    hipLaunchKernelGGL(trunk_fwd, dim3(grid), dim3(NTHR), LDS_BYTES, stream, a);
#endif
}
```

```cpp
#include <hip/hip_runtime.h>
#include <cstdio>
#include <cstdint>

#define NAIVE_CONV 0
#define NAIVE_LRU 0
#ifndef DENSE2_FP8
#define DENSE2_FP8 1
#endif
#ifndef GEMM_PV
#define GEMM_PV -1
#endif
#ifndef XPAD
#define XPAD 128
#endif
#ifndef PROBE_PHASE
#define PROBE_PHASE -1
#endif
#ifndef PROBE_N
#define PROBE_N 2
#endif
#ifndef PROBE_SUB
#define PROBE_SUB 0
#endif
#ifndef PROBE_SKIP_EPI
#define PROBE_SKIP_EPI 0
#endif
#ifndef MK_PER_PHASE
#define MK_PER_PHASE 0
#endif

namespace pg8 {
#define PG8_LAS __attribute__((address_space(3)))
typedef unsigned short bf16_t;
typedef short bf16x8 __attribute__((ext_vector_type(8)));
typedef float f32x4 __attribute__((ext_vector_type(4)));
typedef unsigned u32x4 __attribute__((ext_vector_type(4)));
typedef int v4i __attribute__((ext_vector_type(4)));
typedef int v8i __attribute__((ext_vector_type(8)));
typedef int v6i __attribute__((ext_vector_type(6)));
typedef int v2i __attribute__((ext_vector_type(2)));
typedef unsigned u32x2 __attribute__((ext_vector_type(2)));
constexpr int BM = 256, BK = 64, HALF = 128, HTB = HALF * BK * 2  , STAGE_BYTES = 8 * HTB, NXCD = 8, WGM = 6;

__host__ __device__ __forceinline__ int lds_byte(int r, int c) { const int st = (r >> 4) * 2 + (c >> 5), rr = r & 15, cc = c & 31, ob = rr * 64 + cc * 2; return st * 1024 + (ob ^ (((ob >> 9) & 1) << 5)); }
__host__ __device__ __forceinline__ void stage_rc(int b, int& R, int& C) { const int st = b / 1024, sb = b % 1024, swz = sb ^ (((sb >> 9) & 1) << 5); R = (st >> 1) * 16 + swz / 64; C = (st & 1) * 32 + (swz % 64) / 2; }
__host__ __device__ __forceinline__ int perm32(int rho) { const int n = rho >> 4, i = rho & 15; return 8 * (i >> 2) + 4 * n + (i & 3); }

struct Unit { int pm, pn; bool skip_epi; };
struct Gemm { const bf16_t* A; const bf16_t* Bt; int M, N, K; int lda = 0; };

struct StaticOrder {
    int nM, nN, nwg, G, c, rep = 1;
    int i0 = 0, i1 = 0x7fffffff;
    __host__ __device__ void init(int M, int N, int G_, int c_) { nM = M / BM; nN = N / BM; nwg = nM * nN; G = G_; c = c_; }
    __host__ __device__ bool next(int i, Unit& u) const {
        i += i0; if (i >= i1) return false;
        long L = (long)i * G + c; if (L >= (long)nwg * rep) return false;
        u.skip_epi = false;
        if (rep > 1) { u.skip_epi = PROBE_SKIP_EPI && (L >= nwg); L %= nwg; }
        int wgid = (int)L; { const int q = nwg / NXCD, r = nwg % NXCD, xcd = wgid % NXCD, off = wgid / NXCD; wgid = (xcd < r ? xcd * (q + 1) : r * (q + 1) + (xcd - r) * q) + off; }
        const int nig = WGM * nN, gid = wgid / nig, fm = gid * WGM, gsz = (nM - fm) < WGM ? (nM - fm) : WGM;
        u.pm = fm + ((wgid % nig) % gsz); u.pn = (wgid % nig) / gsz; return true;
    }
    __device__ __forceinline__ size_t b_off(const Unit&) const { return 0; }
    __device__ __forceinline__ int a_tile(const Unit& u) const { return u.pm; }
    __device__ __forceinline__ void a_ready(const Unit&) const {}
    __device__ __forceinline__ void done(const Unit&) const {}
};
struct MoeOrder : StaticOrder {
    int te[8]; int dg[7]; size_t estride;
    __device__ __forceinline__ size_t b_off(const Unit& u) const { int e = 0;
#pragma unroll
        for (int k = 0; k < 7; ++k) e += (u.pm >= te[k]) ? 1 : 0;
        return (size_t)e * estride; }
    __device__ __forceinline__ int a_tile(const Unit& u) const { int t = u.pm;
#pragma unroll
        for (int k = 0; k < 7; ++k) t += (u.pm >= te[k]) ? dg[k] : 0;
        return t; }
};

__device__ __forceinline__ unsigned cvt_pk_bf16(float lo, float hi) { unsigned r; asm volatile("v_cvt_pk_bf16_f32 %0, %1, %2" : "=v"(r) : "v"(lo), "v"(hi)); return r; }

constexpr float NORM_EPS = 1e-6f, NORM_INV_D = 1.0f / 2048.0f;
struct EpiBf16 {
    static constexpr bool PERM = true, AFTER_DRAIN = false;
    bf16_t* O; int ldc; const float* ssq;
    __device__ __forceinline__ void operator()(const f32x4 (&acc)[2][2][4][2], const Unit& u, int wr, int wc, int fr, int fq) const {
        const int row0 = u.pm * BM + wr * 64 + fr, col0 = u.pn * BM + wc * 32 + 8 * fq;
#pragma unroll
        for (int ai = 0; ai < 2; ++ai)
#pragma unroll
            for (int m = 0; m < 4; ++m) { bf16_t* rowp = O + (size_t)(row0 + ai * HALF + m * 16) * ldc + col0;
                float rs = 1.0f; if (ssq) { const f32x4* p = (const f32x4*)(ssq + (size_t)(row0 + ai * HALF + m * 16) * 8); const f32x4 a = p[0], b = p[1]; rs = __builtin_amdgcn_rsqf((((a[0] + a[1]) + (a[2] + a[3])) + ((b[0] + b[1]) + (b[2] + b[3]))) * NORM_INV_D + NORM_EPS); }
#pragma unroll
                for (int bj = 0; bj < 2; ++bj) { const f32x4 v0 = acc[ai][bj][m][0] * rs, v1 = acc[ai][bj][m][1] * rs;
                    u32x4 w; w.x = cvt_pk_bf16(v0[0], v0[1]); w.y = cvt_pk_bf16(v0[2], v0[3]); w.z = cvt_pk_bf16(v1[0], v1[1]); w.w = cvt_pk_bf16(v1[2], v1[3]);
                    *(u32x4*)(rowp + bj * HALF) = w; } }
    }
};
struct EpiInProj {
    static constexpr bool PERM = true, AFTER_DRAIN = false;
    bf16_t* O; int ldc; const float* ssq;
    __device__ __forceinline__ void operator()(const f32x4 (&acc)[2][2][4][2], const Unit& u, int wr, int wc, int fr, int fq) const {
        const int row0 = u.pm * BM + wr * 64 + fr;
        const bool glu = u.pn < 8;
        const int col0 = glu ? (u.pn * HALF + wc * 32 + 8 * fq) : (1024 + (u.pn - 8) * BM + wc * 32 + 8 * fq);
#pragma unroll
        for (int ai = 0; ai < 2; ++ai)
#pragma unroll
            for (int m = 0; m < 4; ++m) { bf16_t* rowp = O + (size_t)(row0 + ai * HALF + m * 16) * ldc + col0;
                float rs = 1.0f; if (ssq) { const f32x4* p = (const f32x4*)(ssq + (size_t)(row0 + ai * HALF + m * 16) * 8); const f32x4 a = p[0], b = p[1]; rs = __builtin_amdgcn_rsqf((((a[0] + a[1]) + (a[2] + a[3])) + ((b[0] + b[1]) + (b[2] + b[3]))) * NORM_INV_D + NORM_EPS); }
                if (glu) { float h[8];
#pragma unroll
                    for (int n = 0; n < 2; ++n)
#pragma unroll
                        for (int j = 0; j < 4; ++j) { const float v = acc[ai][0][m][n][j] * rs, g = acc[ai][1][m][n][j] * rs;
                            h[4 * n + j] = v * __builtin_amdgcn_rcpf(1.0f + __builtin_amdgcn_exp2f(-1.44269504089f * g)); }
                    u32x4 w; w.x = cvt_pk_bf16(h[0], h[1]); w.y = cvt_pk_bf16(h[2], h[3]); w.z = cvt_pk_bf16(h[4], h[5]); w.w = cvt_pk_bf16(h[6], h[7]);
                    *(u32x4*)rowp = w;
                } else {
#pragma unroll
                    for (int bj = 0; bj < 2; ++bj) { const f32x4 v0 = acc[ai][bj][m][0] * rs, v1 = acc[ai][bj][m][1] * rs;
                        u32x4 w; w.x = cvt_pk_bf16(v0[0], v0[1]); w.y = cvt_pk_bf16(v0[2], v0[3]); w.z = cvt_pk_bf16(v1[0], v1[1]); w.w = cvt_pk_bf16(v1[2], v1[3]);
                        *(u32x4*)(rowp + bj * HALF) = w; } } }
    }
};
struct EpiSwiGlu {
    static constexpr bool PERM = true, AFTER_DRAIN = false;
    bf16_t* O; int ldc;
    __device__ __forceinline__ void operator()(const f32x4 (&acc)[2][2][4][2], const Unit& u, int wr, int wc, int fr, int fq) const {
        const int row0 = u.pm * BM + wr * 64 + fr, col0 = u.pn * HALF + wc * 32 + 8 * fq;
#pragma unroll
        for (int ai = 0; ai < 2; ++ai)
#pragma unroll
            for (int m = 0; m < 4; ++m) { bf16_t* rowp = O + (size_t)(row0 + ai * HALF + m * 16) * ldc + col0;
                float h[8];
#pragma unroll
                for (int n = 0; n < 2; ++n)
#pragma unroll
                    for (int j = 0; j < 4; ++j) { const float g = acc[ai][0][m][n][j], v = acc[ai][1][m][n][j];
                        h[4 * n + j] = g * __builtin_amdgcn_rcpf(1.0f + __builtin_amdgcn_exp2f(-1.44269504089f * g)) * v; }
                u32x4 w; w.x = cvt_pk_bf16(h[0], h[1]); w.y = cvt_pk_bf16(h[2], h[3]); w.z = cvt_pk_bf16(h[4], h[5]); w.w = cvt_pk_bf16(h[6], h[7]);
                *(u32x4*)rowp = w; }
    }
};

__device__ __forceinline__ unsigned cvt4_fp8(float a, float b, float c, float d) { int w = 0; w = __builtin_amdgcn_cvt_pk_fp8_f32(a, b, w, false); w = __builtin_amdgcn_cvt_pk_fp8_f32(c, d, w, true); return (unsigned)w; }
struct EpiBf16S {
    static constexpr bool PERM = true, AFTER_DRAIN = false;
    bf16_t* O; int ldc; float sc;
    __device__ __forceinline__ void operator()(const f32x4 (&acc)[2][2][4][2], const Unit& u, int wr, int wc, int fr, int fq) const {
        const int row0 = u.pm * BM + wr * 64 + fr, col0 = u.pn * BM + wc * 32 + 8 * fq;
#pragma unroll
        for (int ai = 0; ai < 2; ++ai)
#pragma unroll
            for (int m = 0; m < 4; ++m) { bf16_t* rowp = O + (size_t)(row0 + ai * HALF + m * 16) * ldc + col0;
#pragma unroll
                for (int bj = 0; bj < 2; ++bj) { const f32x4 v0 = acc[ai][bj][m][0] * sc, v1 = acc[ai][bj][m][1] * sc;
                    u32x4 w; w.x = cvt_pk_bf16(v0[0], v0[1]); w.y = cvt_pk_bf16(v0[2], v0[3]); w.z = cvt_pk_bf16(v1[0], v1[1]); w.w = cvt_pk_bf16(v1[2], v1[3]);
                    *(u32x4*)(rowp + bj * HALF) = w; } }
    }
};
struct EpiSwiGlu8 {
    static constexpr bool PERM = true, AFTER_DRAIN = false;
    unsigned char* O; int ldc; float sc; const float* ssq;
    __device__ __forceinline__ void operator()(const f32x4 (&acc)[2][2][4][2], const Unit& u, int wr, int wc, int fr, int fq) const {
        const int row0 = u.pm * BM + wr * 64 + fr, col0 = u.pn * HALF + wc * 32 + 8 * fq;
#pragma unroll
        for (int ai = 0; ai < 2; ++ai)
#pragma unroll
            for (int m = 0; m < 4; ++m) { unsigned char* rowp = O + (size_t)(row0 + ai * HALF + m * 16) * ldc + col0;
                float rs = sc; if (ssq) { const f32x4* p = (const f32x4*)(ssq + (size_t)(row0 + ai * HALF + m * 16) * 8); const f32x4 a = p[0], b = p[1]; rs = sc * __builtin_amdgcn_rsqf((((a[0] + a[1]) + (a[2] + a[3])) + ((b[0] + b[1]) + (b[2] + b[3]))) * NORM_INV_D + NORM_EPS); }
                float h[8]; const float c1 = -1.44269504089f * rs, c2 = rs * rs;
#pragma unroll
                for (int n = 0; n < 2; ++n) { const f32x4 ag = acc[ai][0][m][n], av = acc[ai][1][m][n]; const f32x4 t = ag * c1; f32x4 e;
#pragma unroll
                    for (int j = 0; j < 4; ++j) e[j] = __builtin_amdgcn_exp2f(t[j]);
                    const f32x4 d = e + 1.0f; f32x4 r;
#pragma unroll
                    for (int j = 0; j < 4; ++j) r[j] = __builtin_amdgcn_rcpf(d[j]);
                    const f32x4 hq = (ag * av) * (r * c2);
#pragma unroll
                    for (int j = 0; j < 4; ++j) h[4 * n + j] = hq[j]; }
                u32x2 w; w.x = cvt4_fp8(h[0], h[1], h[2], h[3]); w.y = cvt4_fp8(h[4], h[5], h[6], h[7]);
                *(u32x2*)rowp = w; }
    }
};
struct EpiResF32 {
    static constexpr bool PERM = false, AFTER_DRAIN = false;
    const float* base; float* out; int ldc;
    __device__ __forceinline__ void operator()(const f32x4 (&acc)[2][2][4][2], const Unit& u, int wr, int wc, int fr, int fq) const {
        const int row0 = u.pm * BM + wr * 64 + fr, col0 = u.pn * BM + wc * 32 + 4 * fq;
#pragma unroll
        for (int ai = 0; ai < 2; ++ai)
#pragma unroll
            for (int m = 0; m < 4; ++m) { const size_t off = (size_t)(row0 + ai * HALF + m * 16) * ldc + col0;
#pragma unroll
                for (int bj = 0; bj < 2; ++bj)
#pragma unroll
                    for (int n = 0; n < 2; ++n) { const f32x4 bs = *(const f32x4*)(base + off + bj * HALF + n * 16); *(f32x4*)(out + off + bj * HALF + n * 16) = bs + acc[ai][bj][m][n]; }
                if (m == 3) asm volatile("" ::: "memory"); }
    }
};

struct EpiResNorm {
    static constexpr bool PERM = false, AFTER_DRAIN = false;
    const float* base; float* out; bf16_t* xb; float* ssq8; int ldc; float sc; PG8_LAS float* part;
    __device__ __forceinline__ void operator()(const f32x4 (&acc)[2][2][4][2], const Unit& u, int wr, int wc, int fr, int fq) const {
        const int row0 = u.pm * BM + wr * 64 + fr, col0 = u.pn * BM + wc * 32 + 4 * fq;
#pragma unroll
        for (int ai = 0; ai < 2; ++ai) {
            float q[4];
#pragma unroll
            for (int m = 0; m < 4; ++m) { const size_t off = (size_t)(row0 + ai * HALF + m * 16) * ldc + col0; q[m] = 0.f;
#pragma unroll
                for (int bj = 0; bj < 2; ++bj)
#pragma unroll
                    for (int n = 0; n < 2; ++n) { const f32x4 bs = *(const f32x4*)(base + off + bj * HALF + n * 16); const f32x4 v = bs + acc[ai][bj][m][n] * sc;
                        *(f32x4*)(out + off + bj * HALF + n * 16) = v; q[m] += (v[0] * v[0] + v[1] * v[1]) + (v[2] * v[2] + v[3] * v[3]);
                        u32x2 w; w.x = cvt_pk_bf16(v[0], v[1]); w.y = cvt_pk_bf16(v[2], v[3]); *(u32x2*)(xb + off + bj * HALF + n * 16) = w; } }
            asm volatile("" ::: "memory");
#pragma unroll
            for (int m = 0; m < 4; ++m) { float t = q[m]; t += __shfl_xor(t, 16); t += __shfl_xor(t, 32);
                if (fq == 0) part[(ai * HALF + wr * 64 + m * 16 + fr) * 4 + wc] = t; } }
        asm volatile("s_waitcnt lgkmcnt(0)" ::: "memory"); __builtin_amdgcn_s_barrier(); asm volatile("" ::: "memory");
        if (threadIdx.x < 256) { const PG8_LAS f32x4* p4 = (const PG8_LAS f32x4*)part + threadIdx.x; const f32x4 p = *p4;
            ssq8[(size_t)(u.pm * BM + threadIdx.x) * 8 + u.pn] = (p[0] + p[1]) + (p[2] + p[3]); }
    }
};
template <bool BASE_BF16> struct EpiResNormT {
    static constexpr bool PERM = false, AFTER_DRAIN = false;
    const void* base; bf16_t* xb; float* ssq8; int ldc; float sc; PG8_LAS float* part;
    __device__ __forceinline__ void operator()(const f32x4 (&acc)[2][2][4][2], const Unit& u, int wr, int wc, int fr, int fq) const {
        const int row0 = u.pm * BM + wr * 64 + fr, col0 = u.pn * BM + wc * 32 + 4 * fq;
        u32x2 bb[2][4][4];
        if constexpr (BASE_BF16) {
#pragma unroll
            for (int ai = 0; ai < 2; ++ai)
#pragma unroll
                for (int m = 0; m < 4; ++m)
#pragma unroll
                    for (int c = 0; c < 4; ++c) bb[ai][m][c] = *(const u32x2*)((const bf16_t*)base + (size_t)(row0 + ai * HALF + m * 16) * ldc + col0 + (c >> 1) * HALF + (c & 1) * 16);
            asm volatile("" ::: "memory"); }
#pragma unroll
        for (int ai = 0; ai < 2; ++ai) {
            float q[4];
#pragma unroll
            for (int m = 0; m < 4; ++m) { const size_t off = (size_t)(row0 + ai * HALF + m * 16) * ldc + col0; q[m] = 0.f;
#pragma unroll
                for (int bj = 0; bj < 2; ++bj)
#pragma unroll
                    for (int n = 0; n < 2; ++n) { f32x4 bs;
                        if constexpr (BASE_BF16) { const u32x2 b = bb[ai][m][bj * 2 + n];
                            bs[0] = __uint_as_float(b.x << 16); bs[1] = __uint_as_float(b.x & 0xffff0000u); bs[2] = __uint_as_float(b.y << 16); bs[3] = __uint_as_float(b.y & 0xffff0000u); }
                        else bs = *(const f32x4*)((const float*)base + off + bj * HALF + n * 16);
                        const f32x4 v = bs + acc[ai][bj][m][n] * sc;
                        u32x2 w; w.x = cvt_pk_bf16(v[0], v[1]); w.y = cvt_pk_bf16(v[2], v[3]); *(u32x2*)(xb + off + bj * HALF + n * 16) = w;
                        const float r0 = __uint_as_float(w.x << 16), r1 = __uint_as_float(w.x & 0xffff0000u), r2 = __uint_as_float(w.y << 16), r3 = __uint_as_float(w.y & 0xffff0000u);
                        q[m] += (r0 * r0 + r1 * r1) + (r2 * r2 + r3 * r3); } }
            asm volatile("" ::: "memory");
#pragma unroll
            for (int m = 0; m < 4; ++m) { float t = q[m]; t += __shfl_xor(t, 16); t += __shfl_xor(t, 32);
                if (fq == 0) part[(ai * HALF + wr * 64 + m * 16 + fr) * 4 + wc] = t; } }
        asm volatile("s_waitcnt lgkmcnt(0)" ::: "memory"); __builtin_amdgcn_s_barrier(); asm volatile("" ::: "memory");
        if (threadIdx.x < 256) { const PG8_LAS f32x4* p4 = (const PG8_LAS f32x4*)part + threadIdx.x; const f32x4 p = *p4;
            ssq8[(size_t)(u.pm * BM + threadIdx.x) * 8 + u.pn] = (p[0] + p[1]) + (p[2] + p[3]); }
    }
};
struct EpiResB16 {
    static constexpr bool PERM = false, AFTER_DRAIN = false;
    bf16_t* x; int ldc;
    __device__ __forceinline__ void operator()(const f32x4 (&acc)[2][2][4][2], const Unit& u, int wr, int wc, int fr, int fq) const {
        const int row0 = u.pm * BM + wr * 64 + fr, col0 = u.pn * BM + wc * 32 + 4 * fq;
        u32x2 bb[2][4][4];
#pragma unroll
        for (int ai = 0; ai < 2; ++ai)
#pragma unroll
            for (int m = 0; m < 4; ++m)
#pragma unroll
                for (int c = 0; c < 4; ++c) bb[ai][m][c] = *(const u32x2*)(x + (size_t)(row0 + ai * HALF + m * 16) * ldc + col0 + (c >> 1) * HALF + (c & 1) * 16);
        asm volatile("" ::: "memory");
#pragma unroll
        for (int ai = 0; ai < 2; ++ai)
#pragma unroll
            for (int m = 0; m < 4; ++m) { const size_t off = (size_t)(row0 + ai * HALF + m * 16) * ldc + col0;
#pragma unroll
                for (int bj = 0; bj < 2; ++bj)
#pragma unroll
                    for (int n = 0; n < 2; ++n) { u32x2* p = (u32x2*)(x + off + bj * HALF + n * 16); const u32x2 b = bb[ai][m][bj * 2 + n]; const f32x4 a = acc[ai][bj][m][n];
                        u32x2 w; w.x = cvt_pk_bf16(__uint_as_float(b.x << 16) + a[0], __uint_as_float(b.x & 0xffff0000u) + a[1]); w.y = cvt_pk_bf16(__uint_as_float(b.y << 16) + a[2], __uint_as_float(b.y & 0xffff0000u) + a[3]); *p = w; }
                if (m == 3) asm volatile("" ::: "memory"); }
    }
};
struct EpiResF32S {
    static constexpr bool PERM = false, AFTER_DRAIN = false;
    const float* base; float* out; int ldc; float sc;
    __device__ __forceinline__ void operator()(const f32x4 (&acc)[2][2][4][2], const Unit& u, int wr, int wc, int fr, int fq) const {
        const int row0 = u.pm * BM + wr * 64 + fr, col0 = u.pn * BM + wc * 32 + 4 * fq;
#pragma unroll
        for (int ai = 0; ai < 2; ++ai)
#pragma unroll
            for (int m = 0; m < 4; ++m) { const size_t off = (size_t)(row0 + ai * HALF + m * 16) * ldc + col0;
#pragma unroll
                for (int bj = 0; bj < 2; ++bj)
#pragma unroll
                    for (int n = 0; n < 2; ++n) { const f32x4 bs = *(const f32x4*)(base + off + bj * HALF + n * 16); *(f32x4*)(out + off + bj * HALF + n * 16) = bs + acc[ai][bj][m][n] * sc; }
                if (m == 3) asm volatile("" ::: "memory"); }
    }
};

template <class Epi, class Sched, bool ALIGN_EPI = false, bool SP2 = false, bool FP8 = false, int PV = 0, bool FP6 = false>
__device__ __forceinline__ void gemm_phase(PG8_LAS unsigned char* lds, const Gemm g, const Sched& S, const Epi& E) {
    const int tid = threadIdx.x, wid = __builtin_amdgcn_readfirstlane(tid >> 6), lane = tid & 63, wr = wid >> 2, wc = wid & 3, fr = lane & 15, fq = lane >> 4;
    const int K = g.K, nt = K / BK, LDA = g.lda ? g.lda : g.K;
    unsigned voffA[2], voffB[2];
#pragma unroll
    for (int i = 0; i < 2; ++i) { int R, C; stage_rc(tid * 16 + i * 8192, R, C); const int Rb = Epi::PERM ? ((R & ~31) + perm32(R & 31)) : R;
        voffA[i] = (unsigned)(R * LDA + C) * 2u; voffB[i] = (unsigned)(Rb * K + C) * 2u; }
    const size_t kstep = (size_t)(BK * 2);
    const size_t hstep = (size_t)HALF * K * 2;
    const size_t tstep = 2 * hstep;
    const size_t hstepA = (size_t)HALF * LDA * 2, tstepA = 2 * hstepA;
    const unsigned ldsw = (unsigned)wid * 1024u;
    const int aoff = lds_byte(wr * 64 + fr, fq * 8), boff = lds_byte(wc * 32 + fr, fq * 8);
    const unsigned abase6 = (unsigned)(unsigned long)(lds + aoff), bbase6 = (unsigned)(unsigned long)(lds + 4 * HTB + boff);
#define PG8_SA(b, h) (((b) * 2 + (h)) * HTB)
#define PG8_SB(b, h) ((4 + (b) * 2 + (h)) * HTB)
#define PG8_STAGE(bufoff, gbase, voff) do { if constexpr (PV != 2) _Pragma("unroll") for (int _i = 0; _i < 2; ++_i) \
        __builtin_amdgcn_global_load_lds((const unsigned*)((const char*)(gbase) + (voff)[_i]), (PG8_LAS unsigned*)(lds + (bufoff) + ldsw + _i * 8192), 16, 0, 0); } while (0)
#define PG8_LDA(dst, b, h) do { if constexpr (PV == 3) {} else if constexpr (FP6) { _Pragma("unroll") for (int m = 0; m < 4; ++m) { v4i lo_; v2i hi_; \
            asm volatile("ds_read_b128 %0, %2 offset:%3\n\tds_read_b64 %1, %2 offset:%4" : "=&v"(lo_), "=&v"(hi_) : "v"(abase6), "n"(PG8_SA(b, h) + m * 2048), "n"(PG8_SA(b, h) + m * 2048 + 1024)); \
            dst##6[m] = __builtin_shufflevector(lo_, __builtin_shufflevector(hi_, hi_, 0, 1, -1, -1), 0, 1, 2, 3, 4, 5); } } \
        else if constexpr (FP8) { _Pragma("unroll") for (int m = 0; m < 4; ++m) { dst##8[m].lo = *(const PG8_LAS v4i*)(lds + PG8_SA(b, h) + aoff + m * 2048); dst##8[m].hi = *(const PG8_LAS v4i*)(lds + PG8_SA(b, h) + aoff + m * 2048 + 1024); } } \
        else { _Pragma("unroll") for (int m = 0; m < 4; ++m) _Pragma("unroll") for (int k = 0; k < 2; ++k) dst[m][k] = *(const PG8_LAS bf16x8*)(lds + PG8_SA(b, h) + aoff + m * 2048 + k * 1024); } } while (0)
#define PG8_LDB(dst, b, h) do { if constexpr (PV == 3) {} else if constexpr (FP6) { _Pragma("unroll") for (int n = 0; n < 2; ++n) { v4i lo_; v2i hi_; \
            asm volatile("ds_read_b128 %0, %2 offset:%3\n\tds_read_b64 %1, %2 offset:%4" : "=&v"(lo_), "=&v"(hi_) : "v"(bbase6), "n"(PG8_SB(b, h) - 4 * HTB + n * 2048), "n"(PG8_SB(b, h) - 4 * HTB + n * 2048 + 1024)); \
            dst##6[n] = __builtin_shufflevector(lo_, __builtin_shufflevector(hi_, hi_, 0, 1, -1, -1), 0, 1, 2, 3, 4, 5); } } \
        else if constexpr (FP8) { _Pragma("unroll") for (int n = 0; n < 2; ++n) { dst##8[n].lo = *(const PG8_LAS v4i*)(lds + PG8_SB(b, h) + boff + n * 2048); dst##8[n].hi = *(const PG8_LAS v4i*)(lds + PG8_SB(b, h) + boff + n * 2048 + 1024); } } \
        else { _Pragma("unroll") for (int n = 0; n < 2; ++n) _Pragma("unroll") for (int k = 0; k < 2; ++k) dst[n][k] = *(const PG8_LAS bf16x8*)(lds + PG8_SB(b, h) + boff + n * 2048 + k * 1024); } } while (0)
#define PG8_MMA(ai, bj, At, Bt) do { __builtin_amdgcn_s_setprio(1); \
        if constexpr (PV == 1) { _Pragma("unroll") for (int m = 0; m < 4; ++m) _Pragma("unroll") for (int k = 0; k < 2; ++k) asm volatile("" :: "v"(At[m][k])); _Pragma("unroll") for (int n = 0; n < 2; ++n) _Pragma("unroll") for (int k = 0; k < 2; ++k) asm volatile("" :: "v"(Bt[n][k])); } \
        else if constexpr (FP6) { _Pragma("unroll") for (int m = 0; m < 4; ++m) _Pragma("unroll") for (int n = 0; n < 2; ++n) \
            asm volatile("v_mfma_scale_f32_16x16x128_f8f6f4 %0, %1, %2, %0, %3, %3 op_sel_hi:[0,0,0] cbsz:2 blgp:2" : "+v"(acc[ai][bj][m][n]) : "v"(Bt##6[n]), "v"(At##6[m]), "v"(sc1)); } \
        else if constexpr (FP8) { _Pragma("unroll") for (int m = 0; m < 4; ++m) _Pragma("unroll") for (int n = 0; n < 2; ++n) \
            asm volatile("v_mfma_scale_f32_16x16x128_f8f6f4 %0, %1, %2, %0, %3, %3 op_sel_hi:[0,0,0]" : "+v"(acc[ai][bj][m][n]) : "v"(Bt##8[n]), "v"(At##8[m]), "v"(sc1)); } \
        else { _Pragma("unroll") for (int m = 0; m < 4; ++m) _Pragma("unroll") for (int n = 0; n < 2; ++n) _Pragma("unroll") for (int k = 0; k < 2; ++k) \
            acc[ai][bj][m][n] = __builtin_amdgcn_mfma_f32_16x16x32_bf16(Bt[n][k], At[m][k], acc[ai][bj][m][n], 0, 0, 0); } \
        __builtin_amdgcn_s_setprio(0); } while (0)
#define PG8_WAIT_V(n) asm volatile("s_waitcnt vmcnt(" #n ")" ::: "memory")
#define PG8_WAIT_L(n) asm volatile("s_waitcnt lgkmcnt(" #n ")" ::: "memory")
#define PG8_BAR __builtin_amdgcn_s_barrier()
#define PG8_SCHED __builtin_amdgcn_sched_barrier(0)
    Unit cur, nxt; int ui = 0;
    if (!S.next(0, cur)) return;
    f32x4 acc[2][2][4][2];
#pragma unroll
    for (int a = 0; a < 2; ++a)
#pragma unroll
        for (int b = 0; b < 2; ++b)
#pragma unroll
            for (int m = 0; m < 4; ++m)
#pragma unroll
                for (int n = 0; n < 2; ++n) acc[a][b][m][n] = (f32x4){0.f, 0.f, 0.f, 0.f};
    const int sc1 = 0x7f7f7f7f;
    bf16x8 At[4][2], B0[2][2], B1[2][2];
    v8i At8[4], B08[2], B18[2];
    v6i At6[4], B06[2], B16[2];
    if constexpr (PV == 3) {
#pragma unroll
        for (int m = 0; m < 4; ++m)
#pragma unroll
            for (int k = 0; k < 2; ++k) At[m][k] = (bf16x8){0, 0, 0, 0, 0, 0, 0, 0};
#pragma unroll
        for (int n = 0; n < 2; ++n)
#pragma unroll
            for (int k = 0; k < 2; ++k) { B0[n][k] = (bf16x8){0, 0, 0, 0, 0, 0, 0, 0}; B1[n][k] = B0[n][k]; } }
    const char* cA = (const char*)g.A + (size_t)S.a_tile(cur) * tstepA; const char* cB = (const char*)g.Bt + S.b_off(cur) + (size_t)cur.pn * tstep;
    S.a_ready(cur);
    if constexpr (SP2) {
        PG8_STAGE(PG8_SB(0, 0), cB, voffB); PG8_STAGE(PG8_SB(0, 1), cB + hstep, voffB); PG8_STAGE(PG8_SA(0, 0), cA, voffA); PG8_STAGE(PG8_SA(0, 1), cA + hstepA, voffA);
        if (wr == 1) PG8_BAR;
        PG8_WAIT_V(2); PG8_BAR;
        PG8_STAGE(PG8_SB(1, 0), cB + kstep, voffB); PG8_STAGE(PG8_SA(1, 0), cA + kstep, voffA); PG8_STAGE(PG8_SB(1, 1), cB + hstep + kstep, voffB);
        PG8_WAIT_V(6); PG8_BAR;
    } else {
        PG8_STAGE(PG8_SB(0, 0), cB, voffB); PG8_STAGE(PG8_SA(0, 0), cA, voffA); PG8_STAGE(PG8_SB(0, 1), cB + hstep, voffB); PG8_STAGE(PG8_SA(0, 1), cA + hstepA, voffA);
        if (wr == 1) PG8_BAR;
        PG8_WAIT_V(4); PG8_BAR;
        PG8_STAGE(PG8_SB(1, 0), cB + kstep, voffB); PG8_STAGE(PG8_SA(1, 0), cA + kstep, voffA); PG8_STAGE(PG8_SB(1, 1), cB + hstep + kstep, voffB);
        PG8_WAIT_V(6); PG8_BAR;
    }
    for (;;) {
        const bool has_next = S.next(ui + 1, nxt);
        const char* nA = has_next ? (const char*)g.A + (size_t)S.a_tile(nxt) * tstepA : cA; const char* nB = has_next ? (const char*)g.Bt + S.b_off(nxt) + (size_t)nxt.pn * tstep : cB;
        for (int t = 0; t < nt; t += 2) {
            const bool last = (t == nt - 2);
            const char* a1 = cA + (size_t)(t + 1) * kstep;
            const char* a2 = last ? nA : cA + (size_t)(t + 2) * kstep; const char* b2 = last ? nB : cB + (size_t)(t + 2) * kstep;
            const char* a3 = a2 + kstep; const char* b3 = b2 + kstep;
            if (last && has_next) S.a_ready(nxt);
            if constexpr (SP2) {
            PG8_LDB(B0, 0, 0); PG8_LDB(B1, 0, 1); PG8_SCHED; PG8_LDA(At, 0, 0); PG8_STAGE(PG8_SA(1, 1), a1 + hstepA, voffA);
            PG8_WAIT_V(8); PG8_WAIT_L(0); PG8_BAR; PG8_MMA(0, 0, At, B0); PG8_MMA(0, 1, At, B1); PG8_BAR; PG8_SCHED;
            PG8_LDA(At, 0, 1); PG8_STAGE(PG8_SB(0, 0), b2, voffB); PG8_STAGE(PG8_SB(0, 1), b2 + hstep, voffB); PG8_STAGE(PG8_SA(0, 0), a2, voffA);
            PG8_WAIT_V(8); PG8_WAIT_L(0); PG8_BAR; PG8_MMA(1, 0, At, B0); PG8_MMA(1, 1, At, B1); PG8_BAR; PG8_SCHED;
            PG8_LDB(B0, 1, 0); PG8_LDB(B1, 1, 1); PG8_SCHED; PG8_LDA(At, 1, 0); PG8_STAGE(PG8_SA(0, 1), a2 + hstepA, voffA);
            PG8_WAIT_V(8); PG8_WAIT_L(0); PG8_BAR; PG8_MMA(0, 0, At, B0); PG8_MMA(0, 1, At, B1); PG8_BAR; PG8_SCHED;
            PG8_LDA(At, 1, 1); PG8_STAGE(PG8_SB(1, 0), b3, voffB); PG8_STAGE(PG8_SB(1, 1), b3 + hstep, voffB); PG8_STAGE(PG8_SA(1, 0), a3, voffA);
            PG8_WAIT_V(8); PG8_WAIT_L(0); PG8_BAR; PG8_MMA(1, 0, At, B0); PG8_MMA(1, 1, At, B1); PG8_BAR; PG8_SCHED;
            } else {
            PG8_LDB(B0, 0, 0); PG8_SCHED; PG8_LDA(At, 0, 0); PG8_STAGE(PG8_SA(1, 1), a1 + hstepA, voffA);
            PG8_WAIT_L(8); PG8_BAR; PG8_WAIT_L(0); PG8_MMA(0, 0, At, B0); PG8_BAR; PG8_SCHED;
            PG8_LDB(B1, 0, 1); PG8_STAGE(PG8_SB(0, 0), b2, voffB);
            PG8_BAR; PG8_WAIT_L(0); PG8_MMA(0, 1, At, B1); PG8_BAR;
            PG8_LDA(At, 0, 1); PG8_STAGE(PG8_SA(0, 0), a2, voffA);
            PG8_BAR; PG8_WAIT_L(0); PG8_MMA(1, 0, At, B0); PG8_BAR; PG8_SCHED;
            PG8_STAGE(PG8_SB(0, 1), b2 + hstep, voffB);
            PG8_WAIT_V(6); PG8_BAR; PG8_MMA(1, 1, At, B1); PG8_BAR;
            PG8_LDB(B0, 1, 0); PG8_SCHED; PG8_LDA(At, 1, 0); PG8_STAGE(PG8_SA(0, 1), a2 + hstepA, voffA);
            PG8_WAIT_L(8); PG8_BAR; PG8_WAIT_L(0); PG8_MMA(0, 0, At, B0); PG8_BAR; PG8_SCHED;
            PG8_LDB(B1, 1, 1); PG8_STAGE(PG8_SB(1, 0), b3, voffB);
            PG8_BAR; PG8_WAIT_L(0); PG8_MMA(0, 1, At, B1); PG8_BAR;
            PG8_LDA(At, 1, 1); PG8_STAGE(PG8_SA(1, 0), a3, voffA);
            PG8_BAR; PG8_WAIT_L(0); PG8_MMA(1, 0, At, B0); PG8_BAR; PG8_SCHED;
            PG8_STAGE(PG8_SB(1, 1), b3 + hstep, voffB);
            PG8_WAIT_V(6); PG8_BAR; PG8_MMA(1, 1, At, B1); PG8_BAR;
            }
        }
        if constexpr (ALIGN_EPI) { if (wr == 0) PG8_BAR; }
        if constexpr (FP8) asm volatile("s_nop 15\n\ts_nop 15" ::: "memory");
        if constexpr (PV == 0) { if (!cur.skip_epi) { E(acc, cur, wr, wc, fr, fq); } } else { asm volatile("" :: "v"(acc[0][0][0][0]), "v"(acc[1][1][3][1])); } S.done(cur);
        if (!has_next) break;
#pragma unroll
        for (int a = 0; a < 2; ++a)
#pragma unroll
            for (int b = 0; b < 2; ++b)
#pragma unroll
                for (int m = 0; m < 4; ++m)
#pragma unroll
                    for (int n = 0; n < 2; ++n) acc[a][b][m][n] = (f32x4){0.f, 0.f, 0.f, 0.f};
        cur = nxt; cA = nA; cB = nB; ++ui;
        if constexpr (ALIGN_EPI) { if (wr == 1) PG8_BAR; }
    }
    PG8_WAIT_V(0);
    if constexpr (!ALIGN_EPI) { if (wr == 0) PG8_BAR; }
    PG8_BAR;
#undef PG8_SA
#undef PG8_SB
#undef PG8_STAGE
#undef PG8_LDA
#undef PG8_LDB
#undef PG8_MMA
#undef PG8_WAIT_V
#undef PG8_WAIT_L
#undef PG8_BAR
#undef PG8_SCHED
}
}

constexpr int NWAVES = 8, NTHR = NWAVES * 64;
constexpr int D = 2048, BATCH = 2, SEQ = 8192, T = BATCH * SEQ, DEPTH = 2;
constexpr int CW = 1024, LW = 1024, LH = 8, LHD = 128, DIN = 4096, CK = 31, LK = 4;
constexpr int UW = 3 * 1024;
constexpr int DFF = 6144, NE = 8;
constexpr float EPS = 1e-6f, LRU_C = 8.0f;
constexpr int MOE_ROWS_MAX = T * 2 + NE * 256;
constexpr float MOE_SC_A = 2.0f;
constexpr float MOE_SC_GU = 64.0f, MOE_SC_D = 128.0f;

constexpr size_t MiB = 1u << 20;
constexpr size_t WS_CTL = 0, CTL_ZERO_BYTES = 1 * MiB;
constexpr size_t WS_WIN = 2 * MiB;
constexpr size_t WS_WOUT = 34 * MiB;
constexpr size_t WS_WGATE = 50 * MiB;
constexpr size_t WS_DWGU = 52 * MiB;
constexpr size_t WS_DWD = 100 * MiB;
constexpr size_t WS_MWGU = 124 * MiB;
constexpr size_t WS_MWD = 316 * MiB;
constexpr size_t WS_X = 700 * MiB;
constexpr size_t WS_H = 828 * MiB;
constexpr size_t WS_ROUTE = 892 * MiB;
constexpr size_t WS_POS = WS_ROUTE + 512 * 1024;
constexpr size_t WS_HAGG = 893 * MiB;
constexpr size_t WS_CAGG = 894 * MiB;
constexpr size_t WS_SSQA = 895 * MiB, WS_SSQB = 895 * MiB + 512 * 1024;
constexpr size_t WS_XG8 = 412 * MiB;
constexpr size_t WS_YB = 896 * MiB;
constexpr size_t WS_XG = WS_YB;
constexpr size_t WS_BIG = 1032 * MiB;
constexpr size_t WS_U = WS_BIG;
constexpr size_t WS_Y = WS_BIG + 128 * MiB;
constexpr size_t WS_P1 = WS_BIG + 192 * MiB;
constexpr size_t WS_P2 = WS_BIG + 224 * MiB;
constexpr size_t WS_HID = WS_BIG;
constexpr size_t WS_END = 1440 * MiB;
constexpr size_t WS_NCONV = WS_XG;
constexpr size_t WS_NRX = WS_XG + 64 * MiB;
constexpr size_t WS_NA = WS_BIG + 256 * MiB;
constexpr size_t WS_NB = WS_BIG + 320 * MiB;
static_assert(WS_NB + 64 * MiB <= WS_END && WS_XG8 + (size_t)NE * T * (D + 128) <= WS_X, "ws map");
constexpr int CW_TMO = 0, CW_CODE = 1;
constexpr int CW_BAR = 4096;
constexpr int CW_CNT = 8192;
constexpr int CW_CUR = 8192 + 1024;
constexpr int CW_XRANK = 8192 + 2048;

constexpr int RING_OFF = 0, RING_BYTES = 131072;
constexpr int LDS_BYTES = 147456;
constexpr int LDSCTL_OFF = LDS_BYTES - 512, MISC_OFF = LDSCTL_OFF + 64;
constexpr int MX_PITCH = 1040, MX_RX = 0, MX_GG = 64 * MX_PITCH, MX_RED = 2 * 64 * MX_PITCH, MX_MR = MX_RED + 2048;
static_assert(MX_MR + 256 <= LDSCTL_OFF, "mixer LDS map");

#define GAS __attribute__((address_space(1)))
#define LAS __attribute__((address_space(3)))
typedef unsigned short bf16;
typedef unsigned v4u __attribute__((ext_vector_type(4)));
typedef unsigned v2u __attribute__((ext_vector_type(2)));
typedef float f32x4 __attribute__((ext_vector_type(4)));
typedef float f32x2 __attribute__((ext_vector_type(2)));
typedef short bf16x8 __attribute__((ext_vector_type(8)));
typedef GAS unsigned gu32;
#define RLX_AGENT __ATOMIC_RELAXED, __HIP_MEMORY_SCOPE_AGENT
#define LDS_WAIT() asm volatile("s_waitcnt lgkmcnt(0)" ::: "memory")
#define VM_WAIT() asm volatile("s_waitcnt vmcnt(0)" ::: "memory")
__device__ __forceinline__ unsigned f2bf(float f) { unsigned u = __builtin_bit_cast(unsigned, f); return (u + 0x7fffu + ((u >> 16) & 1u)) >> 16; }
__device__ __forceinline__ unsigned pk2(float lo, float hi) { unsigned r; asm("v_cvt_pk_bf16_f32 %0, %1, %2" : "=v"(r) : "v"(lo), "v"(hi)); return r; }
__device__ __forceinline__ float bf_lo(unsigned w) { return __uint_as_float(w << 16); }
__device__ __forceinline__ float bf_hi(unsigned w) { return __uint_as_float(w & 0xffff0000u); }
__device__ __forceinline__ float bf2f(bf16 b) { return __uint_as_float(((unsigned)b) << 16); }
__device__ __forceinline__ float sigmoidf_(float x) { return __builtin_amdgcn_rcpf(1.0f + __builtin_amdgcn_exp2f(-1.44269504089f * x)); }
__device__ __forceinline__ float gelu_tanh(float x) { const float u = 0.7978845608f * (x + 0.044715f * x * x * x); return x * sigmoidf_(2.0f * u); }

#define XB_TMO      128
#define XB_XCNT(j)  (256  + 64 * (j))
#define XB_XSUB(j)  (1280 + 64 * (j))
#define XB_XGEN(j)  (2304 + 64 * (j))
#define XB_TOP      3328
#define XB_TOPGEN   3392
#define XCD_BAR_WORDS 3456
#define XB_SPIN_CAP (1u << 18)
__device__ __forceinline__ unsigned xb_ld(unsigned* p)              { return __hip_atomic_load(p, __ATOMIC_RELAXED, __HIP_MEMORY_SCOPE_AGENT); }
__device__ __forceinline__ unsigned xb_add(unsigned* p, unsigned v) { return __hip_atomic_fetch_add(p, v, __ATOMIC_RELAXED, __HIP_MEMORY_SCOPE_AGENT); }
__device__ __forceinline__ unsigned xb_xcc_id() { return (unsigned)__builtin_amdgcn_s_getreg((3 << 11) | 20) & 0xFu; }
#define XB_SPIN(cond, bar) do { unsigned _sp = 0; while (cond) { __builtin_amdgcn_s_sleep(1); \
    if ((++_sp & 255u) == 0u) { if (xb_ld(&(bar)[XB_TMO])) break; if (_sp > XB_SPIN_CAP) { atomicAdd(&(bar)[XB_TMO], 1u); break; } } } } while (0)
struct XcdBarrier { unsigned* bar; unsigned x; volatile LAS unsigned* st; };
__device__ __forceinline__ XcdBarrier xcd_barrier_post(unsigned* bar, volatile LAS unsigned* st) {
    XcdBarrier b; b.bar = bar; b.x = xb_xcc_id(); b.st = st;
    if (threadIdx.x == 0) (void)xb_add(&bar[XB_XCNT(b.x)], 1u);
    return b;
}
__device__ __forceinline__ void xcd_barrier_complete(unsigned* bar, unsigned x, unsigned& nloc, unsigned& nx) {
    const unsigned G = gridDim.x * gridDim.y * gridDim.z;
    unsigned sum, cnt, mine, sp = 0u;
    for (;;) {
        sum = 0u; cnt = 0u; mine = 0u;
#pragma unroll
        for (unsigned j = 0; j < 16; ++j) { const unsigned c = xb_ld(&bar[XB_XCNT(j)]); sum += c; cnt += (c > 0u) ? 1u : 0u; mine = (j == x) ? c : mine; }
        if (sum == G) break;
        __builtin_amdgcn_s_sleep(1);
        if ((++sp & 255u) == 0u) { if (xb_ld(&bar[XB_TMO])) break; if (sp > XB_SPIN_CAP) { atomicAdd(&bar[XB_TMO], 1u); break; } }
    }
    nloc = mine > 0u ? mine : 1u; nx = cnt > 0u ? cnt : 1u;
}
__device__ __forceinline__ void xcd_barrier(const XcdBarrier& b) {
    asm volatile("s_waitcnt vmcnt(0)" ::: "memory");
    __syncthreads();
    if (threadIdx.x == 0) {
        unsigned* bar = b.bar;
        __builtin_amdgcn_s_waitcnt(0);
        unsigned nloc = b.st[0], nx = b.st[1];
        if (nloc == 0u) { xcd_barrier_complete(bar, b.x, nloc, nx); b.st[0] = nloc; b.st[1] = nx; }
        const unsigned old = xb_add(&bar[XB_XSUB(b.x)], 1u);
        const unsigned gen = old / nloc;
        if (old + 1u == (gen + 1u) * nloc) {
            __builtin_amdgcn_fence(__ATOMIC_RELEASE, "agent");
            asm volatile("s_waitcnt vmcnt(0)" ::: "memory");
            const unsigned og = xb_add(&bar[XB_TOP], 1u);
            const unsigned tg = og / nx;
            if (og + 1u == (tg + 1u) * nx) xb_add(&bar[XB_TOPGEN], 1u);
            else XB_SPIN(xb_ld(&bar[XB_TOPGEN]) == tg, bar);
            __builtin_amdgcn_fence(__ATOMIC_ACQUIRE, "agent");
            xb_add(&bar[XB_XGEN(b.x)], 1u);
            asm volatile("s_waitcnt vmcnt(0)" ::: "memory");
        } else {
            XB_SPIN(xb_ld(&bar[XB_XGEN(b.x)]) == gen, bar);
            __builtin_amdgcn_fence(__ATOMIC_ACQUIRE, "agent");
            asm volatile("s_waitcnt vmcnt(0)" ::: "memory");
        }
    }
    __syncthreads();
}

__device__ __forceinline__ float wave_sum(float v) {
#pragma unroll
    for (int o = 1; o < 64; o <<= 1) v += __shfl_xor(v, o);
    return v;
}

constexpr int CW_ = 1024;
__device__ __forceinline__ void tr_item(const float* __restrict__ W, int K, int N, bf16* WT, int mode, int item, LAS unsigned* scr, int lane, const float* kgain = nullptr) {
    const int nblk = N >> 6, kb = item / nblk, nb = item - kb * nblk, k0 = kb << 6, n0 = nb << 6;
    const int q = lane & 15, r = lane >> 4;
    f32x4 A[8], B[8];
#pragma unroll
    for (int i = 0; i < 8; ++i) { const float* p = W + (size_t)(k0 + 2 * (4 * i + r)) * N + n0 + 4 * q; A[i] = __builtin_nontemporal_load((const GAS f32x4*)p); B[i] = __builtin_nontemporal_load((const GAS f32x4*)(p + N)); }
    if (kgain) {
#pragma unroll
        for (int i = 0; i < 8; ++i) { const f32x2 g2 = *(const GAS f32x2*)(kgain + k0 + 2 * (4 * i + r)); A[i] *= g2.x; B[i] *= g2.y; } }
#pragma unroll
    for (int i = 0; i < 8; ++i)
#pragma unroll
        for (int j = 0; j < 4; ++j) scr[(4 * q + j) * 32 + ((4 * i + r) ^ (4 * (q & 7)))] = pk2(A[i][j], B[i][j]);
    LDS_WAIT(); asm volatile("" ::: "memory");
    const int c = lane & 7;
#pragma unroll
    for (int jj = 0; jj < 8; ++jj) { const int n = (lane >> 3) + 8 * jj; const v4u o = *(const LAS v4u*)(scr + n * 32 + 4 * (c ^ ((n >> 2) & 7)));
        const int ng = n0 + n; int row = mode == 0 ? ng : ((ng >> 7) * 256 + (ng & 127) + (mode == 2 ? 128 : 0));
        if (mode == 3) row = ng >= 2 * CW_ ? ng : (ng < CW_ ? ((ng >> 7) * 256 + (ng & 127)) : ((((ng - CW_) >> 7) * 256) + 128 + ((ng - CW_) & 127)));
        *(GAS v4u*)(WT + (size_t)row * K + k0 + 8 * c) = o; }
    LDS_WAIT(); asm volatile("" ::: "memory");
}


__device__ __forceinline__ unsigned cvt4_fp8(float a, float b, float c, float d) { int w = 0; w = __builtin_amdgcn_cvt_pk_fp8_f32(a, b, w, false); w = __builtin_amdgcn_cvt_pk_fp8_f32(c, d, w, true); return (unsigned)w; }
__device__ __forceinline__ void tr_item8(const float* __restrict__ W, int K, int N, unsigned char* WT, int mode, int item, LAS unsigned* scr, int lane, float sc) {
    const int nblk = N >> 5, kb = item / nblk, nb = item - kb * nblk, k0 = kb << 7, n0 = nb << 5;
    const int q = lane & 7, r = lane >> 3;
#pragma unroll
    for (int i = 0; i < 4; ++i) { const int p = 8 * i + r; const float* src = W + (size_t)(k0 + 4 * p) * N + n0 + 4 * q;
        const f32x4 R0 = __builtin_nontemporal_load((const GAS f32x4*)src), R1 = __builtin_nontemporal_load((const GAS f32x4*)(src + N)), R2 = __builtin_nontemporal_load((const GAS f32x4*)(src + 2 * (size_t)N)), R3 = __builtin_nontemporal_load((const GAS f32x4*)(src + 3 * (size_t)N));
#pragma unroll
        for (int j = 0; j < 4; ++j) scr[(4 * q + j) * 32 + (p ^ (4 * q))] = cvt4_fp8(R0[j] * sc, R1[j] * sc, R2[j] * sc, R3[j] * sc); }
    LDS_WAIT(); asm volatile("" ::: "memory");
    const int c = lane & 7;
#pragma unroll
    for (int jj = 0; jj < 4; ++jj) { const int n = (lane >> 3) + 8 * jj; const v4u o = *(const LAS v4u*)(scr + n * 32 + 4 * (c ^ ((n >> 2) & 7)));
        const int ng = n0 + n; const int row = mode == 0 ? ng : ((ng >> 7) * 256 + (ng & 127) + (mode == 2 ? 128 : 0));
        *(GAS v4u*)(WT + (size_t)row * K + k0 + 16 * c) = o; }
    LDS_WAIT(); asm volatile("" ::: "memory");
}

__device__ __forceinline__ void row_to_bf16_ssq(const float* xrow, bf16* orow, float* ssq8row, int lane) {
    const GAS f32x4* xr = (const GAS f32x4*)xrow + lane;
    f32x4 v[8]; float s = 0.f;
#pragma unroll
    for (int j = 0; j < 8; ++j) v[j] = xr[64 * j];
    GAS v2u* o8 = (GAS v2u*)orow + lane;
#pragma unroll
    for (int j = 0; j < 8; ++j) { v2u o; o.x = pk2(v[j].x, v[j].y); o.y = pk2(v[j].z, v[j].w); o8[64 * j] = o;
        const float r0 = bf_lo(o.x), r1 = bf_hi(o.x), r2 = bf_lo(o.y), r3 = bf_hi(o.y); s += (r0 * r0 + r1 * r1) + (r2 * r2 + r3 * r3); }
    s = wave_sum(s);
    if (lane < 2) ((GAS f32x4*)ssq8row)[lane] = (f32x4){lane == 0 ? s : 0.f, 0.f, 0.f, 0.f};
}
__device__ __forceinline__ void rms_row_to_bf16(const float* xrow, const float* gain, bf16* orow, int lane) {
    const GAS f32x4* xr = (const GAS f32x4*)xrow + lane; const GAS f32x4* gr = (const GAS f32x4*)gain + lane;
    f32x4 v[8]; float s = 0.f;
#pragma unroll
    for (int j = 0; j < 8; ++j) { v[j] = xr[64 * j]; s += (v[j].x * v[j].x + v[j].y * v[j].y) + (v[j].z * v[j].z + v[j].w * v[j].w); }
    const float rstd = 1.0f / sqrtf(wave_sum(s) * (1.0f / D) + EPS);
    GAS v2u* o8 = (GAS v2u*)orow + lane;
#pragma unroll
    for (int j = 0; j < 8; ++j) { const f32x4 g = gr[64 * j]; v2u o; o.x = pk2(v[j].x * rstd * g.x, v[j].y * rstd * g.y); o.y = pk2(v[j].z * rstd * g.z, v[j].w * rstd * g.w); o8[64 * j] = o; }
}


__device__ __forceinline__ float transpose_reduce64(float (&v)[64], int lane) {
#pragma unroll
    for (int d = 32; d >= 1; d >>= 1) {
        const bool up = (lane & d) != 0;
#pragma unroll
        for (int i = 0; i < d; ++i) { float x = v[i], y = v[i + d]; asm volatile("" : "+v"(x), "+v"(y));
            const float keep = up ? y : x; const float send = up ? x : y; v[i] = keep + __shfl_xor(send, d); }
    }
    return v[0];
}

__device__ __forceinline__ void swap32f(float& a, float& b) { const auto r = __builtin_amdgcn_permlane32_swap(__float_as_uint(a), __float_as_uint(b), false, false); a = __uint_as_float(r[0]); b = __uint_as_float(r[1]); }
__device__ __forceinline__ void swap16f(float& a, float& b) { const auto r = __builtin_amdgcn_permlane16_swap(__float_as_uint(a), __float_as_uint(b), false, false); a = __uint_as_float(r[0]); b = __uint_as_float(r[1]); }
__device__ __forceinline__ float transpose_reduce32(float (&v)[32], int lane) {
#pragma unroll
    for (int i = 0; i < 16; ++i) { float x = v[i], y = v[i + 16]; swap32f(x, y); v[i] = x + y; }
#pragma unroll
    for (int i = 0; i < 8; ++i) { float x = v[i], y = v[i + 8]; swap16f(x, y); v[i] = x + y; }
#pragma unroll
    for (int d = 8; d >= 2; d >>= 1) {
        const bool up = (lane & d) != 0;
#pragma unroll
        for (int i = 0; i < d / 2; ++i) { float x = v[i], y = v[i + d / 2]; asm volatile("" : "+v"(x), "+v"(y));
            const float keep = up ? y : x; const float send = up ? x : y; v[i] = keep + __shfl_xor(send, d); }
    }
    v[0] += __shfl_xor(v[0], 1);
    return v[0];
}

__device__ __forceinline__ void conv_unit(const bf16* U, bf16* Y, const float* conv_w, const float* conv_b, const float* lng, const float* lnb, int tile, LAS unsigned char* lds, int tid, int lane, int wave) {
    LAS float* red = (LAS float*)(lds + MX_RED);
    LAS float* mr = (LAS float*)(lds + MX_MR);
    const int r0 = tile * 64, tl0 = r0 & (SEQ - 1), c0 = 2 * tid;
    for (int chunk = 0; chunk < 2; ++chunk) {
        const int rb = r0 + 32 * chunk; const bool head = (tl0 + 32 * chunk) == 0;
        f32x2 w[CK];
#pragma unroll
        for (int k = 0; k < CK; ++k) w[k] = *(const GAS f32x2*)(conv_w + k * CW + c0);
        const f32x2 bias = *(const GAS f32x2*)(conv_b + c0);
        f32x2 acc[32];
#pragma unroll
        for (int o = 0; o < 32; ++o) acc[o] = bias;
        const GAS unsigned* up = (const GAS unsigned*)(U + (size_t)rb * UW + c0);
        unsigned vb[2][4];
#pragma unroll
        for (int jj = 0; jj < 4; ++jj) { const long ro = head ? 0 : (long)(jj - 30); vb[0][jj] = up[ro * (UW / 2)]; }
#pragma unroll
        for (int jb = 0; jb < 16; ++jb) {
            if (jb < 15) {
#pragma unroll
                for (int jj = 0; jj < 4; ++jj) { const int j = 4 * (jb + 1) + jj; if (j < 62) { const long ro = (head && j < 30) ? 0 : (long)(j - 30); vb[(jb + 1) & 1][jj] = up[ro * (UW / 2)]; } } }
            const unsigned (&vv)[4] = vb[jb & 1];
#pragma unroll
            for (int jj = 0; jj < 4; ++jj) { const int j = 4 * jb + jj; if (j < 62) {
                f32x2 glu; glu.x = bf_lo(vv[jj]); glu.y = bf_hi(vv[jj]);
                if (head && j < 30) glu = (f32x2){0.f, 0.f};
#pragma unroll
                for (int o = 0; o < 32; ++o) { const int k = j - o; if (k >= 0 && k < CK) acc[o] += w[k] * glu; } } }
        }
        { float v[32];
#pragma unroll
          for (int o = 0; o < 32; ++o) v[o] = acc[o].x + acc[o].y;
          const float t1 = transpose_reduce32(v, lane); if (!(lane & 1)) red[wave * 64 + (lane >> 1)] = t1;
#pragma unroll
          for (int o = 0; o < 32; ++o) v[o] = acc[o].x * acc[o].x + acc[o].y * acc[o].y;
          const float t2 = transpose_reduce32(v, lane); if (!(lane & 1)) red[wave * 64 + 32 + (lane >> 1)] = t2; }
        __syncthreads();
        if (tid < 32) { float s1 = 0.f, s2 = 0.f;
#pragma unroll
            for (int wv = 0; wv < 8; ++wv) { s1 += red[wv * 64 + tid]; s2 += red[wv * 64 + 32 + tid]; }
            const float mean = s1 * (1.0f / CW); const float var = fmaxf(s2 * (1.0f / CW) - mean * mean, 0.f);
            mr[2 * tid] = mean; mr[2 * tid + 1] = __builtin_amdgcn_rsqf(var + EPS); }
        __syncthreads();
        const f32x2 lg = *(const GAS f32x2*)(lng + c0), lb = *(const GAS f32x2*)(lnb + c0);
        GAS unsigned* yp = (GAS unsigned*)(Y + (size_t)rb * D + c0);
#pragma unroll
        for (int o = 0; o < 32; ++o) { const float mean = mr[2 * o], rstd = mr[2 * o + 1];
            const float z0 = (acc[o].x - mean) * rstd * lg.x + lb.x, z1 = (acc[o].y - mean) * rstd * lg.y + lb.y;
            yp[(size_t)o * (D / 2)] = pk2(z0 * sigmoidf_(z0), z1 * sigmoidf_(z1)); }
        __syncthreads();
    }
}

__device__ __forceinline__ void lru_unit(const bf16* U, bf16* P1, bf16* P2, float* HAGG, float* CAGG, const bf16* WgT  ,
                                         const float* lcw, const float* lcb, const float* ba, const float* bxx, const float* lam, int tile, LAS unsigned char* lds, int tid, int lane, int wave) {
    const int r0 = tile * 64, tl0 = r0 & (SEQ - 1);
    const int fr = lane & 15, fq = lane >> 4;
    for (int hh = 0; hh < 2; ++hh) {
        { const int cp = tid & 255, th = tid >> 8, c = 512 * hh + 2 * cp;
          f32x2 w4[LK];
#pragma unroll
          for (int k = 0; k < LK; ++k) w4[k] = *(const GAS f32x2*)(lcw + k * LW + c);
          const f32x2 b4 = *(const GAS f32x2*)(lcb + c);
          const bool head = (tl0 == 0) && (th == 0);
          const GAS unsigned* up = (const GAS unsigned*)(U + (size_t)(r0 + 32 * th) * UW + CW + c);
          f32x2 win[3];
#pragma unroll
          for (int i = 0; i < 3; ++i) { const unsigned u = head ? 0u : up[(long)(i - 3) * (UW / 2)]; win[i] = (f32x2){bf_lo(u), bf_hi(u)}; }
          LAS unsigned* rxw = (LAS unsigned*)(lds + MX_RX + (32 * th) * MX_PITCH + 4 * cp);
          LAS unsigned* ggw = (LAS unsigned*)(lds + MX_GG + (32 * th) * MX_PITCH + 4 * cp);
#pragma unroll 8
          for (int i = 0; i < 32; ++i) { const unsigned u = up[(long)i * (UW / 2)], gt = up[(long)i * (UW / 2) + CW / 2];
              const f32x2 cur = (f32x2){bf_lo(u), bf_hi(u)};
              const f32x2 rx = b4 + w4[0] * win[0] + w4[1] * win[1] + w4[2] * win[2] + w4[3] * cur;
              win[0] = win[1]; win[1] = win[2]; win[2] = cur;
              rxw[i * (MX_PITCH / 4)] = pk2(rx.x, rx.y);
              ggw[i * (MX_PITCH / 4)] = pk2(gelu_tanh(bf_lo(gt)), gelu_tanh(bf_hi(gt))); } }
        __syncthreads();
        { const int hl = wave >> 1, hd = 4 * hh + hl, nb = 64 * (wave & 1);
          const bf16* WaT = WgT + (size_t)hd * LHD * LHD; const bf16* WxT = WgT + (size_t)(LH + hd) * LHD * LHD;
          bf16x8 bA[4], bX[4]; float ba_c, bx_c, lam_c;
#pragma unroll
          for (int ks = 0; ks < 4; ++ks) { bA[ks] = *(const GAS bf16x8*)(WaT + (size_t)(nb + fr) * LHD + 32 * ks + 8 * fq); bX[ks] = *(const GAS bf16x8*)(WxT + (size_t)(nb + fr) * LHD + 32 * ks + 8 * fq); }
          ba_c = ba[LHD * hd + nb + fr]; bx_c = bxx[LHD * hd + nb + fr]; lam_c = lam[LHD * hd + nb + fr];
#pragma unroll 1
          for (int nt = 0; nt < 4; ++nt) {
              const int n0 = nb + 16 * nt, ch = LHD * hd + n0 + fr, lcol = LHD * hl + n0 + fr;
              f32x4 aa[4], ax[4];
#pragma unroll
              for (int m = 0; m < 4; ++m) { aa[m] = (f32x4){0.f, 0.f, 0.f, 0.f}; ax[m] = aa[m]; }
#pragma unroll
              for (int ks = 0; ks < 4; ++ks)
#pragma unroll
                  for (int m = 0; m < 4; ++m) { const bf16x8 af = *(const LAS bf16x8*)(lds + MX_RX + (16 * m + fr) * MX_PITCH + (LHD * hl + 32 * ks + 8 * fq) * 2);
                      aa[m] = __builtin_amdgcn_mfma_f32_16x16x32_bf16(af, bA[ks], aa[m], 0, 0, 0); ax[m] = __builtin_amdgcn_mfma_f32_16x16x32_bf16(af, bX[ks], ax[m], 0, 0, 0); }
              const float ba_u = ba_c, bx_u = bx_c, lam_u = lam_c;
              if (nt < 3) {
                  asm volatile("" ::: "memory");
#pragma unroll
                  for (int ks = 0; ks < 4; ++ks) { bA[ks] = *(const GAS bf16x8*)(WaT + (size_t)(n0 + 16 + fr) * LHD + 32 * ks + 8 * fq); bX[ks] = *(const GAS bf16x8*)(WxT + (size_t)(n0 + 16 + fr) * LHD + 32 * ks + 8 * fq); }
                  ba_c = ba[ch + 16]; bx_c = bxx[ch + 16]; lam_c = lam[ch + 16]; }
              const float nl = -lam_u; const float sp8 = LRU_C * (fmaxf(nl, 0.f) + __logf(1.0f + __expf(-fabsf(nl))));
              const LAS bf16* rxr = (const LAS bf16*)(lds + MX_RX) + lcol; const LAS bf16* ggr = (const LAS bf16*)(lds + MX_GG) + lcol;
              float hl4[4][4], cl4[4][4], A[4], B[4];
#pragma unroll
              for (int m = 0; m < 4; ++m) { float h = 0.f, cp = 1.f;
#pragma unroll
                  for (int j = 0; j < 4; ++j) { const int tt = 16 * m + 4 * fq + j;
                      const float ga = sigmoidf_(aa[m][j] + ba_u), gx = sigmoidf_(ax[m][j] + bx_u);
                      const float la = -sp8 * ga, a = __builtin_amdgcn_exp2f(1.44269504089f * la);
                      const float x2 = 2.0f * la;
                      const float om_s = -x2 * (1.0f + x2 * (0.5f + x2 * (0.16666667f + x2 * (0.041666668f + x2 * 0.0083333338f))));
                      const float om = (x2 > -0.25f) ? om_s : (1.0f - a * a);
                      float mult = __builtin_amdgcn_sqrtf(fmaxf(om, 0.f)); if (tl0 == 0 && tt == 0) mult = 1.0f;
                      const float b = mult * gx * bf2f(rxr[tt * (MX_PITCH / 2)]);
                      h = a * h + b; cp *= a; hl4[m][j] = h; cl4[m][j] = cp; }
                  A[m] = cp; B[m] = h; }
#pragma unroll
              for (int m = 0; m < 4; ++m) { const float Ap = __shfl_up(A[m], 16), Bp = __shfl_up(B[m], 16); if (fq >= 1) { B[m] = A[m] * Bp + B[m]; A[m] = A[m] * Ap; } }
#pragma unroll
              for (int m = 0; m < 4; ++m) { const float Ap = __shfl_up(A[m], 32), Bp = __shfl_up(B[m], 32); if (fq >= 2) { B[m] = A[m] * Bp + B[m]; A[m] = A[m] * Ap; } }
              float TA[4], TB[4], EA[4], EB[4];
#pragma unroll
              for (int m = 0; m < 4; ++m) { TA[m] = __shfl(A[m], 48 + fr); TB[m] = __shfl(B[m], 48 + fr); EA[m] = __shfl_up(A[m], 16); EB[m] = __shfl_up(B[m], 16); if (fq == 0) { EA[m] = 1.f; EB[m] = 0.f; } }
              float Hc = 0.f, Cc = 1.f;
#pragma unroll
              for (int m = 0; m < 4; ++m) { const float Hin = EA[m] * Hc + EB[m], Cin = EA[m] * Cc;
#pragma unroll
                  for (int j = 0; j < 4; ++j) { const int tt = 16 * m + 4 * fq + j; const float g = bf2f(ggr[tt * (MX_PITCH / 2)]);
                      const float hf = hl4[m][j] + cl4[m][j] * Hin, cf = cl4[m][j] * Cin;
                      { const unsigned w = pk2(hf * g, cf * g); P1[(size_t)(r0 + tt) * LW + ch] = (bf16)(w & 0xffffu); P2[(size_t)(r0 + tt) * LW + ch] = (bf16)(w >> 16); } }
                  Hc = TA[m] * Hc + TB[m]; Cc = TA[m] * Cc; }
              if (fq == 0) { HAGG[(size_t)tile * LW + ch] = Hc; CAGG[(size_t)tile * LW + ch] = Cc; }
          } }
        __syncthreads();
    }
}

__device__ __forceinline__ void lru_fix_unit(const bf16* P1, const bf16* P2, const float* HAGG, const float* CAGG, bf16* Y, int tile, LAS unsigned char* lds, int tid) {
    const int tb = tile & ~(SEQ / 64 - 1), j = tile & (SEQ / 64 - 1);
    const int cg = tid & 127, ts = tid >> 7;
    float A[8], B[8];
#pragma unroll
    for (int q = 0; q < 8; ++q) { A[q] = 1.f; B[q] = 0.f; }
    const int i0 = (j * ts) >> 2, i1 = (j * (ts + 1)) >> 2;
#pragma unroll 4
    for (int i = i0; i < i1; ++i) { const GAS f32x4* cp = (const GAS f32x4*)(CAGG + (size_t)(tb + i) * LW + 8 * cg); const GAS f32x4* hp = (const GAS f32x4*)(HAGG + (size_t)(tb + i) * LW + 8 * cg);
        const f32x4 c0 = cp[0], c1 = cp[1], h0 = hp[0], h1 = hp[1];
#pragma unroll
        for (int q = 0; q < 4; ++q) { B[q] = c0[q] * B[q] + h0[q]; A[q] *= c0[q]; B[4 + q] = c1[q] * B[4 + q] + h1[q]; A[4 + q] *= c1[q]; } }
    LAS float* part = (LAS float*)lds;
#pragma unroll
    for (int q = 0; q < 8; ++q) { part[(ts * 128 + cg) * 16 + q] = A[q]; part[(ts * 128 + cg) * 16 + 8 + q] = B[q]; }
    __syncthreads();
    float hin[8];
#pragma unroll
    for (int q = 0; q < 8; ++q) hin[q] = 0.f;
#pragma unroll
    for (int sgm = 0; sgm < 4; ++sgm)
#pragma unroll
        for (int q = 0; q < 8; ++q) hin[q] = part[(sgm * 128 + cg) * 16 + q] * hin[q] + part[(sgm * 128 + cg) * 16 + 8 + q];
    __syncthreads();
    const int r0 = tile * 64;
#pragma unroll 4
    for (int tt = ts; tt < 64; tt += 4) { const v4u p1 = *(const GAS v4u*)(P1 + (size_t)(r0 + tt) * LW + 8 * cg), p2 = *(const GAS v4u*)(P2 + (size_t)(r0 + tt) * LW + 8 * cg);
        v4u o;
        o.x = pk2(bf_lo(p1.x) + bf_lo(p2.x) * hin[0], bf_hi(p1.x) + bf_hi(p2.x) * hin[1]); o.y = pk2(bf_lo(p1.y) + bf_lo(p2.y) * hin[2], bf_hi(p1.y) + bf_hi(p2.y) * hin[3]);
        o.z = pk2(bf_lo(p1.z) + bf_lo(p2.z) * hin[4], bf_hi(p1.z) + bf_hi(p2.z) * hin[5]); o.w = pk2(bf_lo(p1.w) + bf_lo(p2.w) * hin[6], bf_hi(p1.w) + bf_hi(p2.w) * hin[7]);
        *(GAS v4u*)(Y + (size_t)(r0 + tt) * D + CW + 8 * cg) = o; }
}


struct MoeItem { const float* W; unsigned char* WT; int K, N, mode, item; float sc; };
__device__ __forceinline__ MoeItem moe_item(int it, const float* wg, const float* wu, const float* wd, unsigned char* MWgu8, unsigned char* MWd8) {
    constexpr int I_GU = (D / 128) * (DFF / 128), I_DN = (DFF / 128) * (D / 128), N_MGU = NE * 2 * I_GU;
    MoeItem m;
    if (it < N_MGU) { const int e = it / (2 * I_GU), rr = it % (2 * I_GU), w = rr / I_GU; m.W = (w == 0 ? wg : wu) + (size_t)e * D * DFF; m.WT = MWgu8 + (size_t)e * 2 * DFF * D; m.K = D; m.N = DFF; m.mode = 1 + w; m.item = rr % I_GU; m.sc = MOE_SC_GU; }
    else { const int r = it - N_MGU, e = r / I_DN; m.W = wd + (size_t)e * DFF * D; m.WT = MWd8 + (size_t)e * D * DFF; m.K = DFF; m.N = D; m.mode = 0; m.item = r % I_DN; m.sc = MOE_SC_D; }
    return m;
}
__device__ __forceinline__ void tr8_load(const MoeItem& m, int sblk, f32x4 (&R)[16], int lane) {
    const int nblk = m.N >> 7, kb = m.item / nblk, nb = m.item - kb * nblk, k0 = (kb << 7) + 32 * sblk, n0 = nb << 7, q = lane & 31, r = lane >> 5;
#pragma unroll
    for (int i = 0; i < 4; ++i) { const float* src = m.W + (size_t)(k0 + 4 * (2 * i + r)) * m.N + n0 + 4 * q;
#pragma unroll
        for (int x = 0; x < 4; ++x) R[4 * i + x] = __builtin_nontemporal_load((const GAS f32x4*)(src + (size_t)x * m.N)); }
}
__device__ __forceinline__ void tr8_sub(const MoeItem& m, int sblk, const f32x4 (&R)[16], LAS unsigned* scr, int lane) {
    const int q = lane & 31, r = lane >> 5; const float sc = m.sc;
#pragma unroll
    for (int i = 0; i < 4; ++i) { const int p = 8 * sblk + 2 * i + r;
#pragma unroll
        for (int j = 0; j < 4; ++j) scr[(4 * q + j) * 32 + (p ^ (4 * (q & 7)))] = cvt4_fp8(R[4 * i][j] * sc, R[4 * i + 1][j] * sc, R[4 * i + 2][j] * sc, R[4 * i + 3][j] * sc); }
}
__device__ __forceinline__ void tr8_store(const MoeItem& m, LAS unsigned* scr, int lane) {
    const int nblk = m.N >> 7, kb = m.item / nblk, nb = m.item - kb * nblk, k0 = kb << 7, n0 = nb << 7;
    LDS_WAIT(); asm volatile("" ::: "memory");
    const int c = lane & 7;
#pragma unroll
    for (int jj = 0; jj < 16; ++jj) { const int n = (lane >> 3) + 8 * jj; const v4u o = *(const LAS v4u*)(scr + n * 32 + 4 * (c ^ ((n >> 2) & 7)));
        const int ng = n0 + n; const int row = m.mode == 0 ? ng : ((ng >> 7) * 256 + (ng & 127) + (m.mode == 2 ? 128 : 0));
        __builtin_nontemporal_store(o, (GAS v4u*)(m.WT + (size_t)row * m.K + k0 + 16 * c)); }
    LDS_WAIT(); asm volatile("" ::: "memory");
}
typedef float v16f __attribute__((ext_vector_type(16)));
typedef unsigned v6u __attribute__((ext_vector_type(6)));
__device__ __forceinline__ void tr6_load(const MoeItem& m, int sblk, f32x2 (&R)[32], int lane) {
    const int nblk = m.N >> 7, kb = m.item / nblk, nb = m.item - kb * nblk, k0 = 16 * kb + 4 * sblk, n0 = nb << 7;
    const __amdgpu_buffer_rsrc_t rs = __builtin_amdgcn_make_buffer_rsrc((void*)m.W, 0, m.K * m.N * 4, 0x00020000);
    const int vo = (n0 + 2 * lane) * 4, rowb = m.N * 4, so0 = k0 * rowb;
#pragma unroll
    for (int t = 0; t < 32; ++t) { const v2u w = __builtin_amdgcn_raw_buffer_load_b64(rs, vo, so0 + ((t & 3) + 256 * (t >> 2)) * rowb, 2  ); R[t] = (f32x2){__uint_as_float(w.x), __uint_as_float(w.y)}; }
}
__device__ __forceinline__ void tr6_sub(const MoeItem& m, int sblk, const f32x2 (&R)[32], LAS unsigned* scr, int lane) {
    const float sc = m.sc;
#pragma unroll
    for (int b = 0; b < 2; ++b) { v16f x, y;
#pragma unroll
        for (int k = 0; k < 16; ++k) { x[k] = R[k][b]; y[k] = R[16 + k][b]; }
        v6u d; asm volatile("v_cvt_scalef32_2xpk16_fp6_f32 %0, %1, %2, %3" : "=&v"(d) : "v"(x), "v"(y), "v"(1.0f / sc));
        const int row = 2 * lane + b, sw = (row >> 2) & 7;
        LAS unsigned* p1 = scr + row * 32 + 4 * (sblk ^ sw); LAS unsigned* p2 = scr + row * 32 + 4 * ((4 + sblk) ^ sw);
        p1[0] = d[0]; p1[1] = d[1]; p1[2] = d[2]; p1[3] = d[3]; p2[0] = d[4]; p2[1] = d[5]; }
}
__device__ __forceinline__ void moe_convert_share(const float* wg, const float* wu, const float* wd, unsigned char* MWgu8, unsigned char* MWd8, LAS unsigned char* lds, int gw, int NGW, int wave, int lane) {
    LAS unsigned* scr = (LAS unsigned*)(lds + RING_OFF + wave * 16384);
    constexpr int N_MGU = NE * 2 * (D / 128) * (DFF / 128), NTOT = N_MGU + NE * (DFF / 128) * (D / 128);
    int it = gw;
    { f32x2 Qa[32], Qb[32];
      for (; it < N_MGU; it += NGW) {
        const MoeItem m = moe_item(it, wg, wu, wd, MWgu8, MWd8);
        tr6_load(m, 0, Qa, lane);
        tr6_load(m, 1, Qb, lane); tr6_sub(m, 0, Qa, scr, lane);
        tr6_load(m, 2, Qa, lane); tr6_sub(m, 1, Qb, scr, lane);
        tr6_load(m, 3, Qb, lane); tr6_sub(m, 2, Qa, scr, lane);
        tr6_sub(m, 3, Qb, scr, lane);
        tr8_store(m, scr, lane);
      } }
    f32x4 Ra[16], Rb[16];
    for (; it < NTOT; it += NGW) {
        const MoeItem m = moe_item(it, wg, wu, wd, MWgu8, MWd8);
        tr8_load(m, 0, Ra, lane);
        tr8_load(m, 1, Rb, lane); tr8_sub(m, 0, Ra, scr, lane);
        tr8_load(m, 2, Ra, lane); tr8_sub(m, 1, Rb, scr, lane);
        tr8_load(m, 3, Rb, lane); tr8_sub(m, 2, Ra, scr, lane);
        tr8_sub(m, 3, Rb, scr, lane);
        tr8_store(m, scr, lane);
    }
}

struct Args { const float* in[24]; float* out; unsigned char* ws; int ph_lo, ph_hi; };
constexpr int N_PHASES = 15;

constexpr int DC_I_IN = (D / 64) * (DIN / 64), DC_I_OUT = (D / 64) * (D / 64), DC_I_GU = (D / 64) * (DFF / 64), DC_I_DN = (DFF / 64) * (D / 64), DC_I_GT = 4;
constexpr int DC_N_GT = DEPTH * 2 * LH * DC_I_GT, DC_N_EARLY = DC_I_IN + DC_N_GT, DC_N_ALL = DC_N_EARLY + DC_I_IN + 2 * DC_I_OUT + 2 * DC_I_GU + DC_I_DN;
__device__ __forceinline__ void dense_convert_items(const Args& args, unsigned char* ws, int lo, int hi, LAS unsigned char* lds, int gw, int NGW, int wave, int lane) {
    LAS unsigned* scr = (LAS unsigned*)(lds + RING_OFF + wave * 8192);
    bf16* Win_t = (bf16*)(ws + WS_WIN); bf16* Wout_t = (bf16*)(ws + WS_WOUT); bf16* Wgate_t = (bf16*)(ws + WS_WGATE); bf16* DWgu = (bf16*)(ws + WS_DWGU); bf16* DWd = (bf16*)(ws + WS_DWD);
    for (int it = lo + gw; it < hi; it += NGW) {
        int r = it;
        if (r < DC_I_IN) { tr_item(args.in[2], D, DIN, Win_t, 3, r, scr, lane, args.in[1]); continue; } r -= DC_I_IN;
        if (r < DC_N_GT) { const int m = r / DC_I_GT;
            const int l = m / 16, ax = (m / 8) & 1, h = m & 7;
            tr_item((ax == 0 ? args.in[9] : args.in[11]) + (size_t)(l * LH + h) * LHD * LHD, LHD, LHD, Wgate_t + (size_t)m * LHD * LHD, 0, r % DC_I_GT, scr, lane); continue; } r -= DC_N_GT;
        if (r < DC_I_IN) { tr_item(args.in[2] + (size_t)D * DIN, D, DIN, Win_t + (size_t)DIN * D, 3, r, scr, lane, args.in[1] + D); continue; } r -= DC_I_IN;
        if (r < 2 * DC_I_OUT) { const int l = r / DC_I_OUT; tr_item(args.in[14] + (size_t)l * D * D, D, D, Wout_t + (size_t)l * D * D, 0, r % DC_I_OUT, scr, lane); continue; } r -= 2 * DC_I_OUT;
        if (r < 2 * DC_I_GU) { const int w = r / DC_I_GU; tr_item(w == 0 ? args.in[16] : args.in[17], D, DFF, DWgu, 1 + w, r % DC_I_GU, scr, lane, args.in[15]); continue; } r -= 2 * DC_I_GU;
#if DENSE2_FP8
        tr_item8(args.in[18], DFF, D, (unsigned char*)DWd, 0, r, scr, lane, MOE_SC_D);
#else
        tr_item(args.in[18], DFF, D, DWd, 0, r, scr, lane);
#endif
    }
}


#define IN(k) (lo <= (k) && (k) < hi)
#define REPS(k) for (int rep_ = 0; rep_ < (((k) == PROBE_PHASE) ? PROBE_N : 1); ++rep_)
#define SEAM(k) do { if (IN(k) && IN((k) + 1)) xcd_barrier(bar); } while (0)
struct Ctx { LAS unsigned char* lds; unsigned char* ws; gu32* ctl; int tid, lane, wave, G, bx, gw, NGW, gtid, NGT, lo, hi, vbx; };
template <int L> __device__ __forceinline__ void layer_phases(const Args& args, const Ctx& C, const XcdBarrier& bar) {
    LAS unsigned char* lds = C.lds; unsigned char* ws = C.ws; gu32* ctl = C.ctl;
    const int tid = C.tid, lane = C.lane, wave = C.wave, G = C.G, bx = C.bx, gw = C.gw, NGW = C.NGW, gtid = C.gtid, NGT = C.NGT, lo = C.lo, hi = C.hi, vbx = C.vbx;
    const float* x_in = args.in[0];
    bf16* Win_t = (bf16*)(ws + WS_WIN); bf16* Wout_t = (bf16*)(ws + WS_WOUT); bf16* Wgate_t = (bf16*)(ws + WS_WGATE);
    bf16* DWgu = (bf16*)(ws + WS_DWGU); bf16* DWd = (bf16*)(ws + WS_DWD); bf16* MWgu = (bf16*)(ws + WS_MWGU); bf16* MWd = (bf16*)(ws + WS_MWD);
    float* X = (float*)(ws + WS_X); bf16* H = (bf16*)(ws + WS_H); bf16* U = (bf16*)(ws + WS_U); bf16* Y = (bf16*)(ws + WS_Y);
    bf16* HID = (bf16*)(ws + WS_HID); bf16* XG8 = (bf16*)(ws + WS_XG8); bf16* YB = (bf16*)(ws + WS_YB);
    int* ROUTE = (int*)(ws + WS_ROUTE); int* POS = (int*)(ws + WS_POS);

    {
        constexpr int l = L, pb = 1 + 6 * L;
        if (IN(pb)) REPS(pb) {
            pg8::Gemm g{H, Win_t + (size_t)l * DIN * D, T, DIN, D}; pg8::StaticOrder S; S.init(T, DIN, G, vbx);
            pg8::EpiInProj E{U, UW, (const float*)(ws + WS_SSQB)};
            if constexpr (L == 0) {
                const int rounds = (S.nwg + G - 1) / G, grp = (vbx * 4) / G, cut = (rounds * grp) / 4;
                S.i0 = 0; S.i1 = cut;
                pg8::gemm_phase<pg8::EpiInProj, pg8::StaticOrder, true, true>(lds + RING_OFF, g, S, E);
                dense_convert_items(args, ws, DC_N_EARLY, DC_N_ALL, lds, gw, NGW, wave, lane);
                __syncthreads();
                S.i0 = cut; S.i1 = 0x7fffffff;
            }
            pg8::gemm_phase<pg8::EpiInProj, pg8::StaticOrder, true, true>(lds + RING_OFF, g, S, E);
#if GEMM_PV >= 0
            if (L == 0) { __syncthreads(); pg8::gemm_phase<pg8::EpiInProj, pg8::StaticOrder, true, true, false, GEMM_PV>(lds + RING_OFF, g, S, E); }
#endif
        }
        SEAM(pb);
        if (IN(pb + 1)) { constexpr int TR = (PROBE_PHASE == pb + 1) ? PROBE_N : 1;
            const float* conv_w = args.in[3] + (size_t)l * CK * CW; const float* conv_b = args.in[4] + (size_t)l * CW;
            const float* lcw = args.in[7] + (size_t)l * LK * LW; const float* lcb = args.in[8] + (size_t)l * LW;
#if NAIVE_CONV || NAIVE_LRU
            float* NCONV = (float*)(ws + WS_NCONV); float* NRX = (float*)(ws + WS_NRX);
            for (int idx = gtid; idx < T * CW; idx += NGT) {
                const int t = idx >> 10, c = idx & 1023, tl = t & (SEQ - 1);
                float s = conv_b[c];
                for (int k = 0; k < CK; ++k) { const int tt = tl - (CK - 1) + k; if (tt >= 0) { const size_t ro = (size_t)(t - (CK - 1) + k) * DIN; const float v = bf2f(U[ro + c]), gt = bf2f(U[ro + CW + c]); s += conv_w[k * CW + c] * (v * sigmoidf_(gt)); } }
                NCONV[idx] = s;
                float r = lcb[c];
                for (int k = 0; k < LK; ++k) { const int tt = tl - (LK - 1) + k; if (tt >= 0) r += lcw[k * LW + c] * bf2f(U[(size_t)(t - (LK - 1) + k) * DIN + 2 * CW + c]); }
                NRX[idx] = r;
            }
#endif
#if !NAIVE_LRU
            for (int tile_ = bx; tile_ < (PROBE_SUB == 2 ? 1 : TR) * (T / 64); tile_ += G) { const int tile = tile_ % (T / 64);
                lru_unit(U, (bf16*)(ws + WS_P1), (bf16*)(ws + WS_P2), (float*)(ws + WS_HAGG), (float*)(ws + WS_CAGG), Wgate_t + (size_t)l * 2 * LH * LHD * LHD, lcw, lcb,
                         args.in[10] + (size_t)l * LW, args.in[12] + (size_t)l * LW, args.in[13] + (size_t)l * LW, tile, lds, tid, lane, wave); }
#endif
#if !NAIVE_CONV
            for (int tile_ = bx; tile_ < (PROBE_SUB == 1 ? 1 : TR) * (T / 64); tile_ += G) { const int tile = tile_ % (T / 64);
                conv_unit(U, Y, conv_w, conv_b, args.in[5] + (size_t)l * CW, args.in[6] + (size_t)l * CW, tile, lds, tid, lane, wave); }
#endif
        }
        SEAM(pb + 1);
        if (IN(pb + 2)) REPS(pb + 2) {
#if NAIVE_CONV
            { const float* lng = args.in[5] + (size_t)l * CW; const float* lnb = args.in[6] + (size_t)l * CW; const float* NCONV = (const float*)(ws + WS_NCONV);
            for (int m = gw; m < T; m += NGW) {
                float v[16]; float s = 0.f;
#pragma unroll
                for (int j = 0; j < 16; ++j) { v[j] = NCONV[(size_t)m * CW + lane + 64 * j]; s += v[j]; }
                const float mean = wave_sum(s) * (1.0f / CW); float q = 0.f;
#pragma unroll
                for (int j = 0; j < 16; ++j) { v[j] -= mean; q += v[j] * v[j]; }
                const float rstd = 1.0f / sqrtf(wave_sum(q) * (1.0f / CW) + EPS);
#pragma unroll
                for (int j = 0; j < 16; ++j) { const int c = lane + 64 * j; const float z = v[j] * rstd * lng[c] + lnb[c]; Y[(size_t)m * D + c] = (bf16)f2bf(z * sigmoidf_(z)); }
            } }
#endif
#if NAIVE_LRU
            { const float* NRX = (const float*)(ws + WS_NRX); float* NA = (float*)(ws + WS_NA); float* NB = (float*)(ws + WS_NB);
            const float* wa = args.in[9] + (size_t)l * LH * LHD * LHD; const float* wx = args.in[11] + (size_t)l * LH * LHD * LHD;
            const float* ba = args.in[10] + (size_t)l * LW; const float* bxx = args.in[12] + (size_t)l * LW; const float* lam = args.in[13] + (size_t)l * LW;
            for (int idx = gtid; idx < T * LW; idx += NGT) {
                const int t = idx >> 10, c = idx & 1023, h = c >> 7, j = c & 127, tl = t & (SEQ - 1);
                float da = ba[c], dx = bxx[c];
                const float* rxr = NRX + (size_t)t * LW + h * LHD; const float* war = wa + (size_t)h * LHD * LHD + j; const float* wxr = wx + (size_t)h * LHD * LHD + j;
                for (int i = 0; i < LHD; ++i) { const float r = rxr[i]; da += r * war[i * LHD]; dx += r * wxr[i * LHD]; }
                const float ga = sigmoidf_(da), gx = sigmoidf_(dx);
                const float nl = -lam[c]; const float sp = (nl > 20.f) ? nl : log1pf(expf(nl));
                const float la = -LRU_C * ga * sp; const float a = expf(la);
                float mult = sqrtf(fmaxf(-expm1f(2.0f * la), 0.f)); if (tl == 0) mult = 1.0f;
                NA[idx] = a; NB[idx] = mult * gx * NRX[idx];
            }
            xcd_barrier(bar);
            if (gtid < BATCH * LW) { const int b = gtid >> 10, c = gtid & 1023; float h = 0.f;
                for (int t = 0; t < SEQ; ++t) { const size_t row = (size_t)b * SEQ + t; h = NA[row * LW + c] * h + NB[row * LW + c];
                    Y[row * D + CW + c] = (bf16)f2bf(h * gelu_tanh(bf2f(U[row * DIN + 3 * CW + c]))); } } }
#else
            for (int tile = bx; tile < T / 64; tile += G)
                lru_fix_unit((const bf16*)(ws + WS_P1), (const bf16*)(ws + WS_P2), (const float*)(ws + WS_HAGG), (const float*)(ws + WS_CAGG), Y, tile, lds, tid);
#endif
        }
        SEAM(pb + 2);
        if (IN(pb + 3)) REPS(pb + 3) {
            pg8::Gemm g{Y, Wout_t + (size_t)l * D * D, T, D, D}; pg8::StaticOrder S; S.init(T, D, G, vbx);
            if constexpr (L == 0) { pg8::EpiResNormT<true> E{H, H, (float*)(ws + WS_SSQA), D, 1.0f, (LAS float*)(lds + RING_BYTES)};
                pg8::gemm_phase<pg8::EpiResNormT<true>, pg8::StaticOrder, true, true>(lds + RING_OFF, g, S, E); }
            else { pg8::EpiResB16 E{H, D};
                pg8::gemm_phase<pg8::EpiResB16, pg8::StaticOrder, true, true>(lds + RING_OFF, g, S, E); }
        }
        SEAM(pb + 3);
        if constexpr (L == 0) {
            if (IN(5)) {
                pg8::Gemm g{H, DWgu, T, 2 * DFF, D}; pg8::StaticOrder S; S.init(T, 2 * DFF, G, vbx);
                typedef pg8::EpiSwiGlu8 EpiD1; EpiD1 E{(unsigned char*)HID, DFF, 1.0f, (const float*)(ws + WS_SSQA)};
                const int rounds = (S.nwg + G - 1) / G, grp = (vbx * 8) / G, cut = (rounds * grp) / 8;
                S.i0 = 0; S.i1 = cut;
                pg8::gemm_phase<EpiD1, pg8::StaticOrder, true, true>(lds + RING_OFF, g, S, E);
                moe_convert_share(args.in[20], args.in[21], args.in[22], (unsigned char*)MWgu, (unsigned char*)MWd, lds, gw, NGW, wave, lane);
                __syncthreads();
                S.i0 = cut; S.i1 = 0x7fffffff;
                pg8::gemm_phase<EpiD1, pg8::StaticOrder, true, true>(lds + RING_OFF, g, S, E);
            }
            SEAM(5);
            if (IN(6)) {
                pg8::Gemm g{HID, DWd, T, D, DFF / 2}; pg8::StaticOrder S; S.init(T, D, G, vbx);
                pg8::EpiResNormT<true> E{H, H, (float*)(ws + WS_SSQB), D, 1.0f / MOE_SC_D, (LAS float*)(lds + RING_BYTES)};
                pg8::gemm_phase<pg8::EpiResNormT<true>, pg8::StaticOrder, true, true, true>(lds + RING_OFF, g, S, E);
            }
            SEAM(6);
        } else {
            if (IN(11)) {
                LAS f32x4* wl = (LAS f32x4*)lds;
                LAS unsigned* rows8 = (LAS unsigned*)(lds + 65536);
                LAS unsigned* meta = (LAS unsigned*)(lds + 131072);
                LAS unsigned* lc = meta + 128;
                LAS unsigned* lbase = meta + 136;
                const float* wrt = args.in[19]; const float* gain = args.in[15] + D;
                for (int q = tid; q < D * NE / 4; q += NTHR) { const f32x4 w = ((const GAS f32x4*)wrt)[q]; const int k = q >> 1, half = q & 1, i = k & 3, ln = (k >> 2) & 63, j = k >> 8; wl[((j * 4 + i) * 2 + half) * 64 + ln] = w; }
                __syncthreads();
                for (int sub = bx; sub < T / 32; sub += G) {
                    if (tid < NE) lc[tid] = 0u;
                    __syncthreads();
#pragma unroll 1
                    for (int rr = 0; rr < 4; ++rr) { const int row = 4 * wave + rr, m = sub * 32 + row;
                        const GAS v2u* xr = (const GAS v2u*)(H + (size_t)m * D) + lane; const GAS f32x4* gr = (const GAS f32x4*)gain + lane;
                        f32x4 v[8]; float ss = 0.f;
#pragma unroll
                        for (int j = 0; j < 8; ++j) { const v2u a = xr[64 * j]; v[j] = (f32x4){bf_lo(a.x), bf_hi(a.x), bf_lo(a.y), bf_hi(a.y)}; ss += (v[j].x * v[j].x + v[j].y * v[j].y) + (v[j].z * v[j].z + v[j].w * v[j].w); }
                        const float rstd = 1.0f / sqrtf(wave_sum(ss) * (1.0f / D) + EPS);
                        f32x4 l0 = (f32x4){0.f, 0.f, 0.f, 0.f}, l1 = l0;
                        v16f hx, hy;
#pragma unroll
                        for (int j = 0; j < 8; ++j) { const f32x4 g = gr[64 * j]; const f32x4 hv = v[j] * rstd * g;
#pragma unroll
                            for (int i = 0; i < 4; ++i) { if (j < 4) hx[4 * j + i] = hv[i] * MOE_SC_A; else hy[4 * (j - 4) + i] = hv[i] * MOE_SC_A;
                                l0 += hv[i] * wl[((j * 4 + i) * 2 + 0) * 64 + lane]; l1 += hv[i] * wl[((j * 4 + i) * 2 + 1) * 64 + lane]; } }
                        { v6u d; asm volatile("v_cvt_scalef32_2xpk16_fp6_f32 %0, %1, %2, 1.0" : "=&v"(d) : "v"(hx), "v"(hy));
                          LAS unsigned* p1 = rows8 + row * 512 + (lane >> 2) * 32 + 4 * (lane & 3); p1[0] = d[0]; p1[1] = d[1]; p1[2] = d[2]; p1[3] = d[3]; p1[16] = d[4]; p1[17] = d[5]; }
                        float p4[4], p2[2], p1;
                        { const bool up = (lane & 32) != 0; float a0[4] = {l0.x, l0.y, l0.z, l0.w}, a1[4] = {l1.x, l1.y, l1.z, l1.w};
#pragma unroll
                          for (int i = 0; i < 4; ++i) { float x = a0[i], y = a1[i]; asm volatile("" : "+v"(x), "+v"(y)); p4[i] = (up ? y : x) + __shfl_xor(up ? x : y, 32); } }
                        { const bool up = (lane & 16) != 0;
#pragma unroll
                          for (int i = 0; i < 2; ++i) { float x = p4[i], y = p4[i + 2]; asm volatile("" : "+v"(x), "+v"(y)); p2[i] = (up ? y : x) + __shfl_xor(up ? x : y, 16); } }
                        { const bool up = (lane & 8) != 0; float x = p2[0], y = p2[1]; asm volatile("" : "+v"(x), "+v"(y)); p1 = (up ? y : x) + __shfl_xor(up ? x : y, 8); }
                        p1 += __shfl_xor(p1, 4); p1 += __shfl_xor(p1, 2); p1 += __shfl_xor(p1, 1);
                        float lg[8];
#pragma unroll
                        for (int e = 0; e < 8; ++e) lg[e] = __int_as_float(__builtin_amdgcn_readlane(__float_as_int(p1), ((e & 4) ? 32 : 0) + ((e & 2) ? 16 : 0) + ((e & 1) ? 8 : 0)));
                        float m1 = lg[0]; int i1 = 0;
#pragma unroll
                        for (int e = 1; e < 8; ++e) if (lg[e] > m1) { m1 = lg[e]; i1 = e; }
                        float m2 = -3.0e38f; int i2 = 0;
#pragma unroll
                        for (int e = 0; e < 8; ++e) if (e != i1 && lg[e] > m2) { m2 = lg[e]; i2 = e; }
                        const float ex = expf(m2 - m1), w1 = 1.0f / (1.0f + ex), w2 = ex / (1.0f + ex);
                        if (lane == 0) { int4 r; r.x = i1; r.y = i2; r.z = __float_as_int(w1); r.w = __float_as_int(w2); ((int4*)ROUTE)[m] = r;
                            meta[row * 4 + 0] = (unsigned)i1; meta[row * 4 + 1] = (unsigned)i2;
                            meta[row * 4 + 2] = __hip_atomic_fetch_add(lc + i1, 1u, __ATOMIC_RELAXED, __HIP_MEMORY_SCOPE_WORKGROUP); meta[row * 4 + 3] = __hip_atomic_fetch_add(lc + i2, 1u, __ATOMIC_RELAXED, __HIP_MEMORY_SCOPE_WORKGROUP); }
                    }
                    __syncthreads();
                    if (tid < NE) lbase[tid] = __hip_atomic_fetch_add(ctl + CW_CNT + 64 * tid, lc[tid], RLX_AGENT);
                    __syncthreads();
#pragma unroll 1
                    for (int rr = 0; rr < 4; ++rr) { const int row = 4 * wave + rr, m = sub * 32 + row;
                        const unsigned e1 = meta[row * 4 + 0], e2 = meta[row * 4 + 1]; const unsigned s1 = lbase[e1] + meta[row * 4 + 2], s2 = lbase[e2] + meta[row * 4 + 3];
                        if (lane == 0) { POS[2 * m] = (int)s1; POS[2 * m + 1] = (int)s2; }
                        const LAS v4u* src = (const LAS v4u*)(rows8 + row * 512) + lane; const v4u q0 = src[0], q1 = src[64];
                        GAS v4u* d1 = (GAS v4u*)((unsigned char*)XG8 + ((size_t)e1 * T + s1) * (D + XPAD)) + lane; GAS v4u* d2 = (GAS v4u*)((unsigned char*)XG8 + ((size_t)e2 * T + s2) * (D + XPAD)) + lane;
                        d1[0] = q0; d1[64] = q1; d2[0] = q0; d2[64] = q1; }
                    __syncthreads();
                }
            }
            SEAM(11);
            if (IN(12) || IN(13)) {
                pg8::MoeOrder S; unsigned acc = 0;
#pragma unroll
                for (int e = 0; e < NE; ++e) { const unsigned c = (unsigned)__builtin_amdgcn_readfirstlane((int)__hip_atomic_load(ctl + CW_CNT + 64 * e, RLX_AGENT)); const unsigned nt = (c + 255u) >> 8; acc += nt; S.te[e] = (int)acc; if (e < 7) S.dg[e] = T / 256 - (int)nt; }
                const int ntiles = (int)acc;
                if (IN(12)) { S.rep = (PROBE_PHASE == 12) ? PROBE_N : 1;
                    S.nM = ntiles; S.nN = 2 * DFF / 256; S.nwg = S.nM * S.nN; S.G = G; S.c = vbx; S.estride = (size_t)2 * DFF * D;
                    pg8::Gemm g{XG8, MWgu, ntiles * 256, 2 * DFF, D / 2, (D + XPAD) / 2};
                    pg8::EpiSwiGlu8 E{(unsigned char*)HID, DFF, 1.0f / (MOE_SC_GU * MOE_SC_A), nullptr};
                    pg8::gemm_phase<pg8::EpiSwiGlu8, pg8::MoeOrder, true, true, true, 0, true>(lds + RING_OFF, g, S, E);
                }
                SEAM(12);
                if (IN(13)) { S.rep = (PROBE_PHASE == 13) ? PROBE_N : 1;
#pragma unroll
                    for (int k = 0; k < 7; ++k) S.dg[k] = 0;
                    S.nM = ntiles; S.nN = D / 256; S.nwg = S.nM * S.nN; S.G = G; S.c = vbx; S.estride = (size_t)D * DFF;
                    pg8::Gemm g{HID, MWd, ntiles * 256, D, DFF / 2};
                    pg8::EpiBf16S E{YB, D, 1.0f / MOE_SC_D};
                    pg8::gemm_phase<pg8::EpiBf16S, pg8::MoeOrder, true, true, true>(lds + RING_OFF, g, S, E);
                }
                SEAM(13);
            }
            if (IN(14)) REPS(14) {
                const float* fn = args.in[23];
                LAS unsigned* tst = (LAS unsigned*)(lds + RING_OFF);
                if (tid == 0) { unsigned acc = 0; for (int e = 0; e < NE; ++e) { tst[e] = acc << 8; acc += (__hip_atomic_load(ctl + CW_CNT + 64 * e, RLX_AGENT) + 255u) >> 8; } }
                __syncthreads();
                const GAS f32x4* gr = (const GAS f32x4*)fn + lane;
                int m = gw; int4 r = (int4){0, 0, 0, 0}; int q1 = 0, q2 = 0;
                v2u xa[8], ya[8], yb[8];
                if (m < T) { r = ((const int4*)ROUTE)[m]; q1 = POS[2 * m]; q2 = POS[2 * m + 1];
                    const int p1 = (int)tst[r.x] + q1, p2 = (int)tst[r.y] + q2;
                    const GAS v2u* xr = (const GAS v2u*)(H + (size_t)m * D) + lane; const GAS v2u* y1 = (const GAS v2u*)(YB + (size_t)p1 * D) + lane; const GAS v2u* y2 = (const GAS v2u*)(YB + (size_t)p2 * D) + lane;
#pragma unroll
                    for (int j = 0; j < 8; ++j) { xa[j] = xr[64 * j]; ya[j] = y1[64 * j]; yb[j] = y2[64 * j]; } }
                int4 rn = (int4){0, 0, 0, 0}; int qn1 = 0, qn2 = 0;
                { const int mn = m + NGW; if (mn < T) { rn = ((const int4*)ROUTE)[mn]; qn1 = POS[2 * mn]; qn2 = POS[2 * mn + 1]; } }
#pragma unroll 1
                for (; m < T; m += NGW) {
                    const float w1 = __int_as_float(r.z), w2 = __int_as_float(r.w);
                    const int mn = m + NGW, mnn = mn + NGW;
                    v2u xb_[8], yc[8], yd[8];
                    if (mn < T) { const int p1 = (int)tst[rn.x] + qn1, p2 = (int)tst[rn.y] + qn2;
                        const GAS v2u* xr = (const GAS v2u*)(H + (size_t)mn * D) + lane; const GAS v2u* y1 = (const GAS v2u*)(YB + (size_t)p1 * D) + lane; const GAS v2u* y2 = (const GAS v2u*)(YB + (size_t)p2 * D) + lane;
#pragma unroll
                        for (int j = 0; j < 8; ++j) { xb_[j] = xr[64 * j]; yc[j] = y1[64 * j]; yd[j] = y2[64 * j]; } }
                    else {
#pragma unroll
                        for (int j = 0; j < 8; ++j) { xb_[j] = (v2u){0u, 0u}; yc[j] = xb_[j]; yd[j] = xb_[j]; } }
                    int4 rnn = (int4){0, 0, 0, 0}; int qa = 0, qb = 0;
                    if (mnn < T) { rnn = ((const int4*)ROUTE)[mnn]; qa = POS[2 * mnn]; qb = POS[2 * mnn + 1]; }
                    f32x4 v[8]; float s = 0.f;
#pragma unroll
                    for (int j = 0; j < 8; ++j) { const v2u x3 = xa[j], a = ya[j], b = yb[j]; v[j] = (f32x4){bf_lo(x3.x), bf_hi(x3.x), bf_lo(x3.y), bf_hi(x3.y)};
                        v[j].x += w1 * bf_lo(a.x) + w2 * bf_lo(b.x); v[j].y += w1 * bf_hi(a.x) + w2 * bf_hi(b.x); v[j].z += w1 * bf_lo(a.y) + w2 * bf_lo(b.y); v[j].w += w1 * bf_hi(a.y) + w2 * bf_hi(b.y);
                        s += (v[j].x * v[j].x + v[j].y * v[j].y) + (v[j].z * v[j].z + v[j].w * v[j].w); }
                    const float rstd = 1.0f / sqrtf(wave_sum(s) * (1.0f / D) + EPS);
                    GAS f32x4* o = (GAS f32x4*)(args.out + (size_t)m * D) + lane;
#pragma unroll
                    for (int j = 0; j < 8; ++j) o[64 * j] = v[j] * rstd * gr[64 * j];
#pragma unroll
                    for (int j = 0; j < 8; ++j) { xa[j] = xb_[j]; ya[j] = yc[j]; yb[j] = yd[j]; }
                    r = rn; rn = rnn; qn1 = qa; qn2 = qb;
                }
            }
        }
    }
}

__global__ void __launch_bounds__(NTHR, 2) trunk_fwd(Args args) {
    extern __shared__ __attribute__((aligned(16))) unsigned char lds_raw[];
    LAS unsigned char* lds = (LAS unsigned char*)lds_raw;
    volatile LAS unsigned* MISC = (volatile LAS unsigned*)(lds + MISC_OFF);
    const int tid = threadIdx.x, lane = tid & 63, wave = __builtin_amdgcn_readfirstlane(tid >> 6);
    const int G = gridDim.x, bx = blockIdx.x;
    const int gw = bx * NWAVES + wave, NGW = G * NWAVES;
    const int gtid = bx * NTHR + tid, NGT = G * NTHR;
    unsigned char* ws = args.ws;
    gu32* ctl = (gu32*)(ws + WS_CTL);
    for (int u = tid; u < (LDS_BYTES - LDSCTL_OFF) / 4; u += NTHR) ((LAS unsigned*)(lds + LDSCTL_OFF))[u] = 0u;
    __syncthreads();
    XcdBarrier bar; bar.bar = (unsigned*)(ctl + CW_BAR); bar.x = 0; bar.st = nullptr;
    if (!MK_PER_PHASE) bar = xcd_barrier_post((unsigned*)(ctl + CW_BAR), MISC + 8);
    const int lo = args.ph_lo, hi = args.ph_hi;
    if (tid == 0) { const unsigned xcc = xb_xcc_id() & 7u; const unsigned r = __hip_atomic_fetch_add(ctl + CW_XRANK + 64 * xcc, 1u, RLX_AGENT); MISC[12] = xcc + 8u * r; }

    const float* x_in = args.in[0];
    bf16* Win_t = (bf16*)(ws + WS_WIN); bf16* Wout_t = (bf16*)(ws + WS_WOUT); bf16* Wgate_t = (bf16*)(ws + WS_WGATE);
    bf16* DWgu = (bf16*)(ws + WS_DWGU); bf16* DWd = (bf16*)(ws + WS_DWD); bf16* MWgu = (bf16*)(ws + WS_MWGU); bf16* MWd = (bf16*)(ws + WS_MWD);
    float* X = (float*)(ws + WS_X); bf16* H = (bf16*)(ws + WS_H); bf16* U = (bf16*)(ws + WS_U); bf16* Y = (bf16*)(ws + WS_Y);
    bf16* HID = (bf16*)(ws + WS_HID); bf16* XG8 = (bf16*)(ws + WS_XG8); bf16* YB = (bf16*)(ws + WS_YB);
    int* ROUTE = (int*)(ws + WS_ROUTE); int* POS = (int*)(ws + WS_POS);

    if (IN(0)) REPS(0) {
        dense_convert_items(args, ws, 0, DC_N_EARLY, lds, gw, NGW, wave, lane);
        for (int m = gw; m < T; m += NGW) row_to_bf16_ssq(x_in + (size_t)m * D, H + (size_t)m * D, (float*)(ws + WS_SSQB) + (size_t)m * 8, lane);
    }
    SEAM(0);

    int vbx = bx;
    if (G == 256 && lo == 0 && hi > 1) {
        bool ok = true;
#pragma unroll
        for (int x = 0; x < 8; ++x) ok = ok && (__builtin_amdgcn_readfirstlane((int)__hip_atomic_load(ctl + CW_XRANK + 64 * x, RLX_AGENT)) == 32);
        const int v = __builtin_amdgcn_readfirstlane((int)MISC[12]);
        if (ok && v >= 0 && v < G) vbx = v;
    }
    Ctx C; C.vbx = vbx; C.lds = lds; C.ws = ws; C.ctl = ctl; C.tid = tid; C.lane = lane; C.wave = wave; C.G = G; C.bx = bx; C.gw = gw; C.NGW = NGW; C.gtid = gtid; C.NGT = NGT; C.lo = lo; C.hi = hi;
    layer_phases<0>(args, C, bar);
    layer_phases<1>(args, C, bar);
#undef IN
#undef SEAM
}

extern "C" void kernel_launch(void* const* d_in, const int* in_sizes, int n_in, void* d_out, int out_size, void* d_ws, size_t ws_size, hipStream_t stream) {
    static int grid = 0;
    if (grid == 0) {
        if (n_in != 24 || in_sizes[0] != T * D || out_size != T * D || ws_size < WS_END) { fprintf(stderr, "kernel_launch: unexpected shapes (n_in %d, in0 %d, out %d, ws %zu < %zu?); nothing launched\n", n_in, n_in > 0 ? in_sizes[0] : -1, out_size, ws_size, (size_t)WS_END); grid = -1; return; }
        int dev = 0, cus = 0, per_cu = 0;
        if (hipGetDevice(&dev) != hipSuccess || hipDeviceGetAttribute(&cus, hipDeviceAttributeMultiprocessorCount, dev) != hipSuccess) { grid = -1; return; }
        if (hipFuncSetAttribute((const void*)trunk_fwd, hipFuncAttributeMaxDynamicSharedMemorySize, LDS_BYTES) != hipSuccess) { fprintf(stderr, "kernel_launch: hipFuncSetAttribute failed\n"); grid = -1; return; }
        if (hipOccupancyMaxActiveBlocksPerMultiprocessor(&per_cu, (const void*)trunk_fwd, NTHR, LDS_BYTES) != hipSuccess || per_cu < 1) fprintf(stderr, "kernel_launch: occupancy query reports %d blocks per CU\n", per_cu);
        (void)hipGetLastError();
        grid = cus;
    }
    if (grid < 0) return;
    if (hipMemsetAsync((char*)d_ws + WS_CTL, 0, CTL_ZERO_BYTES, stream) != hipSuccess) return;
    Args a{};
    for (int i = 0; i < 24; ++i) a.in[i] = (const float*)d_in[i];
    a.out = (float*)d_out; a.ws = (unsigned char*)d_ws;
#if MK_PER_PHASE
    for (int p = 0; p < N_PHASES; ++p) { a.ph_lo = p; a.ph_hi = p + 1; hipLaunchKernelGGL(trunk_fwd, dim3(grid), dim3(NTHR), LDS_BYTES, stream, a); }
#else
    a.ph_lo = 0; a.ph_hi = N_PHASES;
    hipLaunchKernelGGL(trunk_fwd, dim3(grid), dim3(NTHR), LDS_BYTES, stream, a);
#endif
}
```
